# Optimizing an MI355X kernel written in HIP

```python
import math
import jax, jax.numpy as jnp
from jax import lax
import numpy as np

D_MODEL = 1024
BATCH = 8
SEQ = 4096
DEPTH = 2

GRID_W = 64
CTX_LEN = 256
RET_HEADS = 4
RET_DK = 64
RET_DV = 64
RET_CHUNK = 128
MLA_HEADS = 8
MLA_Q_RANK = 256
MLA_KV_RANK = 128
MLA_NOPE = 64
MLA_ROPE = 32
MLA_DV = 64
MLA_QBLOCK = 128
WIN_Q_HEADS = 4
WIN_KV_HEADS = 2
WIN_DH = 64
WINDOW = 128
WIN_BLOCK = 128
N_EXPERTS = 16
EXPERT_FF = 768
CAPACITY_FACTOR = 2

ROPE_BASE = 10000.0
NORM_EPS = 1e-6
GN_EPS = 1e-5
NEG_INF = -1e30

IN_SPLITS = (RET_HEADS * RET_DK, RET_HEADS * RET_DK, RET_HEADS * RET_DV, RET_HEADS * RET_DV,
             MLA_Q_RANK, MLA_KV_RANK, MLA_ROPE,
             WIN_Q_HEADS * WIN_DH, WIN_KV_HEADS * WIN_DH, WIN_KV_HEADS * WIN_DH)
IN_COLS = sum(IN_SPLITS)

kernel_name = 'hybrid_ret_mla_swa_ec_diffusion'


def rmsnorm(x, g):
    xf = x.astype(jnp.float32)
    y = xf * lax.rsqrt(jnp.mean(xf * xf, axis=-1, keepdims=True) + NORM_EPS)
    return (y * g.astype(jnp.float32)).astype(x.dtype)


def modulate(h, shift, scale):
    return h * (1 + scale) + shift


def split_cols(p):
    offs = [int(o) for o in np.cumsum(IN_SPLITS)[:-1]]
    return jnp.split(p, offs, axis=-1)


def rope_1d(x, pos):
    dh = x.shape[-1]
    inv = ROPE_BASE ** (-jnp.arange(0, dh, 2, dtype=jnp.float32) / dh)
    ang = pos.astype(jnp.float32)[:, None] * inv[None, :]
    cos = jnp.cos(ang)[:, None, :].astype(x.dtype)
    sin = jnp.sin(ang)[:, None, :].astype(x.dtype)
    x1, x2 = jnp.split(x, 2, axis=-1)
    return jnp.concatenate([x1 * cos - x2 * sin, x1 * sin + x2 * cos], axis=-1)


def axial_rope(x, row, col):
    xr, xc = jnp.split(x, 2, axis=-1)
    return jnp.concatenate([rope_1d(xr, row), rope_1d(xc, col)], axis=-1)


def retention_scan(q, k, v, log_g, s0, inclusive):
    b, h, l, dk = q.shape
    dv = v.shape[-1]
    C = RET_CHUNK
    n = l // C
    qc = q.reshape(b, h, n, C, dk)
    kc = k.reshape(b, h, n, C, dk)
    vc = v.reshape(b, h, n, C, dv)
    idx = jnp.arange(C, dtype=jnp.float32)
    diff = idx[:, None] - idx[None, :]
    keep = (diff >= 0) if inclusive else (diff > 0)
    lg = log_g.astype(jnp.float32)
    dmat = jnp.where(keep, jnp.exp(lg[:, None, None] * jnp.where(keep, diff, 0.0)), 0.0).astype(q.dtype)
    scores = jnp.einsum('bhncd,bhnmd->bhncm', qc, kc) * dmat[:, None]
    y = jnp.einsum('bhncm,bhnme->bhnce', scores, vc)
    k_w = jnp.exp(lg[:, None] * (C - 1 - idx)[None, :]).astype(q.dtype)
    q_w = jnp.exp(lg[:, None] * (idx + 1)[None, :]).astype(q.dtype)
    chunk_kv = jnp.einsum('bhncd,bhnce->nbhde', kc * k_w[:, None, :, None], vc)
    g_chunk = jnp.exp(lg * C).astype(q.dtype)[:, None, None]

    def step(s, kv_n):
        return g_chunk * s + kv_n, s

    s_final, s_prev = lax.scan(step, s0.astype(q.dtype), chunk_kv)
    y = y + jnp.einsum('bhncd,nbhde->bhnce', qc * q_w[:, None, :, None], s_prev)
    return y.reshape(b, h, l, dv), s_final


def head_groupnorm(y):
    yf = y.astype(jnp.float32)
    mu = jnp.mean(yf, axis=-1, keepdims=True)
    var = jnp.mean(jnp.square(yf - mu), axis=-1, keepdims=True)
    return ((yf - mu) * lax.rsqrt(var + GN_EPS)).astype(y.dtype)


def retention_group(q_x, k_x, v_x, g_x, q_c, k_c, v_c, g_c, decay_f, decay_b, need_ctx):
    def heads(t):
        bb, ll, _ = t.shape
        return t.reshape(bb, ll, RET_HEADS, -1).transpose(0, 2, 1, 3)

    def flip(t):
        return t[:, :, ::-1]

    lg_f = jnp.log1p(-jnp.exp2(decay_f.astype(jnp.float32)))
    lg_b = jnp.log1p(-jnp.exp2(decay_b.astype(jnp.float32)))
    scale = RET_DK ** -0.5
    qx, kx, vx = heads(q_x), heads(k_x) * scale, heads(v_x)
    qc, kc, vc = heads(q_c), heads(k_c) * scale, heads(v_c)
    zero = jnp.zeros((qx.shape[0], RET_HEADS, RET_DK, RET_DV), qx.dtype)
    yc_f, s_f = retention_scan(qc, kc, vc, lg_f, zero, True)
    yc_b, s_b = retention_scan(flip(qc), flip(kc), flip(vc), lg_b, zero, False)
    yx_f, _ = retention_scan(qx, kx, vx, lg_f, s_f, True)
    yx_b, _ = retention_scan(flip(qx), flip(kx), flip(vx), lg_b, s_b, False)

    def finish(y, g):
        bb, hh, ll, dd = y.shape
        y = head_groupnorm(y).transpose(0, 2, 1, 3).reshape(bb, ll, hh * dd)
        return y * jax.nn.silu(g)

    out_x = finish(yx_f + flip(yx_b), g_x)
    out_c = finish(yc_f + flip(yc_b), g_c) if need_ctx else None
    return out_x, out_c


def mla_group(cq_x, ckv_x, kr_x, cq_c, ckv_c, kr_c, row, col, qnorm_g, kvnorm_g, w_uq, w_uk, w_uv, need_ctx):
    scale = (MLA_NOPE + MLA_ROPE) ** -0.5

    def queries(cq):
        q = jnp.einsum('blr,rhe->blhe', rmsnorm(cq, qnorm_g), w_uq)
        return q[..., :MLA_NOPE], q[..., MLA_NOPE:]

    def attend(ql, qr, kv, kr):
        s = (jnp.einsum('bhqr,bkr->bhqk', ql, kv) + jnp.einsum('bhqp,bkp->bhqk', qr, kr)).astype(jnp.float32) * scale
        p = jax.nn.softmax(s, axis=-1).astype(kv.dtype)
        return jnp.einsum('bhqk,bkr->bhqr', p, kv)

    def up(ol):
        o = jnp.einsum('bhlr,rhd->blhd', ol, w_uv)
        return o.reshape(o.shape[0], o.shape[1], -1)

    kv_c = rmsnorm(ckv_c, kvnorm_g)
    kv_x = rmsnorm(ckv_x, kvnorm_g)
    kr_xr = axial_rope(kr_x[:, :, None, :], row, col)[:, :, 0, :]
    kv_all = jnp.concatenate([kv_c, kv_x], axis=1)
    kr_all = jnp.concatenate([kr_c, kr_xr], axis=1)
    qn_x, qr_x = queries(cq_x)
    qr_x = axial_rope(qr_x, row, col).transpose(0, 2, 1, 3)
    ql_x = jnp.einsum('blhd,rhd->bhlr', qn_x, w_uk)
    b, h, l, r = ql_x.shape
    nb = l // MLA_QBLOCK

    def blocks(t):
        return t.reshape(b, h, nb, MLA_QBLOCK, t.shape[-1]).transpose(2, 0, 1, 3, 4)

    ol = lax.map(lambda qs: attend(qs[0], qs[1], kv_all, kr_all), (blocks(ql_x), blocks(qr_x)))
    ol = ol.transpose(1, 2, 0, 3, 4).reshape(b, h, l, r)
    out_x = up(ol)
    out_c = None
    if need_ctx:
        qn_c, qr_c = queries(cq_c)
        ql_c = jnp.einsum('blhd,rhd->bhlr', qn_c, w_uk)
        out_c = up(attend(ql_c, qr_c.transpose(0, 2, 1, 3), kv_c, kr_c))
    return out_x, out_c


def window_group(q_x, k_x, v_x, q_c, k_c, v_c, row, col, sink, need_ctx):
    b, l, _ = q_x.shape
    lc = q_c.shape[1]
    hk, g, d = WIN_KV_HEADS, WIN_Q_HEADS // WIN_KV_HEADS, WIN_DH
    W = WIN_BLOCK
    nb = l // W
    scale = d ** -0.5
    qx = axial_rope(q_x.reshape(b, l, WIN_Q_HEADS, d), row, col).reshape(b, l, hk, g, d)
    kx = axial_rope(k_x.reshape(b, l, hk, d), row, col)
    vx = v_x.reshape(b, l, hk, d)
    kc = k_c.reshape(b, lc, hk, d)
    vc = v_c.reshape(b, lc, hk, d)
    sink_l = sink.astype(jnp.float32).reshape(hk, g, 1, 1)

    def band(t):
        tp = jnp.pad(t, ((0, 0), (W, W), (0, 0), (0, 0))).reshape(b, nb + 2, W, hk, d)
        return jnp.concatenate([tp[:, :-2], tp[:, 1:-1], tp[:, 2:]], axis=2)

    kb, vb = band(kx), band(vx)
    qi = jnp.arange(nb)[:, None, None] * W + jnp.arange(W)[None, :, None]
    kj = (jnp.arange(nb)[:, None, None] - 1) * W + jnp.arange(3 * W)[None, None, :]
    mask = (jnp.abs(kj - qi) <= WINDOW) & (kj >= 0) & (kj < l)
    qb = qx.reshape(b, nb, W, hk, g, d)
    s_loc = jnp.einsum('bnqhgd,bnkhd->bnhgqk', qb, kb).astype(jnp.float32) * scale
    s_loc = jnp.where(mask[None, :, None, None], s_loc, NEG_INF)
    s_ctx = jnp.einsum('bnqhgd,bkhd->bnhgqk', qb, kc).astype(jnp.float32) * scale
    s_sink = jnp.broadcast_to(sink_l, s_loc.shape[:-1] + (1,))
    p = jax.nn.softmax(jnp.concatenate([s_loc, s_ctx, s_sink], axis=-1), axis=-1).astype(vx.dtype)
    o = (jnp.einsum('bnhgqk,bnkhd->bnqhgd', p[..., :3 * W], vb)
         + jnp.einsum('bnhgqk,bkhd->bnqhgd', p[..., 3 * W:3 * W + lc], vc))
    out_x = o.reshape(b, l, WIN_Q_HEADS * d)
    out_c = None
    if need_ctx:
        s = jnp.einsum('bqhgd,bkhd->bhgqk', q_c.reshape(b, lc, hk, g, d), kc).astype(jnp.float32) * scale
        s = jnp.concatenate([s, jnp.broadcast_to(sink_l, s.shape[:-1] + (1,))], axis=-1)
        pc = jax.nn.softmax(s, axis=-1).astype(vc.dtype)
        out_c = jnp.einsum('bhgqk,bkhd->bqhgd', pc[..., :lc], vc).reshape(b, lc, WIN_Q_HEADS * d)
    return out_x, out_c


def hybrid_mixer(px, pc, row, col, ret_decay_f, ret_decay_b, mla_qnorm_g, mla_kvnorm_g,
                 mla_w_uq, mla_w_uk, mla_w_uv, win_sink, need_ctx):
    (rq_x, rk_x, rv_x, rg_x, cq_x, ckv_x, kr_x, wq_x, wk_x, wv_x) = split_cols(px)
    (rq_c, rk_c, rv_c, rg_c, cq_c, ckv_c, kr_c, wq_c, wk_c, wv_c) = split_cols(pc)
    ret_x, ret_c = retention_group(rq_x, rk_x, rv_x, rg_x, rq_c, rk_c, rv_c, rg_c,
                                   ret_decay_f, ret_decay_b, need_ctx)
    mla_x, mla_c = mla_group(cq_x, ckv_x, kr_x, cq_c, ckv_c, kr_c, row, col, mla_qnorm_g, mla_kvnorm_g,
                             mla_w_uq, mla_w_uk, mla_w_uv, need_ctx)
    win_x, win_c = window_group(wq_x, wk_x, wv_x, wq_c, wk_c, wv_c, row, col, win_sink, need_ctx)
    y_x = jnp.concatenate([ret_x, mla_x, win_x], axis=-1)
    y_c = jnp.concatenate([ret_c, mla_c, win_c], axis=-1) if need_ctx else None
    return y_x, y_c


def expert_choice_ffn(h, router_w, w_gate, w_up, w_down):
    b, l, d = h.shape
    cap = CAPACITY_FACTOR * l // N_EXPERTS
    aff = jax.nn.softmax(jnp.einsum('bld,de->ble', h, router_w).astype(jnp.float32), axis=-1)
    gate, idx = lax.top_k(aff.transpose(0, 2, 1), cap)
    xs = jax.vmap(lambda hb, ib: hb[ib])(h, idx)
    hid = jax.nn.silu(jnp.einsum('becd,edf->becf', xs, w_gate)) * jnp.einsum('becd,edf->becf', xs, w_up)
    ys = jnp.einsum('becf,efd->becd', hid, w_down) * gate[..., None].astype(h.dtype)
    return jax.vmap(lambda yb, ib: jnp.zeros((l, d), h.dtype).at[ib.reshape(-1)].add(yb.reshape(-1, d)))(ys, idx)


def setup_inputs(seed: int = 0) -> dict:
    key = jax.random.key(seed)
    ks = iter(jax.random.split(key, 32))

    def nrm(shape, scale):
        return jax.random.normal(next(ks), shape, jnp.float32) * scale

    L, D = DEPTH, D_MODEL
    sched = -5.0 - jnp.arange(RET_HEADS, dtype=jnp.float32)
    return {
        'x': nrm((BATCH, SEQ, D), 1.0),
        'c': nrm((BATCH, D), 1.0),
        'ctx': nrm((BATCH, CTX_LEN, D), 1.0),
        'c_ctx': nrm((D,), 1.0),
        'norm1_g': 1.0 + nrm((L, D), 0.05),
        'norm2_g': 1.0 + nrm((L, D), 0.05),
        'ada_w': nrm((L, D, 6 * D), 0.5 * D ** -0.5),
        'ada_b': nrm((L, 6 * D), 0.02),
        'w_in': nrm((L, D, IN_COLS), D ** -0.5),
        'ret_decay_f': sched + nrm((L, RET_HEADS), 0.1),
        'ret_decay_b': sched + nrm((L, RET_HEADS), 0.1),
        'mla_qnorm_g': 1.0 + nrm((L, MLA_Q_RANK), 0.05),
        'mla_kvnorm_g': 1.0 + nrm((L, MLA_KV_RANK), 0.05),
        'mla_w_uq': nrm((L, MLA_Q_RANK, MLA_HEADS, MLA_NOPE + MLA_ROPE), MLA_Q_RANK ** -0.5),
        'mla_w_uk': nrm((L, MLA_KV_RANK, MLA_HEADS, MLA_NOPE), MLA_KV_RANK ** -0.5),
        'mla_w_uv': nrm((L, MLA_KV_RANK, MLA_HEADS, MLA_DV), MLA_KV_RANK ** -0.5),
        'win_sink': nrm((L, WIN_Q_HEADS), 0.5),
        'w_out': nrm((L, D, D), D ** -0.5),
        'router_w': nrm((L, D, N_EXPERTS), D ** -0.5),
        'exp_w_gate': nrm((L, N_EXPERTS, D, EXPERT_FF), D ** -0.5),
        'exp_w_up': nrm((L, N_EXPERTS, D, EXPERT_FF), D ** -0.5),
        'exp_w_down': nrm((L, N_EXPERTS, EXPERT_FF, D), EXPERT_FF ** -0.5),
        'final_g': 1.0 + nrm((D,), 0.05),
    }


def reference(x, c, ctx, c_ctx, norm1_g, norm2_g, ada_w, ada_b, w_in, ret_decay_f, ret_decay_b,
              mla_qnorm_g, mla_kvnorm_g, mla_w_uq, mla_w_uk, mla_w_uv, win_sink, w_out,
              router_w, exp_w_gate, exp_w_up, exp_w_down, final_g):
    n_tok = x.shape[1]
    rows = n_tok // GRID_W
    row = jnp.repeat(jnp.arange(rows, dtype=jnp.int32), GRID_W)
    col = jnp.tile(jnp.arange(GRID_W, dtype=jnp.int32), rows)
    for layer in range(DEPTH):
        need_ctx = layer < DEPTH - 1
        mod_x = [m[:, None, :] for m in jnp.split(jax.nn.silu(c) @ ada_w[layer] + ada_b[layer], 6, axis=-1)]
        mod_c = jnp.split(jax.nn.silu(c_ctx) @ ada_w[layer] + ada_b[layer], 6, axis=-1)
        hx = modulate(rmsnorm(x, norm1_g[layer]), mod_x[0], mod_x[1])
        hc = modulate(rmsnorm(ctx, norm1_g[layer]), mod_c[0], mod_c[1])
        yx, yc = hybrid_mixer(hx @ w_in[layer], hc @ w_in[layer], row, col,
                              ret_decay_f[layer], ret_decay_b[layer], mla_qnorm_g[layer], mla_kvnorm_g[layer],
                              mla_w_uq[layer], mla_w_uk[layer], mla_w_uv[layer], win_sink[layer], need_ctx)
        x = x + mod_x[2] * (yx @ w_out[layer])
        hx = modulate(rmsnorm(x, norm2_g[layer]), mod_x[3], mod_x[4])
        x = x + mod_x[5] * expert_choice_ffn(hx, router_w[layer], exp_w_gate[layer], exp_w_up[layer], exp_w_down[layer])
        if need_ctx:
            ctx = ctx + mod_c[2] * (yc @ w_out[layer])
            hc = modulate(rmsnorm(ctx, norm2_g[layer]), mod_c[3], mod_c[4])
            ctx = ctx + mod_c[5] * expert_choice_ffn(hc, router_w[layer], exp_w_gate[layer], exp_w_up[layer], exp_w_down[layer])
    return rmsnorm(x, final_g)
```

```cpp
#include <hip/hip_runtime.h>
#include <stdint.h>
#include <stdio.h>

namespace {
typedef unsigned short bf16_t;
#define LAS __attribute__((address_space(3)))
constexpr int NB = 8, SEQ = 4096, CTXL = 256, DM = 1024;
constexpr int NLAT = NB * SEQ;
constexpr int NCTX = NB * CTXL;
constexpr int NROWS = NLAT + NCTX;
constexpr int NKEYS = CTXL + SEQ;
constexpr int PCOLS = 1952, PLD = 2048;
constexpr int C_RQ = 0, C_RK = 256, C_RV = 512, C_RG = 768, C_CQ = 1024, C_CKV = 1280, C_KR = 1408, C_WQ = 1440, C_WK = 1696, C_WV = 1824;
constexpr int NEXP = 16, FF = 768, CAP = 512, CAPC = 32;
constexpr float LOG2E = 1.4426950408889634f;

constexpr size_t O_CTL = 0;
constexpr size_t O_QCNT = 49152 + 1024;
constexpr size_t O_DEPW = 0;
constexpr size_t O_CANON = 49152 + 512;
constexpr size_t O_QXCD = 49152 + 4096;
constexpr size_t O_RETLG = 49152;
constexpr size_t O_MOD = 65536;
constexpr size_t O_XC = 524288;
constexpr size_t O_AFF = O_XC + 8388608;
constexpr size_t O_IDX = O_AFF + 2228224;
constexpr size_t O_GATE = O_IDX + 262144;
constexpr size_t O_IDXC = O_GATE + 262144;
constexpr size_t O_GATEC = O_IDXC + 16384;
constexpr size_t O_SLOT = O_GATEC + 16384;
constexpr size_t O_WQ = O_SLOT + 1114112;
constexpr size_t O_WK = O_WQ + 17825792;
constexpr size_t O_WV = O_WK + 8912896;
constexpr size_t O_HX = O_WV + 8912896;
constexpr size_t O_P = O_HX + 71303168;
constexpr size_t O_QM = O_P + 142606336;
constexpr size_t O_KM = O_QM + 53477376;
constexpr size_t O_VM = O_KM + 53477376;
constexpr size_t O_END = O_VM + 35651584;
constexpr size_t O_WINT = O_END;
constexpr size_t O_WOUTT = O_WINT + 2 * 2048 * 1024 * 2;
constexpr size_t O_WGUT = O_WOUTT + 2 * 1024 * 1024 * 2;
constexpr size_t O_WDT = O_WGUT + (size_t)16 * 1536 * 1024 * 2;
constexpr size_t O_END2 = O_WDT + (size_t)16 * 1024 * 768 * 2;

constexpr size_t O_VT = O_END2;
constexpr size_t O_END3 = O_VT + 35651584;
constexpr size_t O_WVT = O_WV;
constexpr size_t O_RVT = O_WGUT;
constexpr size_t O_KVF = O_RVT + 17825792;
constexpr size_t O_KVB = O_KVF + 17825792;
constexpr size_t O_SPF = O_KVB + 17825792;
constexpr size_t O_SPB = O_SPF + 8912896;
static_assert(O_SPB + 8912896 <= O_WDT + (size_t)16 * 1024 * 768 * 2, "retention buffers fit in the expert-weight region");
constexpr size_t O_WUQT = O_END3;
constexpr size_t O_WUKT = O_WUQT + 2 * 768 * 256 * 2;
constexpr size_t O_WUVT = O_WUKT + 2 * 512 * 128 * 2;
constexpr size_t O_END4 = O_WUVT + 2 * 512 * 128 * 2;
constexpr size_t O_SSQ = O_WQ;
constexpr size_t O_HID = O_P;
constexpr size_t O_HIDC = O_P + 100663296;
constexpr size_t O_YS = O_QM;
constexpr size_t O_YSC = O_QM + 134217728;

struct Params {
    const float *x, *c, *ctx, *c_ctx, *norm1_g, *norm2_g, *ada_w, *ada_b, *w_in, *ret_decay_f, *ret_decay_b,
        *mla_qnorm_g, *mla_kvnorm_g, *mla_w_uq, *mla_w_uk, *mla_w_uv, *win_sink, *w_out, *router_w,
        *exp_w_gate, *exp_w_up, *exp_w_down, *final_g;
    float* out; unsigned char* ws;
};

typedef const __attribute__((address_space(4))) Params KParams;
__device__ __forceinline__ int opaque_tid() { int t = (int)threadIdx.x; asm volatile("" : "+v"(t)); return t; }
#define STAGE_PARAMS() KParams* pp_ = (KParams*)__builtin_amdgcn_kernarg_segment_ptr(); asm volatile("" : "+s"(pp_)); KParams& p = *pp_; const int tid_ = opaque_tid(); int bid_ = (int)blockIdx.x, G_ = (int)gridDim.x; asm volatile("" : "+s"(bid_), "+s"(G_))
__device__ __forceinline__ float bf2f(bf16_t v) { return __uint_as_float(((unsigned)v) << 16); }
__device__ __forceinline__ float bflo(unsigned v) { return __uint_as_float(v << 16); }
__device__ __forceinline__ float bfhi(unsigned v) { return __uint_as_float(v & 0xffff0000u); }
__device__ __forceinline__ unsigned f2bf(float f) { unsigned u = __float_as_uint(f); return (u + 0x7fffu + ((u >> 16) & 1u)) >> 16; }
__device__ __forceinline__ unsigned pk2(float lo, float hi) { return f2bf(lo) | (f2bf(hi) << 16); }
__device__ __forceinline__ float wave_sum(float v) {
    v += __int_as_float(__builtin_amdgcn_ds_swizzle(__float_as_int(v), (1 << 10) | 0x1f));
    v += __int_as_float(__builtin_amdgcn_ds_swizzle(__float_as_int(v), (2 << 10) | 0x1f));
    v += __int_as_float(__builtin_amdgcn_ds_swizzle(__float_as_int(v), (4 << 10) | 0x1f));
    v += __int_as_float(__builtin_amdgcn_ds_swizzle(__float_as_int(v), (8 << 10) | 0x1f));
    v += __int_as_float(__builtin_amdgcn_ds_swizzle(__float_as_int(v), (16 << 10) | 0x1f));
    const auto rr = __builtin_amdgcn_permlane32_swap(__float_as_uint(v), __float_as_uint(v), false, false);
    return __uint_as_float(rr[0]) + __uint_as_float(rr[1]);
}
__device__ __forceinline__ float wave_max(float v) {
    v = fmaxf(v, __int_as_float(__builtin_amdgcn_ds_swizzle(__float_as_int(v), (1 << 10) | 0x1f)));
    v = fmaxf(v, __int_as_float(__builtin_amdgcn_ds_swizzle(__float_as_int(v), (2 << 10) | 0x1f)));
    v = fmaxf(v, __int_as_float(__builtin_amdgcn_ds_swizzle(__float_as_int(v), (4 << 10) | 0x1f)));
    v = fmaxf(v, __int_as_float(__builtin_amdgcn_ds_swizzle(__float_as_int(v), (8 << 10) | 0x1f)));
    v = fmaxf(v, __int_as_float(__builtin_amdgcn_ds_swizzle(__float_as_int(v), (16 << 10) | 0x1f)));
    const auto rr = __builtin_amdgcn_permlane32_swap(__float_as_uint(v), __float_as_uint(v), false, false);
    return fmaxf(__uint_as_float(rr[0]), __uint_as_float(rr[1]));
}
__device__ __forceinline__ float lane_bcast(float v, int srclane  ) { return __uint_as_float(__builtin_amdgcn_readlane(__float_as_uint(v), srclane)); }
__device__ __forceinline__ float silu_f(float v) { return v / (1.f + expf(-v)); }

#define WSP(T, off) ((T*)(p.ws + (off)))
template <class PT> __device__ __forceinline__ float* xrow_ptr(const PT& p, int row) { return row < NLAT ? p.out + (size_t)row * DM : WSP(float, O_XC) + (size_t)(row - NLAT) * DM; }
template <class PT> __device__ __forceinline__ const float* mod_ptr(const PT& p, int layer, int bv, int chunk) { return WSP(const float, O_MOD) + ((size_t)(layer * 9 + bv) * 6 + chunk) * 1024; }
struct RowInfo { int b, t, isctx, bv, key; };
__device__ __forceinline__ RowInfo row_info(int row) {
    RowInfo r;
    if (row < NLAT) { r.b = row >> 12; r.t = row & 4095; r.isctx = 0; r.bv = r.b; r.key = 256 + r.t; }
    else { const int q = row - NLAT; r.b = q >> 8; r.t = q & 255; r.isctx = 1; r.bv = 8; r.key = r.t; }
    return r;
}

__constant__ float ROPE_INV8[8] = {1.f, 0.31622776601683794f, 0.1f, 0.031622776601683794f, 0.01f, 0.0031622776601683794f, 0.001f, 0.00031622776601683794f};
__constant__ float ROPE_INV16[16] = {1.f, 0.5623413251903491f, 0.31622776601683794f, 0.1778279410038923f, 0.1f, 0.05623413251903491f, 0.031622776601683794f, 0.01778279410038923f,
                                     0.01f, 0.005623413251903491f, 0.0031622776601683794f, 0.001778279410038923f, 0.001f, 0.0005623413251903491f, 0.00031622776601683794f, 0.0001778279410038923f};
__device__ __forceinline__ void sincos_acc(float ang, float& s, float& c) {
    float rev = ang * 0.15915494309189535f;
    rev -= floorf(rev);
    s = __builtin_amdgcn_sinf(rev); c = __builtin_amdgcn_cosf(rev);
}

__device__ __forceinline__ void st_mods(char* smem) {
    STAGE_PARAMS();
    float* sv = (float*)smem;
    float* red = sv + 9 * 1024;
    const int tid = tid_;
    if (bid_ == 0 && tid < 16) { const int l = tid >> 3, dir = (tid >> 2) & 1, h = tid & 3;
        const double dec = (double)(dir ? p.ret_decay_b : p.ret_decay_f)[l * 4 + h];
        WSP(float, O_RETLG)[tid] = (float)(log1p(-exp2(dec)) * 1.4426950408889634); }
    for (int i = tid; i < 9 * 1024; i += 512) { const int v = i >> 10, k = i & 1023; const float c = v < 8 ? p.c[v * 1024 + k] : p.c_ctx[k]; sv[i] = silu_f(c); }
    __syncthreads();
    for (int item = bid_; item < 2 * 96; item += G_) {
        const int l = item / 96, j0 = (item % 96) * 64, col = tid & 63, kq = tid >> 6;
        float acc[9];
#pragma unroll
        for (int v = 0; v < 9; ++v) acc[v] = 0.f;
        const float* W = p.ada_w + (size_t)l * 1024 * 6144 + j0 + col;
        for (int k = kq * 128; k < kq * 128 + 128; ++k) {
            const float w = W[(size_t)k * 6144];
#pragma unroll
            for (int v = 0; v < 9; ++v) acc[v] += sv[v * 1024 + k] * w;
        }
#pragma unroll
        for (int v = 0; v < 9; ++v) red[(kq * 9 + v) * 64 + col] = acc[v];
        __syncthreads();
        for (int i = tid; i < 576; i += 512) {
            const int v = i >> 6, cc = i & 63; float s = 0.f;
#pragma unroll
            for (int q = 0; q < 8; ++q) s += red[(q * 9 + v) * 64 + cc];
            WSP(float, O_MOD)[(size_t)(l * 9 + v) * 6144 + j0 + cc] = s + p.ada_b[l * 6144 + j0 + cc];
        }
        __syncthreads();
    }
}

__device__ __forceinline__ void st_rownorm(int mode) {
    STAGE_PARAMS();
    typedef float f32x4v __attribute__((ext_vector_type(4)));
    const int lane = tid_ & 63, wave = tid_ >> 6;
    const int gw = bid_ * 8 + wave, NGW = G_ * 8;
    const int nrows = mode == 2 ? NLAT : NROWS;
    f32x4v vn[4]; uint4 sn0 = make_uint4(0u, 0u, 0u, 0u), sn1 = sn0;
#define RN_SRC(r) (mode == 0 ? ((r) >= NLAT ? p.ctx + (size_t)((r) - NLAT) * DM : p.x + (size_t)(r) * DM) : (const float*)xrow_ptr(p, (r)))
    if (gw < nrows) { const float* src = RN_SRC(gw);
#pragma unroll
        for (int j = 0; j < 4; ++j) vn[j] = ((const f32x4v*)src)[lane + 64 * j];
        if (mode != 0) { const uint4* sl = (const uint4*)(WSP(const short, O_SLOT) + (size_t)gw * 16); sn0 = sl[0]; sn1 = sl[1]; } }
    for (int row = gw; row < nrows; row += NGW) {
        const RowInfo ri = row_info(row);
        f32x4v v[4];
#pragma unroll
        for (int j = 0; j < 4; ++j) v[j] = vn[j];
        const unsigned sw[8] = {sn0.x, sn0.y, sn0.z, sn0.w, sn1.x, sn1.y, sn1.z, sn1.w};
        const int nrow = row + NGW;
        if (nrow < nrows) { const float* src = RN_SRC(nrow);
#pragma unroll
            for (int j = 0; j < 4; ++j) vn[j] = ((const f32x4v*)src)[lane + 64 * j];
            if (mode != 0) { const uint4* sl = (const uint4*)(WSP(const short, O_SLOT) + (size_t)nrow * 16); sn0 = sl[0]; sn1 = sl[1]; } }
        f32x4v pg5[4], pg1[4], psc[4], psh[4];
        {   const float* g5p = mode != 0 ? mod_ptr(p, mode - 1, ri.bv, 5) : p.final_g;
            const float* g1p = mode == 2 ? p.final_g : p.norm1_g + mode * 1024;
            const float* shp = mode == 2 ? p.final_g : mod_ptr(p, mode, ri.bv, 0); const float* scp = mode == 2 ? p.final_g : mod_ptr(p, mode, ri.bv, 1);
#pragma unroll
            for (int j = 0; j < 4; ++j) { if (mode != 0) pg5[j] = ((const f32x4v*)g5p)[lane + 64 * j]; pg1[j] = ((const f32x4v*)g1p)[lane + 64 * j];
                if (mode != 2) { psc[j] = ((const f32x4v*)scp)[lane + 64 * j]; psh[j] = ((const f32x4v*)shp)[lane + 64 * j]; } } }
        __builtin_amdgcn_sched_barrier(0);
        if (mode != 0) {
            const int lprev = mode - 1;
            f32x4v a[4];
#pragma unroll
            for (int j = 0; j < 4; ++j) a[j] = (f32x4v){0.f, 0.f, 0.f, 0.f};
#pragma unroll
            for (int g8 = 0; g8 < 4; ++g8) {
                uint2 yb[4][4];
#pragma unroll
                for (int k = 0; k < 4; ++k) { const int e = 4 * g8 + k;
                    const int s = (int)(short)((e & 1) ? (sw[e >> 1] >> 16) : (sw[e >> 1] & 0xffffu));
                    if (s >= 0) {
                        const bf16_t* yr = ri.isctx ? WSP(const bf16_t, O_YSC) + ((size_t)e * 256 + ri.b * 32 + s) * 1024
                                                    : WSP(const bf16_t, O_YS) + ((size_t)(ri.b * 16 + e) * 512 + s) * 1024;
#pragma unroll
                        for (int j = 0; j < 4; ++j) yb[k][j] = ((const uint2*)yr)[lane + 64 * j];
                    } }
                __builtin_amdgcn_sched_barrier(0);
#pragma unroll
                for (int k = 0; k < 4; ++k) { const int e = 4 * g8 + k;
                    const int s = (int)(short)((e & 1) ? (sw[e >> 1] >> 16) : (sw[e >> 1] & 0xffffu));
                    if (s >= 0) {
#pragma unroll
                        for (int j = 0; j < 4; ++j) { const uint2 u = yb[k][j]; a[j].x += bflo(u.x); a[j].y += bfhi(u.x); a[j].z += bflo(u.y); a[j].w += bfhi(u.y); }
                    } }
            }
            float* dst = xrow_ptr(p, row);
#pragma unroll
            for (int j = 0; j < 4; ++j) {
                v[j] += pg5[j] * a[j];
                if (mode == 1) ((f32x4v*)dst)[lane + 64 * j] = v[j];
            }
        }
        float ss = 0.f;
#pragma unroll
        for (int j = 0; j < 4; ++j) ss += v[j].x * v[j].x + v[j].y * v[j].y + v[j].z * v[j].z + v[j].w * v[j].w;
        ss = wave_sum(ss);
        const float rstd = rsqrtf(ss * (1.f / 1024.f) + 1e-6f);
        if (mode == 2) {
#pragma unroll
            for (int j = 0; j < 4; ++j) ((f32x4v*)(p.out + (size_t)row * DM))[lane + 64 * j] = v[j] * rstd * pg1[j];
        } else {
            const int layer = mode;
            bf16_t* hx = WSP(bf16_t, O_HX) + (size_t)row * DM;
#pragma unroll
            for (int j = 0; j < 4; ++j) {
                const f32x4v h = v[j] * rstd * pg1[j] * (psc[j] + 1.f) + psh[j];
                ((uint2*)hx)[lane + 64 * j] = make_uint2(pk2(h.x, h.y), pk2(h.z, h.w));
            }
        }
    }
#undef RN_SRC
}

__device__ __forceinline__ int opq(int v) { asm volatile("" : "+v"(v)); return v; }


__device__ __forceinline__ void st_norm2_router(int layer, char* smem) {
    STAGE_PARAMS();
    typedef float f32x4v __attribute__((ext_vector_type(4)));
    typedef short bf16x8v __attribute__((ext_vector_type(8)));
    typedef unsigned u32x4v __attribute__((ext_vector_type(4)));
    LAS unsigned char* lds = (LAS unsigned char*)(LAS char*)smem;
    constexpr int WS = 2064;
    LAS unsigned short* whi = (LAS unsigned short*)lds; LAS unsigned short* wlo = (LAS unsigned short*)(lds + 16 * WS);
    LAS float* gg = (LAS float*)(lds + 32 * WS); LAS float* s4 = gg + 1024;
    const int tid = tid_, lane = tid & 63, wave = tid >> 6, r16 = lane & 15, kg = lane >> 4;
    const int nrows = layer == 0 ? NROWS : NLAT;
    { const float* RW = p.router_w + (size_t)layer * 1024 * 16;
      for (int i = tid; i < 1024 * 16; i += 512) { const float w = RW[i]; const unsigned hi = f2bf(w); const unsigned lo = f2bf(w - __uint_as_float(hi << 16));
          whi[(i & 15) * (WS / 2) + (i >> 4)] = (unsigned short)hi; wlo[(i & 15) * (WS / 2) + (i >> 4)] = (unsigned short)lo; } }
    const float* g2 = p.norm2_g + layer * 1024;
    for (int chunk = bid_; chunk < nrows / 128; chunk += G_) {
        const int row0 = chunk * 128; const RowInfo ri = row_info(row0);
        __syncthreads();
        { const float* sh = mod_ptr(p, layer, ri.bv, 3); const float* sc = mod_ptr(p, layer, ri.bv, 4);
          for (int i = tid; i < 1024; i += 512) { gg[i] = g2[i] * (1.f + sc[i]); s4[i] = sh[i]; } }
        __syncthreads();
        const int row = row0 + wave * 16 + r16;
        const f32x4v* xr = (const f32x4v*)xrow_ptr(p, row) + 2 * kg;
        float ss;
        { const float* sq = WSP(const float, O_SSQ) + (size_t)(4 * kg) * NROWS + row; ss = (sq[0] + sq[NROWS]) + (sq[2 * (size_t)NROWS] + sq[3 * (size_t)NROWS]); }
        ss += __int_as_float(__builtin_amdgcn_ds_swizzle(__float_as_int(ss), (16 << 10) | 0x1f));
        { const auto rr = __builtin_amdgcn_permlane32_swap(__float_as_uint(ss), __float_as_uint(ss), false, false); ss = __uint_as_float(rr[0]) + __uint_as_float(rr[1]); }
        const float rstd = rsqrtf(ss * (1.f / 1024.f) + 1e-6f);
        bf16_t* h2 = WSP(bf16_t, O_HX) + (size_t)row * DM + 8 * kg;
        const LAS unsigned char* wb = lds + r16 * WS + 16 * kg;
        f32x4v acc = (f32x4v){0.f, 0.f, 0.f, 0.f};
        f32x4v xa[4], xb[4];
#pragma unroll
        for (int j = 0; j < 4; ++j) { xa[j] = xr[8 * j]; xb[j] = xr[8 * j + 1]; }
#pragma unroll 1
        for (int sg = 0; sg < 32; sg += 4) {
          f32x4v ca[4], cb[4];
#pragma unroll
          for (int j = 0; j < 4; ++j) { ca[j] = xa[j]; cb[j] = xb[j]; }
          if (sg + 4 < 32) {
#pragma unroll
              for (int j = 0; j < 4; ++j) { xa[j] = xr[8 * (sg + 4 + j)]; xb[j] = xr[8 * (sg + 4 + j) + 1]; } }
          __builtin_amdgcn_sched_barrier(0);
#pragma unroll
          for (int j = 0; j < 4; ++j) {
            const int s = sg + j;
            const f32x4v a = ca[j], b = cb[j];
            const f32x4v ga = *(const LAS f32x4v*)(gg + 32 * s + 8 * kg), gb = *(const LAS f32x4v*)(gg + 32 * s + 8 * kg + 4), sa = *(const LAS f32x4v*)(s4 + 32 * s + 8 * kg), sb = *(const LAS f32x4v*)(s4 + 32 * s + 8 * kg + 4);
            const f32x4v ha = a * rstd * ga + sa, hb = b * rstd * gb + sb;
            u32x4v hi, lo;
            hi.x = pk2(ha.x, ha.y); hi.y = pk2(ha.z, ha.w); hi.z = pk2(hb.x, hb.y); hi.w = pk2(hb.z, hb.w);
            lo.x = pk2(ha.x - bflo(hi.x), ha.y - bfhi(hi.x)); lo.y = pk2(ha.z - bflo(hi.y), ha.w - bfhi(hi.y));
            lo.z = pk2(hb.x - bflo(hi.z), hb.y - bfhi(hi.z)); lo.w = pk2(hb.z - bflo(hi.w), hb.w - bfhi(hi.w));
            *(u32x4v*)(h2 + 32 * s) = hi;
            const bf16x8v wh = *(const LAS bf16x8v*)(wb + 64 * s), wl = *(const LAS bf16x8v*)(wb + 16 * WS + 64 * s);
            const bf16x8v hiv = __builtin_bit_cast(bf16x8v, hi), lov = __builtin_bit_cast(bf16x8v, lo);
            acc = __builtin_amdgcn_mfma_f32_16x16x32_bf16(hiv, wh, acc, 0, 0, 0);
            acc = __builtin_amdgcn_mfma_f32_16x16x32_bf16(hiv, wl, acc, 0, 0, 0);
            acc = __builtin_amdgcn_mfma_f32_16x16x32_bf16(lov, wh, acc, 0, 0, 0);
          }
        }
#pragma unroll
        for (int q = 0; q < 4; ++q) {
            float mx = acc[q];
            mx = fmaxf(mx, __int_as_float(__builtin_amdgcn_ds_swizzle(__float_as_int(mx), (1 << 10) | 0x1f)));
            mx = fmaxf(mx, __int_as_float(__builtin_amdgcn_ds_swizzle(__float_as_int(mx), (2 << 10) | 0x1f)));
            mx = fmaxf(mx, __int_as_float(__builtin_amdgcn_ds_swizzle(__float_as_int(mx), (4 << 10) | 0x1f)));
            mx = fmaxf(mx, __int_as_float(__builtin_amdgcn_ds_swizzle(__float_as_int(mx), (8 << 10) | 0x1f)));
            const float ex = expf(acc[q] - mx);
            float sm = ex;
            sm += __int_as_float(__builtin_amdgcn_ds_swizzle(__float_as_int(sm), (1 << 10) | 0x1f));
            sm += __int_as_float(__builtin_amdgcn_ds_swizzle(__float_as_int(sm), (2 << 10) | 0x1f));
            sm += __int_as_float(__builtin_amdgcn_ds_swizzle(__float_as_int(sm), (4 << 10) | 0x1f));
            sm += __int_as_float(__builtin_amdgcn_ds_swizzle(__float_as_int(sm), (8 << 10) | 0x1f));
            WSP(float, O_AFF)[(size_t)(row0 + wave * 16 + 4 * kg + q) * 16 + r16] = ex / sm;
        }
    }
    __syncthreads();
}

__device__ __forceinline__ void st_topk(int layer, char* smem) {
    STAGE_PARAMS();
    float* wcnt = (float*)smem;
    unsigned* wsum = (unsigned*)(wcnt + 24);
    const int tid = tid_, lane = tid & 63, wave = tid >> 6;
    const int nprob = layer == 0 ? 256 : 128;
    const float* AFF = WSP(const float, O_AFF);
    for (int pr = bid_; pr < nprob; pr += G_) {
        const bool isctx = pr >= 128; const int be = pr & 127, b = be >> 4, e = be & 15;
        const int n = isctx ? CTXL : SEQ, kk = isctx ? CAPC : CAP;
        const size_t row0 = isctx ? (size_t)NLAT + b * CTXL : (size_t)b * SEQ;
        unsigned kx[8];
#pragma unroll
        for (int u = 0; u < 8; ++u) { const int t = tid * 8 + u; kx[u] = (t < n) ? __float_as_uint(AFF[(row0 + t) * 16 + e]) : 0u; }
        __syncthreads();
        unsigned T = 0u; int par = 0;
        for (int bit = 29; bit >= -1; --bit) {
            const unsigned cand = bit >= 0 ? (T | (1u << bit)) : T + 1u;
            float c = 0.f;
#pragma unroll
            for (int u = 0; u < 8; ++u) c += (kx[u] >= cand) ? 1.f : 0.f;
            c = wave_sum(c);
            if (lane == 0) wcnt[par * 8 + wave] = c;
            __syncthreads();
            float tot = 0.f;
#pragma unroll
            for (int w = 0; w < 8; ++w) tot += wcnt[par * 8 + w];
            par ^= 1;
            if (bit >= 0) { if (tot >= (float)kk) T = cand; }
            else wcnt[16 + 0] = tot;
        }
        __syncthreads();
        const int krem = kk - (int)wcnt[16];
        unsigned cg = 0u, ce = 0u;
#pragma unroll
        for (int u = 0; u < 8; ++u) { cg += (kx[u] > T) ? 1u : 0u; ce += (kx[u] == T) ? 1u : 0u; }
        const unsigned packed = cg | (ce << 16);
        unsigned incl = packed;
#pragma unroll
        for (int o = 1; o < 64; o <<= 1) { const unsigned t2 = (unsigned)__builtin_amdgcn_ds_bpermute(((lane - o) & 63) << 2, (int)incl); if (lane >= o) incl += t2; }
        if (lane == 63) wsum[wave] = incl;
        __syncthreads();
        unsigned off = 0u;
        for (int w = 0; w < wave; ++w) off += wsum[w];
        const unsigned excl = incl - packed + off;
        unsigned gpre = excl & 0xFFFFu, epre = excl >> 16;
        int* IDX = isctx ? WSP(int, O_IDXC) + e * 256 + b * CAPC : WSP(int, O_IDX) + be * CAP;
        float* GT = isctx ? WSP(float, O_GATEC) + e * 256 + b * CAPC : WSP(float, O_GATE) + be * CAP;
        short* SL = WSP(short, O_SLOT);
#pragma unroll
        for (int u = 0; u < 8; ++u) {
            const int t = tid * 8 + u;
            if (t < n) {
                const unsigned k = kx[u]; const bool g = k > T, eq = k == T;
                const bool sel = g || (eq && (int)epre < krem);
                const int slot = (int)gpre + ((int)epre < krem ? (int)epre : krem);
                if (sel) { IDX[slot] = (int)row0 + t; GT[slot] = __uint_as_float(k); }
                SL[(row0 + t) * 16 + e] = sel ? (short)slot : (short)-1;
                gpre += g ? 1u : 0u; epre += eq ? 1u : 0u;
            }
        }
        __syncthreads();
    }
}


namespace pg {
typedef short bf16x8 __attribute__((ext_vector_type(8)));
typedef float f32x4 __attribute__((ext_vector_type(4)));
typedef unsigned u32x4 __attribute__((ext_vector_type(4)));
constexpr int BM = 256, BK = 64, HALF = 128, HTB = HALF * BK * 2, STAGE_BYTES = 8 * HTB;
__device__ __forceinline__ int lds_byte(int r, int c) { const int st = (r >> 4) * 2 + (c >> 5), rr = r & 15, cc = c & 31, ob = rr * 64 + cc * 2; return st * 1024 + (ob ^ (((ob >> 9) & 1) << 5)); }
__device__ __forceinline__ void stage_rc(int b, int& R, int& C) { const int st = b / 1024, sb = b % 1024, swz = sb ^ (((sb >> 9) & 1) << 5); R = (st >> 1) * 16 + swz / 64; C = (st & 1) * 32 + (swz % 64) / 2; }
__device__ __forceinline__ int perm32(int rho) { const int n = rho >> 4, i = rho & 15; return 8 * (i >> 2) + 4 * n + (i & 3); }
__device__ __forceinline__ unsigned cvt_pk_bf16(float lo, float hi) { unsigned r; asm volatile("v_cvt_pk_bf16_f32 %0, %1, %2" : "=v"(r) : "v"(lo), "v"(hi)); return r; }

template <bool GATHER, class Epi, class Sched>
__device__ __forceinline__ void gemm_run(LAS unsigned char* lds, const int K, const Sched& S, const Epi& E, const int tid) {
    typedef typename Sched::Unit Unit;
    const int wid = __builtin_amdgcn_readfirstlane(tid >> 6), lane = tid & 63, wr = wid >> 2, wc = wid & 3, fr = lane & 15, fq = lane >> 4;
    const int nt = K / BK;
    int Rs[2], Cs[2]; unsigned voffB[2], voffA[2];
#pragma unroll
    for (int i = 0; i < 2; ++i) { stage_rc(tid * 16 + i * 8192, Rs[i], Cs[i]); const int Rb = (Rs[i] & ~31) + perm32(Rs[i] & 31); voffB[i] = (unsigned)(Rb * K + Cs[i]) * 2u; voffA[i] = (unsigned)(Rs[i] * K + Cs[i]) * 2u; }
    const size_t kstep = (size_t)(BK * 2);
    const size_t hstepB = (size_t)HALF * K * 2;
    const unsigned ldsw = (unsigned)wid * 1024u;
    const int aoff = lds_byte(wr * 64 + fr, fq * 8), boff = lds_byte(wc * 32 + fr, fq * 8);
#define PG_SA(b, h) (((b) * 2 + (h)) * HTB)
#define PG_SB(b, h) ((4 + (b) * 2 + (h)) * HTB)
#define PG_STAGE_B(bufoff, gbase) do { _Pragma("unroll") for (int _i = 0; _i < 2; ++_i) \
        __builtin_amdgcn_global_load_lds((const unsigned*)((const char*)(gbase) + voffB[_i]), (LAS unsigned*)(lds + (bufoff) + ldsw + _i * 8192), 16, 0, 0); } while (0)
#define PG_GLDS(src_, dst_) __builtin_amdgcn_global_load_lds((const unsigned*)(src_), (LAS unsigned*)(dst_), 16, 0, 0)
#define PG_STAGE_A(bufoff, gbase, h, NXT) do { \
        if constexpr (GATHER) { if (NXT) { PG_GLDS((const char*)(gbase) + ((h) ? on10 : on00), lds + (bufoff) + ldsw); PG_GLDS((const char*)(gbase) + ((h) ? on11 : on01), lds + (bufoff) + ldsw + 8192); } \
                                else     { PG_GLDS((const char*)(gbase) + ((h) ? oc10 : oc00), lds + (bufoff) + ldsw); PG_GLDS((const char*)(gbase) + ((h) ? oc11 : oc01), lds + (bufoff) + ldsw + 8192); } } \
        else { PG_GLDS((const char*)(gbase) + (size_t)(h) * hstepB + voffA[0], lds + (bufoff) + ldsw); PG_GLDS((const char*)(gbase) + (size_t)(h) * hstepB + voffA[1], lds + (bufoff) + ldsw + 8192); } } while (0)
#define PG_LDA(dst, b, h) do { _Pragma("unroll") for (int m = 0; m < 4; ++m) _Pragma("unroll") for (int k = 0; k < 2; ++k) dst[m][k] = *(const LAS bf16x8*)(lds + PG_SA(b, h) + aoff + m * 2048 + k * 1024); } while (0)
#define PG_LDB(dst, b, h) do { _Pragma("unroll") for (int n = 0; n < 2; ++n) _Pragma("unroll") for (int k = 0; k < 2; ++k) dst[n][k] = *(const LAS bf16x8*)(lds + PG_SB(b, h) + boff + n * 2048 + k * 1024); } while (0)
#define PG_MMA(ai, bj, At, Bt) do { __builtin_amdgcn_s_setprio(1); _Pragma("unroll") for (int m = 0; m < 4; ++m) _Pragma("unroll") for (int n = 0; n < 2; ++n) _Pragma("unroll") for (int k = 0; k < 2; ++k) \
        acc[ai][bj][m][n] = __builtin_amdgcn_mfma_f32_16x16x32_bf16(Bt[n][k], At[m][k], acc[ai][bj][m][n], 0, 0, 0); __builtin_amdgcn_s_setprio(0); } while (0)
#define PG_WAIT_V(n) asm volatile("s_waitcnt vmcnt(" #n ")" ::: "memory")
#define PG_WAIT_L(n) asm volatile("s_waitcnt lgkmcnt(" #n ")" ::: "memory")
#define PG_BAR __builtin_amdgcn_s_barrier()
#define PG_SCHED __builtin_amdgcn_sched_barrier(0)
    Unit cur, nxt; int ui = 0;
    if (!S.next(0, cur)) return;
    f32x4 acc[2][2][4][2];
#pragma unroll
    for (int a = 0; a < 2; ++a)
#pragma unroll
        for (int b = 0; b < 2; ++b)
#pragma unroll
            for (int m = 0; m < 4; ++m)
#pragma unroll
                for (int n = 0; n < 2; ++n) acc[a][b][m][n] = (f32x4){0.f, 0.f, 0.f, 0.f};
    bf16x8 At[4][2], B0[2][2], B1[2][2];
    unsigned oc00 = 0, oc01 = 0, oc10 = 0, oc11 = 0, on00 = 0, on01 = 0, on10 = 0, on11 = 0;
    if constexpr (GATHER) { oc00 = S.a_off(cur, Rs[0]) + (unsigned)Cs[0] * 2u; oc01 = S.a_off(cur, Rs[1]) + (unsigned)Cs[1] * 2u;
        oc10 = S.a_off(cur, HALF + Rs[0]) + (unsigned)Cs[0] * 2u; oc11 = S.a_off(cur, HALF + Rs[1]) + (unsigned)Cs[1] * 2u; }
    const char* cA = S.a_base(cur); const char* cB = S.b_base(cur);
    PG_STAGE_B(PG_SB(0, 0), cB); PG_STAGE_B(PG_SB(0, 1), cB + hstepB); PG_STAGE_A(PG_SA(0, 0), cA, 0, false); PG_STAGE_A(PG_SA(0, 1), cA, 1, false);
    if (wr == 1) PG_BAR;
    PG_WAIT_V(2); PG_BAR;
    PG_STAGE_B(PG_SB(1, 0), cB + kstep); PG_STAGE_A(PG_SA(1, 0), cA + kstep, 0, false); PG_STAGE_B(PG_SB(1, 1), cB + hstepB + kstep);
    PG_WAIT_V(6); PG_BAR;
    int psig = -1;
    for (;;) {
        const bool has_next = S.next(ui + 1, nxt);
        const char* nA = cA; const char* nB = cB;
        if (has_next) { nA = S.a_base(nxt); nB = S.b_base(nxt); }
        for (int t = 0; t < nt; t += 2) {
            const bool last = (t == nt - 2);
            if constexpr (GATHER) { if (last) {
                const Unit& nu = has_next ? nxt : cur;
                on00 = S.a_off(nu, Rs[0]) + (unsigned)Cs[0] * 2u; on01 = S.a_off(nu, Rs[1]) + (unsigned)Cs[1] * 2u;
                on10 = S.a_off(nu, HALF + Rs[0]) + (unsigned)Cs[0] * 2u; on11 = S.a_off(nu, HALF + Rs[1]) + (unsigned)Cs[1] * 2u; } }
            const char* a1 = cA + (size_t)(t + 1) * kstep;
            const char* a2 = last ? nA : cA + (size_t)(t + 2) * kstep; const char* b2 = last ? nB : cB + (size_t)(t + 2) * kstep;
            const char* a3 = a2 + kstep; const char* b3 = b2 + kstep;
            PG_LDB(B0, 0, 0); PG_LDB(B1, 0, 1); PG_SCHED; PG_LDA(At, 0, 0); PG_STAGE_A(PG_SA(1, 1), a1, 1, false);
            PG_WAIT_V(8); PG_WAIT_L(0); PG_BAR; PG_MMA(0, 0, At, B0); PG_MMA(0, 1, At, B1); PG_BAR; PG_SCHED;
            PG_LDA(At, 0, 1); PG_STAGE_B(PG_SB(0, 0), b2); PG_STAGE_B(PG_SB(0, 1), b2 + hstepB); PG_STAGE_A(PG_SA(0, 0), a2, 0, last);
            PG_WAIT_V(8); PG_WAIT_L(0); PG_BAR; PG_MMA(1, 0, At, B0); PG_MMA(1, 1, At, B1); PG_BAR; PG_SCHED;
            PG_LDB(B0, 1, 0); PG_LDB(B1, 1, 1); PG_SCHED; PG_LDA(At, 1, 0); PG_STAGE_A(PG_SA(0, 1), a2, 1, last);
            PG_WAIT_V(8); PG_WAIT_L(0); PG_BAR; PG_MMA(0, 0, At, B0); PG_MMA(0, 1, At, B1); PG_BAR; PG_SCHED;
            PG_LDA(At, 1, 1); PG_STAGE_B(PG_SB(1, 0), b3); PG_STAGE_B(PG_SB(1, 1), b3 + hstepB); PG_STAGE_A(PG_SA(1, 0), a3, 0, last);
            PG_WAIT_V(8); PG_WAIT_L(0); PG_BAR; PG_MMA(1, 0, At, B0); PG_MMA(1, 1, At, B1); PG_BAR; PG_SCHED;
        }
        if (wr == 0) PG_BAR;
        if (psig >= 0) E.signal(psig, lane);
        E(acc, cur, wr, wc, fr, fq);
        psig = __builtin_amdgcn_readfirstlane(E.sig(cur));
        if (!has_next) break;
#pragma unroll
        for (int a = 0; a < 2; ++a)
#pragma unroll
            for (int b = 0; b < 2; ++b)
#pragma unroll
                for (int m = 0; m < 4; ++m)
#pragma unroll
                    for (int n = 0; n < 2; ++n) acc[a][b][m][n] = (f32x4){0.f, 0.f, 0.f, 0.f};
        cur = nxt; cA = nA; cB = nB; if constexpr (GATHER) { oc00 = on00; oc01 = on01; oc10 = on10; oc11 = on11; } ++ui;
        if (wr == 1) PG_BAR;
    }
    PG_WAIT_V(0);
    if (psig >= 0) E.signal(psig, lane);
    PG_BAR;
#undef PG_SA
#undef PG_SB
#undef PG_STAGE_A
#undef PG_GLDS
#undef PG_STAGE_B
#undef PG_LDA
#undef PG_LDB
#undef PG_MMA
#undef PG_WAIT_V
#undef PG_WAIT_L
#undef PG_BAR
#undef PG_SCHED
}
}

__device__ __forceinline__ void transpose_item(const float* W, int K, int N, bf16_t* WT, int row_off, LAS float* scr, int item, int lane) {
    typedef float f32x4v __attribute__((ext_vector_type(4)));
    const int nblk = N / 32, kb = item / nblk, nb = item % nblk, k0 = 64 * kb, n0 = 32 * nb;
    const int kk = lane >> 3, n4 = (lane & 7) * 4;
    f32x4v v[8];
#pragma unroll
    for (int i = 0; i < 8; ++i) v[i] = *(const f32x4v*)(W + (size_t)(k0 + 8 * i + kk) * N + n0 + n4);
#pragma unroll
    for (int i = 0; i < 8; ++i) *(LAS f32x4v*)(scr + (8 * i + kk) * 36 + n4) = v[i];
    asm volatile("s_waitcnt lgkmcnt(0)" ::: "memory");
    const int n = lane & 31;
#pragma unroll
    for (int j = 0; j < 4; ++j) { const int c = (lane >> 5) + 2 * j; const LAS float* s = scr + (8 * c) * 36 + n;
        uint4 o; o.x = pk2(s[0 * 36], s[1 * 36]); o.y = pk2(s[2 * 36], s[3 * 36]); o.z = pk2(s[4 * 36], s[5 * 36]); o.w = pk2(s[6 * 36], s[7 * 36]);
        *(uint4*)(WT + (size_t)(row_off + n0 + n) * K + k0 + 8 * c) = o; }
    asm volatile("s_waitcnt lgkmcnt(0)" ::: "memory");
}
__device__ __forceinline__ void st_prep_weights(int which, int layer, char* smem, int vb, int nb) {
    STAGE_PARAMS();
    if (vb < 0) return;
    const int lane = tid_ & 63, wave = tid_ >> 6;
    LAS float* scr = (LAS float*)(LAS char*)smem + wave * (64 * 36);
    const int gw = vb * 8 + wave, NGW = nb * 8;
    if (which == 0) {
        constexpr int I_IN = 16 * 61, I_OUT = 16 * 32;
        for (int it = gw; it < 2 * (I_IN + I_OUT); it += NGW) {
            const int l = it / (I_IN + I_OUT); int r = it % (I_IN + I_OUT);
            if (r < I_IN) transpose_item(p.w_in + (size_t)l * 1024 * PCOLS, 1024, PCOLS, WSP(bf16_t, O_WINT) + (size_t)l * 2048 * 1024, 0, scr, r, lane);
            else transpose_item(p.w_out + (size_t)l * 1024 * 1024, 1024, 1024, WSP(bf16_t, O_WOUTT) + (size_t)l * 1024 * 1024, 0, scr, r - I_IN, lane);
        }
        for (int it = gw; it < 2 * 640; it += NGW) {
            const int l = it / 640, r = it % 640;
            const float* W; int N, n, s_; bf16_t* dst;
            if (r < 384) { const int f = r, hd = f / 48, nb = (f / 16) % 3; s_ = f % 16; W = p.mla_w_uq + (size_t)l * 256 * 768; N = 768; n = 96 * hd + 32 * nb + (lane & 31); dst = WSP(bf16_t, O_WUQT) + (size_t)l * 768 * 256 + (size_t)f * 512; }
            else { const int f = (r - 384) & 127, hd = f / 16, nb = (f / 8) & 1; s_ = f % 8; const bool isv = r >= 512; W = (isv ? p.mla_w_uv : p.mla_w_uk) + (size_t)l * 128 * 512; N = 512; n = 64 * hd + 32 * nb + (lane & 31);
                dst = WSP(bf16_t, isv ? O_WUVT : O_WUKT) + (size_t)l * 512 * 128 + (size_t)f * 512; }
            const float* src = W + (size_t)(16 * s_ + 8 * (lane >> 5)) * N + n;
            float v[8];
#pragma unroll
            for (int j = 0; j < 8; ++j) v[j] = src[(size_t)j * N];
            *(uint4*)(dst + lane * 8) = make_uint4(pk2(v[0], v[1]), pk2(v[2], v[3]), pk2(v[4], v[5]), pk2(v[6], v[7]));
        }
        for (int i = gw * 64 + lane; i < 2 * 96 * 128; i += NGW * 64) { const int l = i / (96 * 128), r = i % (96 * 128);
            ((uint4*)(WSP(bf16_t, O_WINT) + ((size_t)l * 2048 + 1952) * 1024))[r] = make_uint4(0u, 0u, 0u, 0u); }
    } else {
        constexpr int I_G = 16 * 24, I_D = 12 * 32;
        for (int it = gw; it < 16 * (2 * I_G + I_D); it += NGW) {
            const int e = it / (2 * I_G + I_D); int r = it % (2 * I_G + I_D);
            const size_t le = (size_t)(layer * 16 + e);
            if (r < 2 * I_G) {
                const bool up = r >= I_G; if (up) r -= I_G;
                const int nb = r % 24;
                const int n0 = nb * 32, dst0 = (n0 >> 7) * 256 + (up ? 128 : 0) + (n0 & 127);
                transpose_item((up ? p.exp_w_up : p.exp_w_gate) + le * 1024 * FF, 1024, FF, WSP(bf16_t, O_WGUT) + (size_t)e * 1536 * 1024, dst0 - n0, scr, r, lane);
            } else transpose_item(p.exp_w_down + le * FF * 1024, FF, 1024, WSP(bf16_t, O_WDT) + (size_t)e * 1024 * FF, 0, scr, r - 2 * I_G, lane);
        }
    }
}

__device__ __forceinline__ int vcu_of(int bid, int G) { return (G % 8 == 0) ? (bid % 8) * (G / 8) + bid / 8 : bid; }
struct SchedWin {
    struct Unit { int pm, pn; };
    const char* A; const char* B; int G, c; bool canon;
    __device__ __forceinline__ bool next(int i, Unit& u) const { const int L = i * G + c;
        if (canon && L >= 1024) { if (L >= 1280 || (c & 31) >= 8) return false; u.pm = 128 + (c >> 5); u.pn = c & 7; return true; }
        if (L >= 136 * 8) return false; u.pm = L >> 3; u.pn = L & 7; return true; }
    __device__ __forceinline__ const char* a_base(const Unit& u) const { return A + (size_t)u.pm * 256 * 2048; }
    __device__ __forceinline__ unsigned a_off(const Unit&, int) const { return 0u; }
    __device__ __forceinline__ const char* b_base(const Unit& u) const { return B + (size_t)u.pn * 256 * 2048; }
};
struct EpiWin {
    bf16_t* P; unsigned* dep; bool plain;
    __device__ __forceinline__ void operator()(const pg::f32x4 (&acc)[2][2][4][2], const SchedWin::Unit& u, int wr, int wc, int fr, int fq) const {
        fr = opq(fr); fq = opq(fq);
#pragma unroll
        for (int ai = 0; ai < 2; ++ai)
#pragma unroll
            for (int m = 0; m < 4; ++m) { bf16_t* rowp = P + (size_t)(u.pm * 256 + ai * 128 + wr * 64 + m * 16 + fr) * PLD + u.pn * 256 + wc * 32 + 8 * fq;
#pragma unroll
                for (int bj = 0; bj < 2; ++bj) { const pg::f32x4 v0 = acc[ai][bj][m][0], v1 = acc[ai][bj][m][1];
                    pg::u32x4 w; w.x = pg::cvt_pk_bf16(v0[0], v0[1]); w.y = pg::cvt_pk_bf16(v0[2], v0[3]); w.z = pg::cvt_pk_bf16(v1[0], v1[1]); w.w = pg::cvt_pk_bf16(v1[2], v1[3]);
                    if (plain) *(pg::u32x4*)(rowp + bj * 128) = w;
                    else asm volatile("global_store_dwordx4 %0, %1, off sc1\n\ts_nop 1" :: "v"(rowp + bj * 128), "v"(w) : "memory"); } }
    }
    __device__ __forceinline__ int sig(const SchedWin::Unit& u) const { return u.pm * 8; }
    __device__ __forceinline__ void signal(int i, int lane) const { if (lane == 0) __hip_atomic_fetch_add(dep + i, 1u, __ATOMIC_RELAXED, __HIP_MEMORY_SCOPE_AGENT); }
};
__device__ __forceinline__ void st_gemm_win_fast(int layer, char* smem, bool canon) {
    STAGE_PARAMS();
    SchedWin S{(const char*)WSP(bf16_t, O_HX), (const char*)(WSP(bf16_t, O_WINT) + (size_t)layer * 2048 * 1024), G_, vcu_of(bid_, G_), canon};
    EpiWin E{WSP(bf16_t, O_P), WSP(unsigned, O_DEPW) + layer * 136 * 8, canon};
    pg::gemm_run<false>((LAS unsigned char*)(LAS char*)smem, 1024, S, E, tid_);
}
struct SchedWout {
    struct Unit { int pm, pn; };
    const char* A; const char* B; int G, c, nunits;
    __device__ __forceinline__ bool next(int i, Unit& u) const { const int L = i * G + c; if (L >= nunits) return false; u.pm = L >> 2; u.pn = L & 3; return true; }
    __device__ __forceinline__ const char* a_base(const Unit& u) const { return A + (size_t)u.pm * 256 * 2048; }
    __device__ __forceinline__ unsigned a_off(const Unit&, int) const { return 0u; }
    __device__ __forceinline__ const char* b_base(const Unit& u) const { return B + (size_t)u.pn * 256 * 2048; }
};
struct EpiWout {
    const float* xin_lat; const float* xin_ctx; float* xo_lat; float* xo_ctx; const float* mod2; LAS float* stage; float* ssq;
    __device__ __forceinline__ void operator()(const pg::f32x4 (&acc)[2][2][4][2], const SchedWout::Unit& u, int wr, int wc, int fr, int fq) const {
        fr = opq(fr); fq = opq(fq);
        const bool isctx = u.pm >= 128; const int bv = isctx ? 8 : (u.pm >> 4);
        const float* xin = isctx ? xin_ctx + (size_t)(u.pm - 128) * 256 * DM : xin_lat + (size_t)u.pm * 256 * DM;
        float* xo = isctx ? xo_ctx + (size_t)(u.pm - 128) * 256 * DM : xo_lat + (size_t)u.pm * 256 * DM;
        const float* g = mod2 + (size_t)bv * 6144 + u.pn * 256 + wc * 32 + 8 * fq;
        pg::f32x4 gv[2][2];
#pragma unroll
        for (int bj = 0; bj < 2; ++bj)
#pragma unroll
            for (int n = 0; n < 2; ++n) gv[bj][n] = *(const pg::f32x4*)(g + bj * 128 + 4 * n);
        LAS float* st = stage + (wr * 4 + wc) * 576;
        const int lane = fr + 16 * fq, sr = lane >> 3, sc = (lane & 7) * 4;
#pragma unroll
        for (int ai = 0; ai < 2; ++ai)
        {
            pg::f32x4 xs[4][2][2];
#pragma unroll
            for (int m = 0; m < 4; ++m)
#pragma unroll
                for (int bj = 0; bj < 2; ++bj) { const size_t off = (size_t)(ai * 128 + wr * 64 + m * 16) * DM + u.pn * 256 + wc * 32 + bj * 128;
                    xs[m][bj][0] = *(const pg::f32x4*)(xin + off + (size_t)sr * DM + sc); xs[m][bj][1] = *(const pg::f32x4*)(xin + off + (size_t)(sr + 8) * DM + sc); }
            __builtin_amdgcn_sched_barrier(0);
#pragma unroll
            for (int m = 0; m < 4; ++m) {
                float q0 = 0.f, q1 = 0.f;
#pragma unroll
                for (int bj = 0; bj < 2; ++bj) {
                    const size_t off = (size_t)(ai * 128 + wr * 64 + m * 16) * DM + u.pn * 256 + wc * 32 + bj * 128;
                    *(LAS pg::f32x4*)(st + fr * 36 + 8 * fq) = gv[bj][0] * acc[ai][bj][m][0];
                    *(LAS pg::f32x4*)(st + fr * 36 + 8 * fq + 4) = gv[bj][1] * acc[ai][bj][m][1];
                    const pg::f32x4 x0 = xs[m][bj][0], x1 = xs[m][bj][1];
                    asm volatile("s_waitcnt lgkmcnt(0)" ::: "memory");
                    const pg::f32x4 r0 = x0 + *(const LAS pg::f32x4*)(st + sr * 36 + sc), r1 = x1 + *(const LAS pg::f32x4*)(st + (sr + 8) * 36 + sc);
                    *(pg::f32x4*)(xo + off + (size_t)sr * DM + sc) = r0;
                    *(pg::f32x4*)(xo + off + (size_t)(sr + 8) * DM + sc) = r1;
                    q0 += r0[0] * r0[0] + r0[1] * r0[1] + r0[2] * r0[2] + r0[3] * r0[3]; q1 += r1[0] * r1[0] + r1[1] * r1[1] + r1[2] * r1[2] + r1[3] * r1[3];
                    asm volatile("s_waitcnt lgkmcnt(0)" ::: "memory");
                }
#define EW_RED(x_) q0 += __int_as_float(__builtin_amdgcn_ds_swizzle(__float_as_int(q0), ((x_) << 10) | 0x1f)); q1 += __int_as_float(__builtin_amdgcn_ds_swizzle(__float_as_int(q1), ((x_) << 10) | 0x1f));
                EW_RED(1) EW_RED(2) EW_RED(4)
#undef EW_RED
                if ((lane & 7) == 0) { float* d = ssq + (size_t)(u.pn * 4 + wc) * NROWS + u.pm * 256 + ai * 128 + wr * 64 + m * 16 + sr; d[0] = q0; d[8] = q1; }
            }
        }
    }
    __device__ __forceinline__ int sig(const SchedWout::Unit&) const { return -1; }
    __device__ __forceinline__ void signal(int, int) const {}
};
__device__ __forceinline__ void st_gemm_wout_fast(int layer, char* smem) {
    STAGE_PARAMS();
    SchedWout S{(const char*)WSP(bf16_t, O_HX), (const char*)(WSP(bf16_t, O_WOUTT) + (size_t)layer * 1024 * 1024), G_, vcu_of(bid_, G_), (layer == 0 ? 136 : 128) * 4};
    EpiWout E{layer == 0 ? p.x : p.out, layer == 0 ? p.ctx : WSP(float, O_XC), p.out, WSP(float, O_XC), WSP(float, O_MOD) + (size_t)layer * 9 * 6144 + 2 * 1024, (LAS float*)((LAS char*)smem + 131072), WSP(float, O_SSQ)};
    pg::gemm_run<false>((LAS unsigned char*)(LAS char*)smem, 1024, S, E, tid_);
}
struct SchedMoeUp {
    struct Unit { int be, pm, pn, isctx; };
    const char* H2; const char* B; const int* idx; const int* idxc; int G, c, nunits;
    __device__ __forceinline__ bool next(int i, Unit& u) const { const int L = i * G + c; if (L >= nunits) return false;
        const bool ic = L >= 1536; const int q = ic ? L - 1536 : L; const int r = ic ? q % 6 : q % 12;
        const int i12 = q / 12;
        u.be = ic ? q / 6 : (i12 & 7) * 16 + (i12 >> 3); u.pm = ic ? 0 : r / 6; u.pn = r % 6; u.isctx = ic ? 1 : 0; return true; }
    __device__ __forceinline__ const char* a_base(const Unit&) const { return H2; }
    __device__ __forceinline__ unsigned a_off(const Unit& u, int r) const { const int* ri = u.isctx ? idxc + u.be * 256 : idx + u.be * CAP + u.pm * 256; return (unsigned)ri[r] * 2048u; }
    __device__ __forceinline__ const char* b_base(const Unit& u) const { return B + ((size_t)(u.isctx ? u.be : (u.be & 15)) * 1536 + (size_t)u.pn * 256) * 2048; }
};
struct EpiMoeUp {
    bf16_t* hid; bf16_t* hidc;
    __device__ __forceinline__ void operator()(const pg::f32x4 (&acc)[2][2][4][2], const SchedMoeUp::Unit& u, int wr, int wc, int fr, int fq) const {
        fr = opq(fr); fq = opq(fq);
        bf16_t* base = u.isctx ? hidc + (size_t)u.be * 256 * FF : hid + ((size_t)u.be * CAP + u.pm * 256) * FF;
#pragma unroll
        for (int ai = 0; ai < 2; ++ai)
#pragma unroll
            for (int m = 0; m < 4; ++m) { bf16_t* rowp = base + (size_t)(ai * 128 + wr * 64 + m * 16 + fr) * FF + u.pn * 128 + wc * 32 + 8 * fq;
                float h[8];
#pragma unroll
                for (int n = 0; n < 2; ++n)
#pragma unroll
                    for (int j = 0; j < 4; ++j) { const float gt = acc[ai][0][m][n][j], up = acc[ai][1][m][n][j]; h[n * 4 + j] = gt * __builtin_amdgcn_rcpf(1.f + __builtin_amdgcn_exp2f(-gt * LOG2E)) * up; }
                pg::u32x4 w; w.x = pg::cvt_pk_bf16(h[0], h[1]); w.y = pg::cvt_pk_bf16(h[2], h[3]); w.z = pg::cvt_pk_bf16(h[4], h[5]); w.w = pg::cvt_pk_bf16(h[6], h[7]);
                *(pg::u32x4*)rowp = w; }
    }
    __device__ __forceinline__ int sig(const SchedMoeUp::Unit&) const { return -1; }
    __device__ __forceinline__ void signal(int, int) const {}
};
__device__ __forceinline__ void st_moe_up_fast(int layer, char* smem) {
    STAGE_PARAMS();
    SchedMoeUp S{(const char*)WSP(bf16_t, O_HX), (const char*)WSP(bf16_t, O_WGUT), WSP(const int, O_IDX), WSP(const int, O_IDXC), G_, vcu_of(bid_, G_), 1536 + (layer == 0 ? 96 : 0)};
    EpiMoeUp E{WSP(bf16_t, O_HID), WSP(bf16_t, O_HIDC)};
    pg::gemm_run<true>((LAS unsigned char*)(LAS char*)smem, 1024, S, E, tid_);
}
struct SchedMoeDown {
    struct Unit { int be, pm, pn, isctx; };
    const char* hid; const char* hidc; const char* B; int G, c, nunits;
    __device__ __forceinline__ bool next(int i, Unit& u) const { const int L = i * G + c; if (L >= nunits) return false;
        const bool ic = L >= 1024; const int q = ic ? L - 1024 : L;
        const int i8 = q >> 3;
        u.be = ic ? (q >> 2) : (i8 & 7) * 16 + (i8 >> 3); u.pm = ic ? 0 : ((q & 7) >> 2); u.pn = q & 3; u.isctx = ic ? 1 : 0; return true; }
    __device__ __forceinline__ const char* a_base(const Unit& u) const { return u.isctx ? hidc + (size_t)u.be * 256 * FF * 2 : hid + ((size_t)u.be * CAP + u.pm * 256) * FF * 2; }
    __device__ __forceinline__ unsigned a_off(const Unit&, int r) const { return (unsigned)r * (FF * 2); }
    __device__ __forceinline__ const char* b_base(const Unit& u) const { return B + ((size_t)(u.isctx ? u.be : (u.be & 15)) * 1024 + (size_t)u.pn * 256) * (FF * 2); }
};
struct EpiMoeDown {
    bf16_t* ys; bf16_t* ysc; const float* gate; const float* gatec;
    __device__ __forceinline__ void operator()(const pg::f32x4 (&acc)[2][2][4][2], const SchedMoeDown::Unit& u, int wr, int wc, int fr, int fq) const {
        fr = opq(fr); fq = opq(fq);
        bf16_t* base = u.isctx ? ysc + (size_t)u.be * 256 * DM : ys + ((size_t)u.be * CAP + u.pm * 256) * DM;
        float gvs[2][4];
        { const float* gp = (u.isctx ? gatec + u.be * 256 : gate + u.be * CAP + u.pm * 256) + wr * 64 + fr;
#pragma unroll
          for (int ai = 0; ai < 2; ++ai)
#pragma unroll
              for (int m = 0; m < 4; ++m) gvs[ai][m] = gp[ai * 128 + m * 16]; }
        __builtin_amdgcn_sched_barrier(0);
#pragma unroll
        for (int ai = 0; ai < 2; ++ai)
#pragma unroll
            for (int m = 0; m < 4; ++m) { const int r = ai * 128 + wr * 64 + m * 16 + fr;
                const float gv = gvs[ai][m];
                bf16_t* rowp = base + (size_t)r * DM + u.pn * 256 + wc * 32 + 8 * fq;
#pragma unroll
                for (int bj = 0; bj < 2; ++bj) { const pg::f32x4 v0 = acc[ai][bj][m][0] * gv, v1 = acc[ai][bj][m][1] * gv;
                    pg::u32x4 w; w.x = pg::cvt_pk_bf16(v0[0], v0[1]); w.y = pg::cvt_pk_bf16(v0[2], v0[3]); w.z = pg::cvt_pk_bf16(v1[0], v1[1]); w.w = pg::cvt_pk_bf16(v1[2], v1[3]);
                    *(pg::u32x4*)(rowp + bj * 128) = w; } }
    }
    __device__ __forceinline__ int sig(const SchedMoeDown::Unit&) const { return -1; }
    __device__ __forceinline__ void signal(int, int) const {}
};
__device__ __forceinline__ void st_moe_down_fast(int layer, char* smem) {
    STAGE_PARAMS();
    SchedMoeDown S{(const char*)WSP(bf16_t, O_HID), (const char*)WSP(bf16_t, O_HIDC), (const char*)WSP(bf16_t, O_WDT), G_, vcu_of(bid_, G_), 1024 + (layer == 0 ? 64 : 0)};
    EpiMoeDown E{WSP(bf16_t, O_YS), WSP(bf16_t, O_YSC), WSP(const float, O_GATE), WSP(const float, O_GATEC)};
    pg::gemm_run<false>((LAS unsigned char*)(LAS char*)smem, FF, S, E, tid_);
}

namespace fa {
typedef short bf16x8 __attribute__((ext_vector_type(8)));
typedef short bf16x4 __attribute__((ext_vector_type(4)));
typedef float f32x16 __attribute__((ext_vector_type(16)));
typedef unsigned u32x4 __attribute__((ext_vector_type(4)));
typedef unsigned u32x2 __attribute__((ext_vector_type(2)));
constexpr int VSTRIDE = 136;
__device__ __forceinline__ unsigned cvt_pk(float lo, float hi) { unsigned r; asm volatile("v_cvt_pk_bf16_f32 %0, %1, %2" : "=v"(r) : "v"(lo), "v"(hi)); return r; }
__device__ __forceinline__ float xhalf_max(float v) { const auto rr = __builtin_amdgcn_permlane32_swap(__float_as_uint(v), __float_as_uint(v), false, false); return fmaxf(__uint_as_float(rr[0]), __uint_as_float(rr[1])); }
__device__ __forceinline__ float xhalf_sum(float v) { const auto rr = __builtin_amdgcn_permlane32_swap(__float_as_uint(v), __float_as_uint(v), false, false); return __uint_as_float(rr[0]) + __uint_as_float(rr[1]); }
typedef short s16x4 __attribute__((ext_vector_type(4)));
__device__ __forceinline__ int vtr_st(int k, int c) { return ((k >> 3) * 2 + (c >> 5)) * 512 + ((k & 7) * 32 + (c & 31)) * 2; }
__device__ __forceinline__ int vtr_base(int lane) { return ((lane & 3) << 3) | (((lane >> 2) & 3) << 6) | (((lane >> 4) & 1) << 5) | (((lane >> 5) & 1) << 8); }
constexpr int vtr_off(int d0, int ks, int half) { return d0 * 512 + ks * 2048 + half * 1024; }
template <int OFF> __device__ __forceinline__ u32x2 vtr_read(int vb) { s16x4 r; asm volatile("ds_read_b64_tr_b16 %0, %1 offset:%2" : "=&v"(r) : "v"(vb), "i"(OFF) : "memory"); return __builtin_bit_cast(u32x2, r); }
#define VTR_READ_ALL(va_, vb_) do { \
    va_[0][0] = vtr_read<vtr_off(0, 0, 0)>(vb_); va_[0][1] = vtr_read<vtr_off(0, 0, 1)>(vb_); va_[0][2] = vtr_read<vtr_off(1, 0, 0)>(vb_); va_[0][3] = vtr_read<vtr_off(1, 0, 1)>(vb_); \
    va_[1][0] = vtr_read<vtr_off(0, 1, 0)>(vb_); va_[1][1] = vtr_read<vtr_off(0, 1, 1)>(vb_); va_[1][2] = vtr_read<vtr_off(1, 1, 0)>(vb_); va_[1][3] = vtr_read<vtr_off(1, 1, 1)>(vb_); \
    va_[2][0] = vtr_read<vtr_off(0, 2, 0)>(vb_); va_[2][1] = vtr_read<vtr_off(0, 2, 1)>(vb_); va_[2][2] = vtr_read<vtr_off(1, 2, 0)>(vb_); va_[2][3] = vtr_read<vtr_off(1, 2, 1)>(vb_); \
    va_[3][0] = vtr_read<vtr_off(0, 3, 0)>(vb_); va_[3][1] = vtr_read<vtr_off(0, 3, 1)>(vb_); va_[3][2] = vtr_read<vtr_off(1, 3, 0)>(vb_); va_[3][3] = vtr_read<vtr_off(1, 3, 1)>(vb_); } while (0)

__device__ __forceinline__ float max3f(float a, float b, float c) { float r; asm("v_max3_f32 %0, %1, %2, %3" : "=v"(r) : "v"(a), "v"(b), "v"(c)); return r; }
template <int DQK, bool WIN, bool QS = false, bool VTR = false>
__device__ __forceinline__ void attn_unit(LAS unsigned char* lds, const int tid, const bf16_t* Qp, const int qstride, const bf16_t* Kp, const bf16_t* Vt, const int vt_stride,
                                          const int ntiles, const int nfirst, const int second0, const int qtok0, const float sink_l2, bf16_t* Yp, const int ystride, const float sink_l2b = 0.f, const bf16_t* Vc = nullptr) {
    constexpr int KSTRIDE = DQK * 2 + 16, KCH = DQK / 8, KBUF = 64 * KSTRIDE, VBUF = 64 * VSTRIDE, NKS = DQK / 16;
    constexpr float THR = 8.f;
    const int lane = tid & 63, wave = __builtin_amdgcn_readfirstlane(tid >> 6), q32 = lane & 31, hh = lane >> 5;
    const int wrow = QS ? (wave & 3) * 32 : wave * 32, hoff = QS ? (wave >> 2) * 64 : 0;
    const int kr0 = tid / KCH, kc0 = tid % KCH, kr1 = (tid + 512) / KCH, kc1 = (tid + 512) % KCH; const bool k2 = (tid + 512) < 64 * KCH;
    const int vd = tid >> 3, vc = tid & 7;
    const unsigned kl0 = kr0 * KSTRIDE + kc0 * 16, kl1 = kr1 * KSTRIDE + kc1 * 16, vl = VTR ? vtr_st(vd, vc * 8) : vd * VSTRIDE + vc * 16;
#define FA_KEY0(i) ((i) < nfirst ? 64 * (i) : second0 + 64 * ((i) - nfirst))
    bf16x8 qf[NKS];
    { const bf16_t* qr = Qp + (size_t)(wrow + q32) * qstride + hoff + 8 * hh;
#pragma unroll
      for (int s = 0; s < NKS; ++s) qf[s] = *(const bf16x8*)(qr + 16 * s); }
    f32x16 o0, o1, o2, negm;
#pragma unroll
    for (int r = 0; r < 16; ++r) { o0[r] = 0.f; o1[r] = 0.f; o2[r] = 0.f; negm[r] = 0.f; }
    float mref = 0.f;
    const bf16x8 ones = (bf16x8){16256, 16256, 16256, 16256, 16256, 16256, 16256, 16256};
    u32x4 ak0, ak1 = (u32x4){0u, 0u, 0u, 0u}, av;
#define FA_LOAD(k0_, k1_, v_, ti_) do { const int key0_ = FA_KEY0(ti_); \
        k0_ = *(const u32x4*)(Kp + (size_t)(key0_ + kr0) * DQK + kc0 * 8); if (k2) k1_ = *(const u32x4*)(Kp + (size_t)(key0_ + kr1) * DQK + kc1 * 8); \
        if (VTR) v_ = *(const u32x4*)((key0_ < 256 ? Vc : Vt) + (size_t)(key0_ + vd) * vt_stride + vc * 8); else v_ = *(const u32x4*)(Vt + (size_t)vd * vt_stride + key0_ + vc * 8); } while (0)
#define FA_STORE(k0_, k1_, v_, b_) do { *(LAS u32x4*)(lds + (b_) * KBUF + kl0) = k0_; if (k2) *(LAS u32x4*)(lds + (b_) * KBUF + kl1) = k1_; \
        if (VTR) *(LAS u32x4*)(lds + 2 * KBUF + (b_) * VBUF + vl) = v_; else { *(LAS u32x2*)(lds + 2 * KBUF + (b_) * VBUF + vl) = (u32x2){v_.x, v_.y}; *(LAS u32x2*)(lds + 2 * KBUF + (b_) * VBUF + vl + 8) = (u32x2){v_.z, v_.w}; } } while (0)
#define FA_BAR() do { asm volatile("s_waitcnt lgkmcnt(0)" ::: "memory"); __syncthreads(); } while (0)
    FA_LOAD(ak0, ak1, av, 0);
    FA_BAR();
    FA_STORE(ak0, ak1, av, 0);
    for (int t = 0; t < ntiles; ++t) {
        const int buf = t & 1;
        FA_BAR();
        const bool more = (t + 1) < ntiles;
        if (more) FA_LOAD(ak0, ak1, av, t + 1);
        {
        const int key0 = FA_KEY0(t);
        bool active = true;
        if (WIN) { if ((t) >= nfirst) { const int kt0 = key0 - 256, qw0 = qtok0 + wrow; active = (kt0 <= qw0 + 31 + 128) && (kt0 + 63 >= qw0 - 128); } }
        if (active) {
            const LAS unsigned char* kb = lds + buf * KBUF + q32 * KSTRIDE + 16 * hh;
            const LAS unsigned char* vb = lds + 2 * KBUF + buf * VBUF + q32 * VSTRIDE + 8 * hh;
            bf16x8 kf0[NKS / 2], kf1[NKS / 2];
#pragma unroll
            for (int s = 0; s < NKS / 2; ++s) { kf0[s] = *(const LAS bf16x8*)(kb + 32 * s); kf1[s] = *(const LAS bf16x8*)(kb + 32 * KSTRIDE + 32 * s); }
            __builtin_amdgcn_sched_barrier(0);
            f32x16 p0 = __builtin_amdgcn_mfma_f32_32x32x16_bf16(kf0[0], qf[0], negm, 0, 0, 0), p1 = __builtin_amdgcn_mfma_f32_32x32x16_bf16(kf1[0], qf[0], negm, 0, 0, 0);
#pragma unroll
            for (int s = 1; s < NKS / 2; ++s) {
                p0 = __builtin_amdgcn_mfma_f32_32x32x16_bf16(kf0[s], qf[s], p0, 0, 0, 0);
                p1 = __builtin_amdgcn_mfma_f32_32x32x16_bf16(kf1[s], qf[s], p1, 0, 0, 0);
            }
            __builtin_amdgcn_sched_barrier(0);
#pragma unroll
            for (int s = 0; s < NKS / 2; ++s) { kf0[s] = *(const LAS bf16x8*)(kb + 32 * (s + NKS / 2)); kf1[s] = *(const LAS bf16x8*)(kb + 32 * KSTRIDE + 32 * (s + NKS / 2)); }
            __builtin_amdgcn_sched_barrier(0);
#pragma unroll
            for (int s = 0; s < NKS / 2; ++s) {
                p0 = __builtin_amdgcn_mfma_f32_32x32x16_bf16(kf0[s], qf[s + NKS / 2], p0, 0, 0, 0);
                p1 = __builtin_amdgcn_mfma_f32_32x32x16_bf16(kf1[s], qf[s + NKS / 2], p1, 0, 0, 0);
            }
            u32x2 va[4][4];
            if (VTR) { const int vtb = (int)(unsigned)(size_t)(lds + 2 * KBUF + buf * VBUF) + vtr_base(lane); VTR_READ_ALL(va, vtb); }
            else {
#pragma unroll
            for (int s = 0; s < 4; ++s) { va[s][0] = *(const LAS u32x2*)(vb + 32 * s); va[s][1] = *(const LAS u32x2*)(vb + 32 * s + 16);
                va[s][2] = *(const LAS u32x2*)(vb + 32 * VSTRIDE + 32 * s); va[s][3] = *(const LAS u32x2*)(vb + 32 * VSTRIDE + 32 * s + 16); } }
            __builtin_amdgcn_sched_barrier(0);
            asm volatile("s_nop 15\n\ts_nop 7" : "+v"(p0), "+v"(p1));
            if (WIN) { if ((t) >= nfirst) { const int qi = qtok0 + wrow + q32, kb0 = key0 - 256 + 4 * hh;
#pragma unroll
                for (int r = 0; r < 16; ++r) { const int kj = kb0 + (r & 3) + 8 * (r >> 2); const int d0 = kj - qi, d1 = d0 + 32;
                    if (d0 > 128 || d0 < -128) p0[r] = -1e30f; if (d1 > 128 || d1 < -128) p1[r] = -1e30f; } } }
            float mxa = max3f(p0[0], p0[1], p1[0]), mxb = max3f(p0[2], p0[3], p1[1]); mxa = max3f(mxa, p1[2], p1[3]);
#pragma unroll
            for (int r = 4; r < 16; r += 4) { mxa = max3f(mxa, p0[r], p0[r + 1]); mxb = max3f(mxb, p0[r + 2], p0[r + 3]); mxa = max3f(mxa, p1[r], p1[r + 1]); mxb = max3f(mxb, p1[r + 2], p1[r + 3]); }
            const float mx = xhalf_max(max3f(mxa, mxb, mxb));
            if ((t == 0) || __any(mx > THR)) {
                const float dl = ((t == 0)) ? mx : fmaxf(mx, 0.f), f = __builtin_amdgcn_exp2f(-dl);
                mref += dl; o2[0] *= f;
#pragma unroll
                for (int r = 0; r < 16; ++r) { o0[r] *= f; o1[r] *= f; p0[r] -= dl; p1[r] -= dl; negm[r] = -mref; }
            }
#pragma unroll
            for (int r = 0; r < 16; ++r) { p0[r] = __builtin_amdgcn_exp2f(p0[r]); p1[r] = __builtin_amdgcn_exp2f(p1[r]); }
            {
                float q0 = p0[0] + p1[0], q1 = p0[1] + p1[1], q2 = p0[2] + p1[2], q3 = p0[3] + p1[3];
#pragma unroll
                for (int r = 4; r < 16; r += 4) { q0 += p0[r] + p1[r]; q1 += p0[r + 1] + p1[r + 1]; q2 += p0[r + 2] + p1[r + 2]; q3 += p0[r + 3] + p1[r + 3]; }
                o2[0] += (q0 + q1) + (q2 + q3);
            }
            bf16x8 pf[4];
#pragma unroll
            for (int s = 0; s < 4; ++s) { unsigned w[4];
#pragma unroll
                for (int j = 0; j < 4; ++j) { const int r = 8 * (s & 1) + 2 * j; w[j] = (s < 2) ? cvt_pk(p0[r], p0[r + 1]) : cvt_pk(p1[r], p1[r + 1]); }
                const u32x4 u = (u32x4){w[0], w[1], w[2], w[3]}; pf[s] = __builtin_bit_cast(bf16x8, u); }
            if (VTR) { asm volatile("s_waitcnt lgkmcnt(0)" ::: "memory"); __builtin_amdgcn_sched_barrier(0); }
#pragma unroll
            for (int s = 0; s < 4; ++s) {
                const u32x4 u0 = (u32x4){va[s][0].x, va[s][0].y, va[s][1].x, va[s][1].y}, u1 = (u32x4){va[s][2].x, va[s][2].y, va[s][3].x, va[s][3].y};
                o0 = __builtin_amdgcn_mfma_f32_32x32x16_bf16(__builtin_bit_cast(bf16x8, u0), pf[s], o0, 0, 0, 0);
                o1 = __builtin_amdgcn_mfma_f32_32x32x16_bf16(__builtin_bit_cast(bf16x8, u1), pf[s], o1, 0, 0, 0);
            }
        }
        }
        if (more) FA_STORE(ak0, ak1, av, buf ^ 1);
    }
#undef FA_LOAD
#undef FA_STORE
#undef FA_BAR
#undef FA_KEY0
    float lt = xhalf_sum(o2[0]);
    if (WIN) lt += __builtin_amdgcn_exp2f(((QS && wave >= 4) ? sink_l2b : sink_l2) - mref);
    const float inv = 1.f / lt;
    bf16_t* yr = Yp + (size_t)(wrow + q32) * ystride + hoff + 4 * hh;
#pragma unroll
    for (int g = 0; g < 4; ++g) {
        *(uint2*)(yr + 8 * g) = make_uint2(cvt_pk(o0[4 * g] * inv, o0[4 * g + 1] * inv), cvt_pk(o0[4 * g + 2] * inv, o0[4 * g + 3] * inv));
        *(uint2*)(yr + 32 + 8 * g) = make_uint2(cvt_pk(o1[4 * g] * inv, o1[4 * g + 1] * inv), cvt_pk(o1[4 * g + 2] * inv, o1[4 * g + 3] * inv));
    }
}
}

__device__ __forceinline__ void st_mla_fast(int layer, char* smem) {
    STAGE_PARAMS();
    LAS unsigned char* lds = (LAS unsigned char*)(LAS char*)smem;
    const int c = vcu_of(bid_, G_);
    const int nunits = 1024 + (layer == 0 ? 64 : 0);
    const bf16_t* QM = WSP(const bf16_t, O_QM); const bf16_t* KM = WSP(const bf16_t, O_KM); const bf16_t* VT = WSP(const bf16_t, O_VT); bf16_t* Y = WSP(bf16_t, O_HX);
    if (tid_ >= 256) __builtin_amdgcn_s_setprio(1);
    for (int L = c; L < nunits; L += G_) {
        int bh, row0, ntiles;
        if (L < 1024) { bh = L >> 4; row0 = (bh >> 3) * SEQ + (L & 15) * 256; ntiles = NKEYS / 64; }
        else { bh = L - 1024; row0 = NLAT + (bh >> 3) * CTXL; ntiles = CTXL / 64; }
        const int h = bh & 7;
        fa::attn_unit<96, false>(lds, tid_, QM + ((size_t)row0 * 8 + h) * 96, 768, KM + (size_t)bh * NKEYS * 96, VT + (size_t)bh * 64 * NKEYS, NKEYS,
                                 ntiles, ntiles, 0, 0, 0.f, Y + (size_t)row0 * DM + 256 + h * 64, DM);
    }
    __builtin_amdgcn_s_setprio(0);
}

template <int NC>
__device__ __forceinline__ void tile_transpose(const bf16_t* P, int row0, int c0, bf16_t* dst, int NH, int b, int key0, LAS unsigned short* scr, int tid) {
    constexpr int LDW = NC + 2;
    for (int id = tid; id < 64 * (NC / 8); id += 512) { const int r = id / (NC / 8), ch = id % (NC / 8);
        const uint4 u = *(const uint4*)(P + (size_t)(row0 + r) * PLD + c0 + ch * 8);
        LAS unsigned* d = (LAS unsigned*)(scr + r * LDW + ch * 8); d[0] = u.x; d[1] = u.y; d[2] = u.z; d[3] = u.w; }
    __syncthreads();
    for (int id = tid; id < NC * 8; id += 512) { const int col = id >> 3, c8 = id & 7;
        unsigned w[4];
#pragma unroll
        for (int j = 0; j < 4; ++j) w[j] = (unsigned)scr[(c8 * 8 + 2 * j) * LDW + col] | ((unsigned)scr[(c8 * 8 + 2 * j + 1) * LDW + col] << 16);
        *(uint4*)(dst + ((size_t)(b * NH + (col >> 6)) * 64 + (col & 63)) * NKEYS + key0 + c8 * 8) = make_uint4(w[0], w[1], w[2], w[3]); }
    __syncthreads();
}
__device__ __forceinline__ int chunk_row0(int b, int ck) { return ck < 2 ? NLAT + b * CTXL + ck * 128 : b * SEQ + (ck - 2) * 128; }
template <class PT>
__device__ __forceinline__ void ret_kv_item(const PT& p, int layer, int item, char* smem, int tid) {
    using namespace fa;
    LAS unsigned char* lds = (LAS unsigned char*)(LAS char*)smem;
    constexpr int IMG = 16384, OFF_KF = IMG, OFF_KB = 2 * IMG;
    const bf16_t* P = WSP(const bf16_t, O_P);
    const int ck = item % 34, bh = item / 34, h = bh & 3, b = bh >> 2;
    const int row0 = chunk_row0(b, ck);
    const float lgf = WSP(const float, O_RETLG)[layer * 8 + h], lgb = WSP(const float, O_RETLG)[layer * 8 + 4 + h];
    {
        u32x4 uk[2], uv[2];
#pragma unroll
        for (int i = 0; i < 2; ++i) { const int id = tid + 512 * i, r = id >> 3, ch = id & 7;
            uk[i] = *(const u32x4*)(P + (size_t)(row0 + r) * PLD + C_RK + h * 64 + ch * 8); uv[i] = *(const u32x4*)(P + (size_t)(row0 + r) * PLD + C_RV + h * 64 + ch * 8); }
#pragma unroll
        for (int i = 0; i < 2; ++i) { const int id = tid + 512 * i, r = id >> 3, ch = id & 7;
            const float wf = __builtin_amdgcn_exp2f(lgf * (float)(127 - r)), wb = __builtin_amdgcn_exp2f(lgb * (float)r);
            const unsigned kw[4] = {uk[i].x, uk[i].y, uk[i].z, uk[i].w};
            u32x4 kf, kbw;
#pragma unroll
            for (int j = 0; j < 4; ++j) { const float k0 = bflo(kw[j]), k1 = bfhi(kw[j]); kf[j] = cvt_pk(k0 * wf, k1 * wf); kbw[j] = cvt_pk(k0 * wb, k1 * wb); }
            const unsigned la = (r >> 6) * 8192 + vtr_st(r & 63, ch * 8);
            *(LAS u32x4*)(lds + la) = uv[i]; *(LAS u32x4*)(lds + OFF_KF + la) = kf; *(LAS u32x4*)(lds + OFF_KB + la) = kbw;
        }
    }
    asm volatile("s_waitcnt lgkmcnt(0)" ::: "memory"); __syncthreads();
    {
        const int lane = tid & 63, wave = __builtin_amdgcn_readfirstlane(tid >> 6), l31 = lane & 31, hh = lane >> 5;
        const int dir = wave >> 2, dvb = (wave >> 1) & 1, dkb = wave & 1;
        const int vab = (int)(unsigned)(size_t)lds + vtr_base(lane) + dvb * 512;
        const int kbb = (int)(unsigned)(size_t)lds + (dir ? OFF_KB : OFF_KF) + vtr_base(lane) + dkb * 512;
        u32x2 fa_[8][2], fb_[8][2];
#define RK_RD(s_) fa_[s_][0] = vtr_read<vtr_off(0, (s_) & 3, 0) + ((s_) >> 2) * 8192>(vab); fa_[s_][1] = vtr_read<vtr_off(0, (s_) & 3, 1) + ((s_) >> 2) * 8192>(vab); \
                  fb_[s_][0] = vtr_read<vtr_off(0, (s_) & 3, 0) + ((s_) >> 2) * 8192>(kbb); fb_[s_][1] = vtr_read<vtr_off(0, (s_) & 3, 1) + ((s_) >> 2) * 8192>(kbb);
        RK_RD(0) RK_RD(1) RK_RD(2) RK_RD(3) RK_RD(4) RK_RD(5) RK_RD(6) RK_RD(7)
#undef RK_RD
        asm volatile("s_waitcnt lgkmcnt(0)" ::: "memory"); __builtin_amdgcn_sched_barrier(0);
        f32x16 acc;
#pragma unroll
        for (int r = 0; r < 16; ++r) acc[r] = 0.f;
#pragma unroll
        for (int s = 0; s < 8; ++s) { const u32x4 ua = (u32x4){fa_[s][0].x, fa_[s][0].y, fa_[s][1].x, fa_[s][1].y}, ub = (u32x4){fb_[s][0].x, fb_[s][0].y, fb_[s][1].x, fb_[s][1].y};
            acc = __builtin_amdgcn_mfma_f32_32x32x16_bf16(__builtin_bit_cast(bf16x8, ua), __builtin_bit_cast(bf16x8, ub), acc, 0, 0, 0); }
        float* o = WSP(float, dir ? O_KVB : O_KVF) + ((size_t)bh * 34 + ck) * 4096 + (size_t)(32 * dvb + 4 * hh) * 64 + 32 * dkb + l31;
#pragma unroll
        for (int r = 0; r < 16; ++r) o[((r & 3) + 8 * (r >> 2)) * 64] = acc[r];
    }
    asm volatile("s_waitcnt lgkmcnt(0)" ::: "memory"); __syncthreads();
}
__device__ __forceinline__ void st_ret_scan(int layer) {
    STAGE_PARAMS();
    for (int g = bid_ * 512 + tid_; g < 32 * 2 * 4096; g += G_ * 512) {
        const int e = g & 4095, dir = (g >> 12) & 1, bh = g >> 13, h = bh & 3;
        const float lg = WSP(const float, O_RETLG)[layer * 8 + dir * 4 + h];
        const float gch = exp2f(lg * 128.f);
        const float* kv = WSP(const float, dir ? O_KVB : O_KVF) + (size_t)bh * 34 * 4096 + e;
        bf16_t* sp = WSP(bf16_t, dir ? O_SPB : O_SPF) + (size_t)bh * 34 * 4096 + e;
        float s = 0.f;
#pragma unroll 1
        for (int c0 = 0; c0 < 34; c0 += 17) {
            float kvv[17];
#pragma unroll
            for (int i = 0; i < 17; ++i) { const int ii = c0 + i, ck = dir ? (ii < 2 ? 1 - ii : 35 - ii) : ii; kvv[i] = kv[(size_t)ck * 4096]; }
#pragma unroll
            for (int i = 0; i < 17; ++i) { const int ii = c0 + i, ck = dir ? (ii < 2 ? 1 - ii : 35 - ii) : ii; sp[(size_t)ck * 4096] = (bf16_t)f2bf(s); s = gch * s + kvv[i]; }
        }
    }
}

__device__ __forceinline__ void st_phase_c(int layer, char* smem, bool canon) {
    STAGE_PARAMS();
    using namespace fa;
    LAS unsigned char* lds = (LAS unsigned char*)(LAS char*)smem;
    constexpr int A1S = 528, A2S = 272, OFF_A2 = 64 * A1S, OFF_TM = OFF_A2 + 64 * A2S, OFF_TW = OFF_TM + 64 * 8 * 8, OFF_TR = OFF_TW + 64 * 16 * 8;
    typedef float f32x2v __attribute__((ext_vector_type(2)));
    LAS f32x2v* tabm = (LAS f32x2v*)(lds + OFF_TM);
    LAS f32x2v* tabw = (LAS f32x2v*)(lds + OFF_TW);
    const int tid = tid_, lane = tid & 63, wave = __builtin_amdgcn_readfirstlane(tid >> 6), l31 = lane & 31, hh = lane >> 5;
    for (int i = tid; i < 64 * 24; i += 512) { const int pos = i / 24, f = i % 24; float sn, cs;
        if (f < 8) { sincos_acc((float)pos * ROPE_INV8[f], sn, cs); tabm[pos * 8 + f] = (f32x2v){cs, sn}; }
        else { sincos_acc((float)pos * ROPE_INV16[f - 8], sn, cs); tabw[pos * 16 + f - 8] = (f32x2v){cs, sn}; } }
    const bf16_t* P = WSP(const bf16_t, O_P);
    const bf16_t* WUQ = WSP(const bf16_t, O_WUQT) + (size_t)layer * 768 * 256;
    const bf16_t* WUK = WSP(const bf16_t, O_WUKT) + (size_t)layer * 512 * 128;
    const bf16_t* WUV = WSP(const bf16_t, O_WUVT) + (size_t)layer * 512 * 128;
    bf16_t* QM = WSP(bf16_t, O_QM); bf16_t* KM = WSP(bf16_t, O_KM); bf16_t* VT = WSP(bf16_t, O_VT);
    const float qscale = 0.10206207261596575f * LOG2E, wscale = 0.125f * LOG2E;
    __syncthreads();
    LAS int* qslot = (LAS int*)(lds + 150016);
    LAS unsigned char* stg = lds + 96512 + (tid >> 6) * 6656;
    for (;;) {
        __syncthreads();
        if (tid == 0) {
            int it;
            if (canon) {
                const int x = vcu_of(bid_, G_) >> 5;
                const int q = (int)__hip_atomic_fetch_add(WSP(unsigned, O_QXCD) + (layer * 8 + x) * 64, 1u, __ATOMIC_RELAXED, __HIP_MEMORY_SCOPE_AGENT);
                if (q >= 204) it = NROWS / 64 + 8 * 4 * 34;
                else { const int mt = q < 68 ? q >> 2 : (q - 68) >> 3, pm = mt < 16 ? 32 * (mt >> 2) + 4 * x + (mt & 3) : 128 + x;
                    if (q < 68) it = pm * 4 + (q & 3);
                    else { const int sub = (q - 68) & 7, chunk = sub >> 2, hd = sub & 3, b = pm < 128 ? pm >> 4 : pm - 128, ck = pm < 128 ? 2 + (pm & 15) * 2 + chunk : chunk;
                        it = NROWS / 64 + (b * 4 + hd) * 34 + ck; } }
            } else it = (int)__hip_atomic_fetch_add(WSP(unsigned, O_QCNT) + layer * 64, 1u, __ATOMIC_RELAXED, __HIP_MEMORY_SCOPE_AGENT);
            if (it < NROWS / 64 + 8 * 4 * 34) {
                int r0 = it * 64;
                if (it >= NROWS / 64) { const int q = it - NROWS / 64; r0 = chunk_row0((q / 34) >> 2, q % 34); }
                const unsigned* dw = WSP(const unsigned, O_DEPW) + (layer * 136 + (r0 >> 8)) * 8;
                for (unsigned spins = 0; __hip_atomic_load(dw, __ATOMIC_RELAXED, __HIP_MEMORY_SCOPE_AGENT) < 64u && spins < (1u << 24); ++spins) __builtin_amdgcn_s_sleep(2);
                __builtin_amdgcn_fence(__ATOMIC_ACQUIRE, "agent");
                asm volatile("s_waitcnt vmcnt(0)" ::: "memory");
            }
            *qslot = it;
        }
        __syncthreads();
        const int item = *qslot;
        if (item >= NROWS / 64 + 8 * 4 * 34) break;
        if (item >= NROWS / 64) { ret_kv_item(p, layer, item - NROWS / 64, smem, tid); continue; }
        const int row0 = item * 64; const RowInfo ri = row_info(row0);
        const int key0 = ri.key, rowpos = ri.t >> 6; const bool isctx = ri.isctx != 0; const bool need_q = !(isctx && layer != 0);
        uint2 uqs[8]; unsigned uks[8];
#pragma unroll
        for (int rr = 0; rr < 8; ++rr) { const bf16_t* pr = P + (size_t)(row0 + wave * 8 + rr) * PLD; uqs[rr] = *(const uint2*)(pr + C_CQ + lane * 4); uks[rr] = *(const unsigned*)(pr + C_CKV + lane * 2); }
        const float4 gq = ((const float4*)(p.mla_qnorm_g + layer * 256))[lane]; const float2 gk = ((const float2*)(p.mla_kvnorm_g + layer * 128))[lane];
        __builtin_amdgcn_sched_barrier(0);
#pragma unroll
        for (int rr = 0; rr < 8; ++rr) { const int r = wave * 8 + rr;
            const uint2 uq = uqs[rr]; const unsigned uk = uks[rr];
            const float q0 = bflo(uq.x), q1 = bfhi(uq.x), q2 = bflo(uq.y), q3 = bfhi(uq.y), k0 = bflo(uk), k1 = bfhi(uk);
            const float rq = rsqrtf(wave_sum(q0 * q0 + q1 * q1 + q2 * q2 + q3 * q3) * (1.f / 256.f) + 1e-6f), rk = rsqrtf(wave_sum(k0 * k0 + k1 * k1) * (1.f / 128.f) + 1e-6f);
            *(LAS u32x2*)(lds + r * A1S + lane * 8) = (u32x2){cvt_pk(q0 * rq * gq.x, q1 * rq * gq.y), cvt_pk(q2 * rq * gq.z, q3 * rq * gq.w)};
            *(LAS unsigned*)(lds + OFF_A2 + r * A2S + lane * 4) = cvt_pk(k0 * rk * gk.x, k1 * rk * gk.y); }
        __syncthreads();
        if (need_q) {
            f32x16 acc[3][2];
#pragma unroll
            for (int nb = 0; nb < 3; ++nb)
#pragma unroll
                for (int tb = 0; tb < 2; ++tb)
#pragma unroll
                    for (int r = 0; r < 16; ++r) acc[nb][tb][r] = 0.f;
            const __attribute__((address_space(1))) bf16_t* wq = (const __attribute__((address_space(1))) bf16_t*)(WUQ + (size_t)(wave * 48) * 512 + lane * 8);
            asm volatile("" : "+v"(wq));
            const LAS unsigned char* ab = lds + l31 * A1S + 16 * hh;
            bf16x8 wA[2][3], wB[2][3];
#define PC_LDW(w_, s0_) do { _Pragma("unroll") for (int j = 0; j < 2; ++j) _Pragma("unroll") for (int nb = 0; nb < 3; ++nb) w_[j][nb] = *(const __attribute__((address_space(1))) bf16x8*)(wq + (size_t)(nb * 16 + (s0_) + j) * 512); } while (0)
#define PC_MMA(w_, s0_) do { _Pragma("unroll") for (int j = 0; j < 2; ++j) { const bf16x8 b0 = *(const LAS bf16x8*)(ab + 32 * ((s0_) + j)), b1 = *(const LAS bf16x8*)(ab + 32 * A1S + 32 * ((s0_) + j)); \
                _Pragma("unroll") for (int nb = 0; nb < 3; ++nb) { acc[nb][0] = __builtin_amdgcn_mfma_f32_32x32x16_bf16(w_[j][nb], b0, acc[nb][0], 0, 0, 0); acc[nb][1] = __builtin_amdgcn_mfma_f32_32x32x16_bf16(w_[j][nb], b1, acc[nb][1], 0, 0, 0); } } } while (0)
            PC_LDW(wA, 0); __builtin_amdgcn_sched_barrier(0);
#pragma unroll
            for (int c = 0; c < 16; c += 4) {
                PC_LDW(wB, c + 2); __builtin_amdgcn_sched_barrier(0);
                PC_MMA(wA, c); __builtin_amdgcn_sched_barrier(0);
                if (c + 4 < 16) { PC_LDW(wA, c + 4); __builtin_amdgcn_sched_barrier(0); }
                PC_MMA(wB, c + 2); __builtin_amdgcn_sched_barrier(0);
            }
#undef PC_LDW
#undef PC_MMA
#pragma unroll
            for (int tb = 0; tb < 2; ++tb) {
                if (!isctx) {
#pragma unroll
                    for (int r = 0; r < 4; ++r) {
                        const f32x2v cr = tabm[rowpos * 8 + 4 * hh + r], cc = tabm[(32 * tb + l31) * 8 + 4 * hh + r];
                        const float x1 = acc[2][tb][r], x2 = acc[2][tb][r + 4], y1 = acc[2][tb][r + 8], y2 = acc[2][tb][r + 12];
                        acc[2][tb][r] = x1 * cr.x - x2 * cr.y; acc[2][tb][r + 4] = x1 * cr.y + x2 * cr.x;
                        acc[2][tb][r + 8] = y1 * cc.x - y2 * cc.y; acc[2][tb][r + 12] = y1 * cc.y + y2 * cc.x; }
                }
#pragma unroll
                for (int nb = 0; nb < 3; ++nb)
#pragma unroll
                    for (int g = 0; g < 4; ++g) *(LAS u32x2*)(stg + opq(l31 * 208 + 8 * hh) + (32 * nb + 8 * g) * 2) = (u32x2){cvt_pk(acc[nb][tb][4 * g] * qscale, acc[nb][tb][4 * g + 1] * qscale), cvt_pk(acc[nb][tb][4 * g + 2] * qscale, acc[nb][tb][4 * g + 3] * qscale)};
                asm volatile("s_waitcnt lgkmcnt(0)" ::: "memory");
#pragma unroll
                for (int ps = 0; ps < 6; ++ps) { const int idx = opq(lane) + 64 * ps, rw = idx / 12, ch = idx % 12;
                    const u32x4 v = *(const LAS u32x4*)(stg + rw * 208 + ch * 16);
                    *(u32x4*)(QM + ((size_t)(row0 + 32 * tb + rw) * 8 + wave) * 96 + ch * 8) = v; }
                asm volatile("s_waitcnt lgkmcnt(0)" ::: "memory");
            }
        }
        {
            f32x16 ak[2][2], av[2][2];
#pragma unroll
            for (int nb = 0; nb < 2; ++nb)
#pragma unroll
                for (int tb = 0; tb < 2; ++tb)
#pragma unroll
                    for (int r = 0; r < 16; ++r) { ak[nb][tb][r] = 0.f; av[nb][tb][r] = 0.f; }
            const __attribute__((address_space(1))) bf16_t* wk = (const __attribute__((address_space(1))) bf16_t*)(WUK + (size_t)(wave * 16) * 512 + lane * 8);
            const __attribute__((address_space(1))) bf16_t* wv = (const __attribute__((address_space(1))) bf16_t*)(WUV + (size_t)(wave * 16) * 512 + lane * 8);
            asm volatile("" : "+v"(wk), "+v"(wv));
            const LAS unsigned char* ab = lds + OFF_A2 + l31 * A2S + 16 * hh;
            bf16x8 uA[2][2], uB[2][2];
#define PC_LDW(w_, s_) do { _Pragma("unroll") for (int nb = 0; nb < 2; ++nb) { w_[nb][0] = *(const __attribute__((address_space(1))) bf16x8*)(wk + (size_t)(nb * 8 + (s_)) * 512); w_[nb][1] = *(const __attribute__((address_space(1))) bf16x8*)(wv + (size_t)(nb * 8 + (s_)) * 512); } } while (0)
#define PC_MMA(w_, s_) do { const bf16x8 b0 = *(const LAS bf16x8*)(ab + 32 * (s_)), b1 = *(const LAS bf16x8*)(ab + 32 * A2S + 32 * (s_)); \
                _Pragma("unroll") for (int nb = 0; nb < 2; ++nb) { \
                    ak[nb][0] = __builtin_amdgcn_mfma_f32_32x32x16_bf16(w_[nb][0], b0, ak[nb][0], 0, 0, 0); ak[nb][1] = __builtin_amdgcn_mfma_f32_32x32x16_bf16(w_[nb][0], b1, ak[nb][1], 0, 0, 0); \
                    av[nb][0] = __builtin_amdgcn_mfma_f32_32x32x16_bf16(b0, w_[nb][1], av[nb][0], 0, 0, 0); av[nb][1] = __builtin_amdgcn_mfma_f32_32x32x16_bf16(b1, w_[nb][1], av[nb][1], 0, 0, 0); } } while (0)
            PC_LDW(uA, 0); __builtin_amdgcn_sched_barrier(0);
#pragma unroll
            for (int c = 0; c < 8; c += 2) {
                PC_LDW(uB, c + 1); __builtin_amdgcn_sched_barrier(0);
                PC_MMA(uA, c); __builtin_amdgcn_sched_barrier(0);
                if (c + 2 < 8) { PC_LDW(uA, c + 2); __builtin_amdgcn_sched_barrier(0); }
                PC_MMA(uB, c + 1); __builtin_amdgcn_sched_barrier(0);
            }
#undef PC_LDW
#undef PC_MMA
            const size_t bhw = (size_t)(ri.b * 8 + wave);
#pragma unroll
            for (int tb = 0; tb < 2; ++tb) {
#pragma unroll
                for (int nb = 0; nb < 2; ++nb)
#pragma unroll
                    for (int g = 0; g < 4; ++g) *(LAS u32x2*)(stg + opq(l31 * 144 + 8 * hh) + (32 * nb + 8 * g) * 2) = (u32x2){cvt_pk(ak[nb][tb][4 * g], ak[nb][tb][4 * g + 1]), cvt_pk(ak[nb][tb][4 * g + 2], ak[nb][tb][4 * g + 3])};
                asm volatile("s_waitcnt lgkmcnt(0)" ::: "memory");
#pragma unroll
                for (int ps = 0; ps < 4; ++ps) { const int idx = opq(lane) + 64 * ps, rw = idx >> 3, ch = idx & 7;
                    const u32x4 v = *(const LAS u32x4*)(stg + rw * 144 + ch * 16);
                    *(u32x4*)(KM + (bhw * NKEYS + key0 + 32 * tb + rw) * 96 + ch * 8) = v; }
                asm volatile("s_waitcnt lgkmcnt(0)" ::: "memory");
            }
#pragma unroll
            for (int nb = 0; nb < 2; ++nb) {
#pragma unroll
                for (int tb = 0; tb < 2; ++tb)
#pragma unroll
                    for (int g = 0; g < 4; ++g) *(LAS u32x2*)(stg + opq(l31 * 144 + 8 * hh) + (32 * tb + 8 * g) * 2) = (u32x2){cvt_pk(av[nb][tb][4 * g], av[nb][tb][4 * g + 1]), cvt_pk(av[nb][tb][4 * g + 2], av[nb][tb][4 * g + 3])};
                asm volatile("s_waitcnt lgkmcnt(0)" ::: "memory");
#pragma unroll
                for (int ps = 0; ps < 4; ++ps) { const int idx = opq(lane) + 64 * ps, rw = idx >> 3, ch = idx & 7;
                    const u32x4 v = *(const LAS u32x4*)(stg + rw * 144 + ch * 16);
                    *(u32x4*)(VT + (bhw * 64 + 32 * nb + rw) * NKEYS + key0 + ch * 8) = v; }
                asm volatile("s_waitcnt lgkmcnt(0)" ::: "memory");
            }
        }
        {
#pragma unroll
            for (int ps = 0; ps < 4; ++ps) { const int id = opq(tid) + 512 * ps, cc = id & 3, tk = (id >> 2) & 63, hd = id >> 8;
                const bf16_t* pr = P + (size_t)(row0 + tk) * PLD + C_KR;
                const uint4 uo = ((const uint4*)pr)[cc], up = ((const uint4*)pr)[cc ^ 1];
                const unsigned wo[4] = {uo.x, uo.y, uo.z, uo.w}, wp[4] = {up.x, up.y, up.z, up.w};
                float y[8];
#pragma unroll
                for (int j = 0; j < 8; ++j) { const float xo = (j & 1) ? bfhi(wo[j >> 1]) : bflo(wo[j >> 1]), xp = (j & 1) ? bfhi(wp[j >> 1]) : bflo(wp[j >> 1]);
                    if (isctx) y[j] = xo;
                    else { const f32x2v cs = tabm[((cc & 2) ? tk : rowpos) * 8 + j]; y[j] = (cc & 1) ? xp * cs.y + xo * cs.x : xo * cs.x - xp * cs.y; } }
                *(uint4*)(KM + ((size_t)(ri.b * 8 + hd) * NKEYS + key0 + tk) * 96 + 64 + cc * 8) = make_uint4(cvt_pk(y[0], y[1]), cvt_pk(y[2], y[3]), cvt_pk(y[4], y[5]), cvt_pk(y[6], y[7]));
            }
        }
        {
#pragma unroll 1
            for (int pg3 = 0; pg3 < 2; ++pg3) {
                uint4 uo3[3], up3[3];
#pragma unroll
                for (int q3 = 0; q3 < 3; ++q3) { const int ps = 3 * pg3 + q3; const bool isq = ps < 4; const int id = opq(tid) + 512 * (isq ? ps : ps - 4);
                    const int ch = isq ? (id & 31) : (id & 7), tk = isq ? (id >> 5) : ((id >> 3) & 63), hdk = id >> 9, cc = ch & 3;
                    const bf16_t* pr = P + (size_t)(row0 + tk) * PLD + (isq ? C_WQ : C_WK + hdk * 64) + (ch >> 2) * 32;
                    uo3[q3] = ((const uint4*)pr)[cc]; up3[q3] = ((const uint4*)pr)[cc ^ 2]; }
                __builtin_amdgcn_sched_barrier(0);
#pragma unroll
                for (int q3 = 0; q3 < 3; ++q3) { const int ps = 3 * pg3 + q3; const bool isq = ps < 4; const int id = opq(tid) + 512 * (isq ? ps : ps - 4);
                    const int ch = isq ? (id & 31) : (id & 7), tk = isq ? (id >> 5) : ((id >> 3) & 63), hdk = id >> 9;
                    const int cc = ch & 3, half = (ch >> 2) & 1;
                    const uint4 uo = uo3[q3], up = up3[q3];
                    const unsigned wo[4] = {uo.x, uo.y, uo.z, uo.w}, wp[4] = {up.x, up.y, up.z, up.w};
                    const float sc = isq ? wscale : 1.f;
                    float y[8];
#pragma unroll
                    for (int j = 0; j < 8; ++j) { const float xo = (j & 1) ? bfhi(wo[j >> 1]) : bflo(wo[j >> 1]), xp = (j & 1) ? bfhi(wp[j >> 1]) : bflo(wp[j >> 1]);
                        if (isctx) y[j] = xo * sc;
                        else { const f32x2v cs = tabw[(half == 0 ? rowpos : tk) * 16 + (cc & 1) * 8 + j]; y[j] = ((cc & 2) ? xp * cs.y + xo * cs.x : xo * cs.x - xp * cs.y) * sc; } }
                    bf16_t* o = isq ? WSP(bf16_t, O_WQ) + (size_t)(row0 + tk) * 256 + ch * 8 : WSP(bf16_t, O_WK) + ((size_t)(ri.b * 2 + hdk) * NKEYS + key0 + tk) * 64 + ch * 8;
                    *(uint4*)o = make_uint4(cvt_pk(y[0], y[1]), cvt_pk(y[2], y[3]), cvt_pk(y[4], y[5]), cvt_pk(y[6], y[7]));
                }
            }
        }
    }
}

__device__ __forceinline__ void st_win_fast(int layer, char* smem) {
    STAGE_PARAMS();
    LAS unsigned char* lds = (LAS unsigned char*)(LAS char*)smem;
    const int c = (vcu_of(bid_, G_) + G_ - 64 % G_) % G_;
    const int nunits = 512 + (layer == 0 ? 32 : 0);
    const bf16_t* WQ = WSP(const bf16_t, O_WQ); const bf16_t* WK = WSP(const bf16_t, O_WK); const bf16_t* WVT = WSP(const bf16_t, O_WVT); bf16_t* Y = WSP(bf16_t, O_HX);
    if (tid_ >= 256) __builtin_amdgcn_s_setprio(1);
    for (int L = c; L < nunits; L += G_) {
        int b, hk, row0, ntiles, second0 = 0, qtok0 = 0;
        if (L < 512) { const int bk = L >> 5, qb = L & 31; b = bk >> 1; hk = bk & 1; qtok0 = qb * 128; row0 = b * SEQ + qtok0;
            const int lo = qtok0 - 128 < 0 ? 0 : qtok0 - 128, hi = qtok0 + 255 > SEQ - 1 ? SEQ - 1 : qtok0 + 255;
            ntiles = 4 + (hi + 1 - lo) / 64; second0 = 256 + lo; }
        else { const int q = L - 512; b = q >> 2; hk = (q >> 1) & 1; row0 = NLAT + b * CTXL + (q & 1) * 128; ntiles = 4; }
        const bf16_t* Pv = WSP(const bf16_t, O_P) + C_WV + hk * 64;
        fa::attn_unit<64, true, true, true>(lds, tid_, WQ + (size_t)row0 * 256 + hk * 128, 256, WK + (size_t)(b * 2 + hk) * NKEYS * 64, Pv + ((long)b * SEQ - 256) * (long)PLD, PLD,
                                      ntiles, 4, second0, qtok0, p.win_sink[layer * 4 + 2 * hk] * LOG2E, Y + (size_t)row0 * DM + 768 + hk * 128, DM, p.win_sink[layer * 4 + 2 * hk + 1] * LOG2E,
                                      Pv + ((size_t)NLAT + (size_t)b * CTXL) * PLD);
    }
    __builtin_amdgcn_s_setprio(0);
}
__device__ __forceinline__ void st_ret_fast(int layer, char* smem) {
    STAGE_PARAMS();
    using namespace fa;
    LAS unsigned char* lds = (LAS unsigned char*)(LAS char*)smem;
    constexpr int KSTR = 144, VSTR = 520, KB = 256 * KSTR;
    const int tid = tid_, lane = tid & 63, wave = __builtin_amdgcn_readfirstlane(tid >> 6), q32 = lane & 31, hh = lane >> 5;
    const int c = (vcu_of(bid_, G_) + G_ - 96 % G_) % G_;
    const int npair = layer == 0 ? 17 : 16, nunits = 32 * npair;
    const bf16_t* P = WSP(const bf16_t, O_P); const bf16_t* RVT = WSP(const bf16_t, O_RVT); bf16_t* Y = WSP(bf16_t, O_HX);
    for (int L = c; L < nunits; L += G_) {
        const int bh = L / npair, pr = L % npair + (layer == 0 ? 0 : 1), b = bh >> 2, h = bh & 3;
        const int row0 = chunk_row0(b, 2 * pr), key0 = pr == 0 ? 0 : 256 + (2 * pr - 2) * 128;
        const float lgf = WSP(const float, O_RETLG)[layer * 8 + h], lgb = WSP(const float, O_RETLG)[layer * 8 + 4 + h];
        __syncthreads();
        const int ckl = wave >> 2, ck = 2 * pr + ckl, cpos = opq(32 * (wave & 3) + q32);
        const int row = row0 + wave * 32 + q32;
        u32x4 uk4[4], uv4[4];
#pragma unroll
        for (int i = 0; i < 4; ++i) { const int id = tid + 512 * i; uk4[i] = *(const u32x4*)(P + (size_t)(row0 + (id >> 3)) * PLD + C_RK + h * 64 + (id & 7) * 8);
            uv4[i] = *(const u32x4*)(P + (size_t)(row0 + (id >> 3)) * PLD + C_RV + h * 64 + (id & 7) * 8); }
        bf16x8 qf[4];
#pragma unroll
        for (int s = 0; s < 4; ++s) qf[s] = *(const bf16x8*)(P + (size_t)row * PLD + C_RQ + h * 64 + 16 * s + 8 * hh);
        uint2 gga[4], ggb[4];
        { const bf16_t* gr0 = P + (size_t)row * PLD + C_RG + h * 64 + 4 * hh;
#pragma unroll
          for (int g = 0; g < 4; ++g) { gga[g] = *(const uint2*)(gr0 + 8 * g); ggb[g] = *(const uint2*)(gr0 + 32 + 8 * g); } }
        bf16x8 spf[2][4][2];
#pragma unroll
        for (int dir = 0; dir < 2; ++dir) { const bf16_t* sp = WSP(const bf16_t, dir ? O_SPB : O_SPF) + ((size_t)bh * 34 + ck) * 4096 + (size_t)q32 * 64 + 8 * hh;
#pragma unroll
            for (int s = 0; s < 4; ++s) { spf[dir][s][0] = *(const bf16x8*)(sp + 16 * s); spf[dir][s][1] = *(const bf16x8*)(sp + 32 * 64 + 16 * s); } }
        __builtin_amdgcn_sched_barrier(0);
#pragma unroll
        for (int i = 0; i < 4; ++i) { const int id = tid + 512 * i; const int r = id >> 3, ch = id & 7;
            *(LAS u32x4*)(lds + r * KSTR + ch * 16) = uk4[i]; }
#pragma unroll
        for (int i = 0; i < 4; ++i) { const int id = tid + 512 * i; const int r = id >> 3, ch = id & 7;
            *(LAS u32x4*)(lds + KB + (r >> 6) * 8192 + vtr_st(r & 63, ch * 8)) = uv4[i]; }
        f32x16 o0, o1;
#pragma unroll
        for (int r = 0; r < 16; ++r) { o0[r] = 0.f; o1[r] = 0.f; }
#pragma unroll
        for (int dir = 0; dir < 2; ++dir) {
            f32x16 r0, r1;
#pragma unroll
            for (int r = 0; r < 16; ++r) { r0[r] = 0.f; r1[r] = 0.f; }
#pragma unroll
            for (int s = 0; s < 4; ++s) {
                const bf16x8 a0 = spf[dir][s][0], a1 = spf[dir][s][1];
                r0 = __builtin_amdgcn_mfma_f32_32x32x16_bf16(a0, qf[s], r0, 0, 0, 0);
                r1 = __builtin_amdgcn_mfma_f32_32x32x16_bf16(a1, qf[s], r1, 0, 0, 0);
            }
            const float wq = __builtin_amdgcn_exp2f(dir ? lgb * (float)(128 - cpos) : lgf * (float)(cpos + 1));
#pragma unroll
            for (int r = 0; r < 16; ++r) { o0[r] += wq * r0[r]; o1[r] += wq * r1[r]; }
        }
        __syncthreads();
#pragma unroll
        for (int tt = 0; tt < 2; ++tt) {
            const int kbase = ckl * 128 + tt * 64;
            const LAS unsigned char* kb = lds + (kbase + q32) * KSTR + 16 * hh;
            f32x16 p0, p1;
#pragma unroll
            for (int r = 0; r < 16; ++r) { p0[r] = 0.f; p1[r] = 0.f; }
#pragma unroll
            for (int s = 0; s < 4; ++s) {
                const bf16x8 a0 = *(const LAS bf16x8*)(kb + 32 * s), a1 = *(const LAS bf16x8*)(kb + 32 * KSTR + 32 * s);
                p0 = __builtin_amdgcn_mfma_f32_32x32x16_bf16(a0, qf[s], p0, 0, 0, 0);
                p1 = __builtin_amdgcn_mfma_f32_32x32x16_bf16(a1, qf[s], p1, 0, 0, 0);
            }
#pragma unroll
            for (int r = 0; r < 16; ++r) { const int mp = tt * 64 + 4 * hh + (r & 3) + 8 * (r >> 2); const int d0 = cpos - mp, d1 = d0 - 32;
                p0[r] *= __builtin_amdgcn_exp2f(((d0 >= 0) ? lgf : -lgb) * (float)d0);
                p1[r] *= __builtin_amdgcn_exp2f(((d1 >= 0) ? lgf : -lgb) * (float)d1); }
            bf16x8 pf[4];
#pragma unroll
            for (int s = 0; s < 4; ++s) { unsigned w[4];
#pragma unroll
                for (int j = 0; j < 4; ++j) { const int r = 8 * (s & 1) + 2 * j; w[j] = (s < 2) ? cvt_pk(p0[r], p0[r + 1]) : cvt_pk(p1[r], p1[r + 1]); }
                const u32x4 u = (u32x4){w[0], w[1], w[2], w[3]}; pf[s] = __builtin_bit_cast(bf16x8, u); }
            u32x2 va[4][4];
            { const int vtb = (int)(unsigned)(size_t)(lds + KB + (kbase >> 6) * 8192) + vtr_base(lane); VTR_READ_ALL(va, vtb); }
            asm volatile("s_waitcnt lgkmcnt(0)" ::: "memory"); __builtin_amdgcn_sched_barrier(0);
#pragma unroll
            for (int s = 0; s < 4; ++s) {
                const u32x2 a00 = va[s][0], a01 = va[s][1], a10 = va[s][2], a11 = va[s][3];
                const u32x4 u0 = (u32x4){a00.x, a00.y, a01.x, a01.y}, u1 = (u32x4){a10.x, a10.y, a11.x, a11.y};
                o0 = __builtin_amdgcn_mfma_f32_32x32x16_bf16(__builtin_bit_cast(bf16x8, u0), pf[s], o0, 0, 0, 0);
                o1 = __builtin_amdgcn_mfma_f32_32x32x16_bf16(__builtin_bit_cast(bf16x8, u1), pf[s], o1, 0, 0, 0);
            }
        }
        float sm = 0.f;
#pragma unroll
        for (int r = 0; r < 16; ++r) { o0[r] *= 0.125f; o1[r] *= 0.125f; sm += o0[r] + o1[r]; }
        const float mu = xhalf_sum(sm) * (1.f / 64.f);
        float sq = 0.f;
#pragma unroll
        for (int r = 0; r < 16; ++r) { o0[r] -= mu; o1[r] -= mu; sq += o0[r] * o0[r] + o1[r] * o1[r]; }
        const float rstd = rsqrtf(xhalf_sum(sq) * (1.f / 64.f) + 1e-5f);
        bf16_t* yr = Y + (size_t)row * DM + h * 64 + 4 * hh;
#pragma unroll
        for (int g = 0; g < 4; ++g) {
            const uint2 ga = gga[g], gb = ggb[g];
            const float g0[4] = {bflo(ga.x), bfhi(ga.x), bflo(ga.y), bfhi(ga.y)}, g1[4] = {bflo(gb.x), bfhi(gb.x), bflo(gb.y), bfhi(gb.y)};
            float y0[4], y1[4];
#pragma unroll
            for (int j = 0; j < 4; ++j) { y0[j] = o0[4 * g + j] * rstd * g0[j] * __builtin_amdgcn_rcpf(1.f + __builtin_amdgcn_exp2f(-g0[j] * LOG2E)); y1[j] = o1[4 * g + j] * rstd * g1[j] * __builtin_amdgcn_rcpf(1.f + __builtin_amdgcn_exp2f(-g1[j] * LOG2E)); }
            *(uint2*)(yr + 8 * g) = make_uint2(cvt_pk(y0[0], y0[1]), cvt_pk(y0[2], y0[3]));
            *(uint2*)(yr + 32 + 8 * g) = make_uint2(cvt_pk(y1[0], y1[1]), cvt_pk(y1[2], y1[3]));
        }
    }
}

#define XB_TMO      128
#define XB_XCNT(j)  (256  + 64 * (j))
#define XB_XSUB(j)  (1280 + 64 * (j))
#define XB_XGEN(j)  (2304 + 64 * (j))
#define XB_TOP      3328
#define XB_TOPGEN   3392
#define XCD_BAR_WORDS 3456
#define XB_SPIN_CAP (1u << 18)

__device__ __forceinline__ unsigned xb_ld(unsigned* p)              { return __hip_atomic_load(p, __ATOMIC_RELAXED, __HIP_MEMORY_SCOPE_AGENT); }
__device__ __forceinline__ unsigned xb_add(unsigned* p, unsigned v) { return __hip_atomic_fetch_add(p, v, __ATOMIC_RELAXED, __HIP_MEMORY_SCOPE_AGENT); }
__device__ __forceinline__ unsigned xb_xcc_id() { return (unsigned)__builtin_amdgcn_s_getreg((3 << 11) | 20) & 0xFu; }
#define XB_SPIN(cond, bar) do { unsigned _sp = 0; while (cond) { __builtin_amdgcn_s_sleep(1); \
    if ((++_sp & 255u) == 0u) { if (xb_ld(&(bar)[XB_TMO])) break; if (_sp > XB_SPIN_CAP) { atomicAdd(&(bar)[XB_TMO], 1u); break; } } } } while (0)

struct XcdBarrier {
    unsigned* bar; unsigned x;
    volatile LAS unsigned* st;
};

__device__ __forceinline__ XcdBarrier xcd_barrier_post(unsigned* bar, volatile LAS unsigned* st) {
    XcdBarrier b; b.bar = bar; b.x = xb_xcc_id(); b.st = st;
    if (threadIdx.x == 0) (void)xb_add(&bar[XB_XCNT(b.x)], 1u);
    return b;
}
__device__ __forceinline__ void xcd_barrier_complete(unsigned* bar, unsigned x, unsigned& nloc, unsigned& nx) {
    const unsigned G = gridDim.x * gridDim.y * gridDim.z;
    unsigned sum, cnt, mine, sp = 0u;
    for (;;) {
        sum = 0u; cnt = 0u; mine = 0u;
#pragma unroll
        for (unsigned j = 0; j < 16; ++j) { const unsigned c = xb_ld(&bar[XB_XCNT(j)]); sum += c; cnt += (c > 0u) ? 1u : 0u; mine = (j == x) ? c : mine; }
        if (sum == G) break;
        __builtin_amdgcn_s_sleep(1);
        if ((++sp & 255u) == 0u) { if (xb_ld(&bar[XB_TMO])) break; if (sp > XB_SPIN_CAP) { atomicAdd(&bar[XB_TMO], 1u); break; } }
    }
    nloc = mine > 0u ? mine : 1u; nx = cnt > 0u ? cnt : 1u;
}

__device__ __forceinline__ void xcd_barrier(const XcdBarrier& b) {
    asm volatile("s_waitcnt vmcnt(0)" ::: "memory");
    __syncthreads();
    if (threadIdx.x == 0) {
        unsigned* bar = b.bar; unsigned bx = b.x; asm volatile("" : "+s"(bar), "+s"(bx));
        __builtin_amdgcn_s_waitcnt(0);
        unsigned nloc = b.st[0], nx = b.st[1];
        if (nloc == 0u) { xcd_barrier_complete(bar, bx, nloc, nx); b.st[0] = nloc; b.st[1] = nx; }
        const unsigned old = xb_add(&bar[XB_XSUB(bx)], 1u);
        const unsigned gen = old / nloc;
        if (old + 1u == (gen + 1u) * nloc) {
            __builtin_amdgcn_fence(__ATOMIC_RELEASE, "agent");
            asm volatile("s_waitcnt vmcnt(0)" ::: "memory");
            const unsigned og = xb_add(&bar[XB_TOP], 1u);
            const unsigned tg = og / nx;
            if (og + 1u == (tg + 1u) * nx) xb_add(&bar[XB_TOPGEN], 1u);
            else XB_SPIN(xb_ld(&bar[XB_TOPGEN]) == tg, bar);
            __builtin_amdgcn_fence(__ATOMIC_ACQUIRE, "agent");
            asm volatile("s_waitcnt vmcnt(0)" ::: "memory");
        } else {
            XB_SPIN(xb_ld(&bar[XB_TOPGEN]) == gen, bar);
            __builtin_amdgcn_fence(__ATOMIC_ACQUIRE, "agent");
            asm volatile("s_waitcnt vmcnt(0)" ::: "memory");
        }
    }
    __syncthreads();
}

constexpr int MK_LDS = 151552;
constexpr size_t CW_BAR = 4096;
__global__ void __launch_bounds__(512, 2) k_mega(Params p, int pad0, int pad1) {
    extern __shared__ __attribute__((aligned(16))) char smem[];
    volatile LAS unsigned* misc = (volatile LAS unsigned*)(smem + MK_LDS - 64);
    if (threadIdx.x < 16) misc[threadIdx.x] = 0u;
    __syncthreads();
    XcdBarrier bar = xcd_barrier_post(WSP(unsigned, O_CTL) + CW_BAR, misc);
#define GRID_BAR() xcd_barrier(bar)
    { const int myx = __builtin_amdgcn_readfirstlane((int)xb_xcc_id()), wantx = __builtin_amdgcn_readfirstlane((int)(blockIdx.x & 7u)), g256 = __builtin_amdgcn_readfirstlane((int)gridDim.x);
      unsigned mismv = (unsigned)(myx != wantx) | (unsigned)(g256 != 256);
      if (threadIdx.x == 0) __hip_atomic_fetch_or(WSP(unsigned, O_CANON), mismv, __ATOMIC_RELAXED, __HIP_MEMORY_SCOPE_AGENT); }
    st_mods(smem);
    st_prep_weights(0, 0, smem, (int)blockIdx.x, (int)gridDim.x);
    GRID_BAR();
    int canon_i = (int)__hip_atomic_load(WSP(unsigned, O_CANON), __ATOMIC_RELAXED, __HIP_MEMORY_SCOPE_AGENT); canon_i = __builtin_amdgcn_readfirstlane(canon_i); asm volatile("" : "+s"(canon_i));
    const bool canon = canon_i == 0;
    for (int l = 0; l < 2; ++l) {
        st_rownorm(l);
        GRID_BAR();
        st_gemm_win_fast(l, smem, canon);
        st_phase_c(l, smem, canon);
        GRID_BAR();
        st_ret_scan(l);
        GRID_BAR();
        st_mla_fast(l, smem); st_win_fast(l, smem); st_ret_fast(l, smem);
        GRID_BAR();
        st_gemm_wout_fast(l, smem);
        GRID_BAR();
        st_norm2_router(l, smem);
        {   const int G = (int)gridDim.x, extra = (l == 0) ? 272 % G : 0;
            st_prep_weights(1, l, smem, (int)blockIdx.x - extra, G - extra); }
        GRID_BAR();
        st_topk(l, smem);
        GRID_BAR();
        st_moe_up_fast(l, smem);
        GRID_BAR();
        st_moe_down_fast(l, smem);
        GRID_BAR();
    }
    st_rownorm(2);
}
}

extern "C" void kernel_launch(void* const* d_in, const int* in_sizes, int n_in, void* d_out, int out_size, void* d_ws, size_t ws_size, hipStream_t stream) {
    if (n_in != 23 || ws_size < O_END4) { fprintf(stderr, "kernel_launch: unexpected n_in %d or ws_size %zu (< %zu)\n", n_in, ws_size, (size_t)O_END4); return; }
    Params p{};
    const float** dst = (const float**)&p;
    for (int i = 0; i < 23; ++i) dst[i] = (const float*)d_in[i];
    p.out = (float*)d_out; p.ws = (unsigned char*)d_ws;
    static int grid = 0;
    if (grid == 0) {
        int dev = 0, cus = 0, per_cu = 0;
        if (hipGetDevice(&dev) != hipSuccess || hipDeviceGetAttribute(&cus, hipDeviceAttributeMultiprocessorCount, dev) != hipSuccess) { fprintf(stderr, "kernel_launch: device query failed\n"); grid = -1; return; }
        (void)hipFuncSetAttribute((const void*)k_mega, hipFuncAttributeMaxDynamicSharedMemorySize, MK_LDS);
        if (hipOccupancyMaxActiveBlocksPerMultiprocessor(&per_cu, (const void*)k_mega, 512, MK_LDS) != hipSuccess || per_cu < 1) { fprintf(stderr, "kernel_launch: occupancy query says %d\n", per_cu); per_cu = 1; }
        (void)hipGetLastError();
        grid = cus;
    }
    if (grid < 0) return;
    (void)hipMemsetAsync((char*)d_ws + O_CTL, 0, 65536, stream);
    hipLaunchKernelGGL(k_mega, dim3(grid), dim3(512), MK_LDS, stream, p, 0, 0);
}
```

```cpp
#include <hip/hip_runtime.h>
#include <stdint.h>
#include <stdio.h>

namespace {
typedef unsigned short bf16_t;
#define LAS __attribute__((address_space(3)))
constexpr int NB = 8, SEQ = 4096, CTXL = 256, DM = 1024;
constexpr int NLAT = NB * SEQ;
constexpr int NCTX = NB * CTXL;
constexpr int NROWS = NLAT + NCTX;
constexpr int NKEYS = CTXL + SEQ;
constexpr int PCOLS = 1952, PLD = 2048;
constexpr int C_RQ = 0, C_RK = 256, C_RV = 512, C_RG = 768, C_CQ = 1024, C_CKV = 1280, C_KR = 1408, C_WQ = 1440, C_WK = 1696, C_WV = 1824;
constexpr int NEXP = 16, FF = 768, CAP = 512, CAPC = 32;
constexpr float LOG2E = 1.4426950408889634f;

constexpr size_t O_CTL = 0;
constexpr size_t O_QCNT = 49152 + 1024;
constexpr size_t O_DEPW = 0;
constexpr size_t O_CANON = 49152 + 512;
constexpr size_t O_QXCD = 49152 + 4096;
constexpr size_t O_DEPX = 32768;
constexpr size_t O_RETLG = 49152;
constexpr size_t O_MOD = 65536;
constexpr size_t O_XC = 524288;
constexpr size_t O_AFF = O_XC + 8388608;
constexpr size_t O_IDX = O_AFF + 2228224;
constexpr size_t O_GATE = O_IDX + 262144;
constexpr size_t O_IDXC = O_GATE + 262144;
constexpr size_t O_GATEC = O_IDXC + 16384;
constexpr size_t O_SLOT = O_GATEC + 16384;
constexpr size_t O_WQ = O_SLOT + 1114112;
constexpr size_t O_WK = O_WQ + 17825792;
constexpr size_t O_WV = O_WK + 8912896;
constexpr size_t O_HX = O_WV + 8912896;
constexpr size_t O_P = O_HX + 71303168;
constexpr size_t O_QM = O_P + 142606336;
constexpr size_t O_KM = O_QM + 53477376;
constexpr size_t O_VM = O_KM + 53477376;
constexpr size_t O_END = O_VM + 35651584;
constexpr size_t O_WINT = O_END;
constexpr size_t O_WOUTT = O_WINT + 2 * 2048 * 1024 * 2;
constexpr size_t O_WGUT = O_WOUTT + 2 * 1024 * 1024 * 2;
constexpr size_t O_WDT = O_WGUT + (size_t)16 * 1536 * 1024 * 2;
constexpr size_t O_END2 = O_WDT + (size_t)16 * 1024 * 768 * 2;

constexpr size_t O_VT = O_END2;
constexpr size_t O_END3 = O_VT + 35651584;
constexpr size_t O_WVT = O_WV;
constexpr size_t O_RVT = O_WGUT;
constexpr size_t O_KVF = O_RVT + 17825792;
constexpr size_t O_KVB = O_KVF + 17825792;
constexpr size_t O_SPF = O_KVB + 17825792;
constexpr size_t O_SPB = O_SPF + 8912896;
static_assert(O_SPB + 8912896 <= O_WDT + (size_t)16 * 1024 * 768 * 2, "retention buffers fit in the expert-weight region");
constexpr size_t O_WUQT = O_END3;
constexpr size_t O_WUKT = O_WUQT + 2 * 768 * 256 * 2;
constexpr size_t O_WUVT = O_WUKT + 2 * 512 * 128 * 2;
constexpr size_t O_END4 = O_WUVT + 2 * 512 * 128 * 2;
constexpr size_t O_SSQ = O_WQ;
constexpr size_t O_HID = O_P;
constexpr size_t O_HIDC = O_P + 100663296;
constexpr size_t O_YS = O_QM;
constexpr size_t O_YSC = O_QM + 134217728;

struct Params {
    const float *x, *c, *ctx, *c_ctx, *norm1_g, *norm2_g, *ada_w, *ada_b, *w_in, *ret_decay_f, *ret_decay_b,
        *mla_qnorm_g, *mla_kvnorm_g, *mla_w_uq, *mla_w_uk, *mla_w_uv, *win_sink, *w_out, *router_w,
        *exp_w_gate, *exp_w_up, *exp_w_down, *final_g;
    float* out; unsigned char* ws;
};

typedef const __attribute__((address_space(4))) Params KParams;
__device__ __forceinline__ int opaque_tid() { int t = (int)threadIdx.x; asm volatile("" : "+v"(t)); return t; }
#define STAGE_PARAMS() KParams* pp_ = (KParams*)__builtin_amdgcn_kernarg_segment_ptr(); asm volatile("" : "+s"(pp_)); KParams& p = *pp_; const int tid_ = opaque_tid(); int bid_ = (int)blockIdx.x, G_ = (int)gridDim.x; asm volatile("" : "+s"(bid_), "+s"(G_))
__device__ __forceinline__ float bf2f(bf16_t v) { return __uint_as_float(((unsigned)v) << 16); }
__device__ __forceinline__ float bflo(unsigned v) { return __uint_as_float(v << 16); }
__device__ __forceinline__ float bfhi(unsigned v) { return __uint_as_float(v & 0xffff0000u); }
__device__ __forceinline__ unsigned f2bf(float f) { unsigned u = __float_as_uint(f); return (u + 0x7fffu + ((u >> 16) & 1u)) >> 16; }
__device__ __forceinline__ unsigned pk2(float lo, float hi) { return f2bf(lo) | (f2bf(hi) << 16); }
__device__ __forceinline__ float wave_sum(float v) {
    v += __int_as_float(__builtin_amdgcn_ds_swizzle(__float_as_int(v), (1 << 10) | 0x1f));
    v += __int_as_float(__builtin_amdgcn_ds_swizzle(__float_as_int(v), (2 << 10) | 0x1f));
    v += __int_as_float(__builtin_amdgcn_ds_swizzle(__float_as_int(v), (4 << 10) | 0x1f));
    v += __int_as_float(__builtin_amdgcn_ds_swizzle(__float_as_int(v), (8 << 10) | 0x1f));
    v += __int_as_float(__builtin_amdgcn_ds_swizzle(__float_as_int(v), (16 << 10) | 0x1f));
    const auto rr = __builtin_amdgcn_permlane32_swap(__float_as_uint(v), __float_as_uint(v), false, false);
    return __uint_as_float(rr[0]) + __uint_as_float(rr[1]);
}
__device__ __forceinline__ float wave_max(float v) {
    v = fmaxf(v, __int_as_float(__builtin_amdgcn_ds_swizzle(__float_as_int(v), (1 << 10) | 0x1f)));
    v = fmaxf(v, __int_as_float(__builtin_amdgcn_ds_swizzle(__float_as_int(v), (2 << 10) | 0x1f)));
    v = fmaxf(v, __int_as_float(__builtin_amdgcn_ds_swizzle(__float_as_int(v), (4 << 10) | 0x1f)));
    v = fmaxf(v, __int_as_float(__builtin_amdgcn_ds_swizzle(__float_as_int(v), (8 << 10) | 0x1f)));
    v = fmaxf(v, __int_as_float(__builtin_amdgcn_ds_swizzle(__float_as_int(v), (16 << 10) | 0x1f)));
    const auto rr = __builtin_amdgcn_permlane32_swap(__float_as_uint(v), __float_as_uint(v), false, false);
    return fmaxf(__uint_as_float(rr[0]), __uint_as_float(rr[1]));
}
__device__ __forceinline__ float lane_bcast(float v, int srclane  ) { return __uint_as_float(__builtin_amdgcn_readlane(__float_as_uint(v), srclane)); }
__device__ __forceinline__ float silu_f(float v) { return v / (1.f + expf(-v)); }

#define WSP(T, off) ((T*)(p.ws + (off)))
template <class PT> __device__ __forceinline__ float* xrow_ptr(const PT& p, int row) { return row < NLAT ? p.out + (size_t)row * DM : WSP(float, O_XC) + (size_t)(row - NLAT) * DM; }
template <class PT> __device__ __forceinline__ const float* mod_ptr(const PT& p, int layer, int bv, int chunk) { return WSP(const float, O_MOD) + ((size_t)(layer * 9 + bv) * 6 + chunk) * 1024; }
struct RowInfo { int b, t, isctx, bv, key; };
__device__ __forceinline__ RowInfo row_info(int row) {
    RowInfo r;
    if (row < NLAT) { r.b = row >> 12; r.t = row & 4095; r.isctx = 0; r.bv = r.b; r.key = 256 + r.t; }
    else { const int q = row - NLAT; r.b = q >> 8; r.t = q & 255; r.isctx = 1; r.bv = 8; r.key = r.t; }
    return r;
}

__constant__ float ROPE_INV8[8] = {1.f, 0.31622776601683794f, 0.1f, 0.031622776601683794f, 0.01f, 0.0031622776601683794f, 0.001f, 0.00031622776601683794f};
__constant__ float ROPE_INV16[16] = {1.f, 0.5623413251903491f, 0.31622776601683794f, 0.1778279410038923f, 0.1f, 0.05623413251903491f, 0.031622776601683794f, 0.01778279410038923f,
                                     0.01f, 0.005623413251903491f, 0.0031622776601683794f, 0.001778279410038923f, 0.001f, 0.0005623413251903491f, 0.00031622776601683794f, 0.0001778279410038923f};
__device__ __forceinline__ void sincos_acc(float ang, float& s, float& c) {
    float rev = ang * 0.15915494309189535f;
    rev -= floorf(rev);
    s = __builtin_amdgcn_sinf(rev); c = __builtin_amdgcn_cosf(rev);
}

__device__ __forceinline__ int vcu_of(int bid, int G) { return (G % 8 == 0) ? (bid % 8) * (G / 8) + bid / 8 : bid; }
__device__ __forceinline__ void st_mods(char* smem) {
    STAGE_PARAMS();
    float* sv = (float*)smem;
    float* red = sv + 9 * 1024;
    const int tid = tid_;
    if (bid_ == 0 && tid < 16) { const int l = tid >> 3, dir = (tid >> 2) & 1, h = tid & 3;
        const double dec = (double)(dir ? p.ret_decay_b : p.ret_decay_f)[l * 4 + h];
        WSP(float, O_RETLG)[tid] = (float)(log1p(-exp2(dec)) * 1.4426950408889634); }
    for (int i = tid; i < 9 * 1024; i += 512) { const int v = i >> 10, k = i & 1023; const float c = v < 8 ? p.c[v * 1024 + k] : p.c_ctx[k]; sv[i] = silu_f(c); }
    __syncthreads();
    for (int item = bid_; item < 2 * 96; item += G_) {
        const int l = item / 96, j0 = (item % 96) * 64, col = tid & 63, kq = tid >> 6;
        float acc[9];
#pragma unroll
        for (int v = 0; v < 9; ++v) acc[v] = 0.f;
        const float* W = p.ada_w + (size_t)l * 1024 * 6144 + j0 + col;
        for (int k = kq * 128; k < kq * 128 + 128; ++k) {
            const float w = W[(size_t)k * 6144];
#pragma unroll
            for (int v = 0; v < 9; ++v) acc[v] += sv[v * 1024 + k] * w;
        }
#pragma unroll
        for (int v = 0; v < 9; ++v) red[(kq * 9 + v) * 64 + col] = acc[v];
        __syncthreads();
        for (int i = tid; i < 576; i += 512) {
            const int v = i >> 6, cc = i & 63; float s = 0.f;
#pragma unroll
            for (int q = 0; q < 8; ++q) s += red[(q * 9 + v) * 64 + cc];
            WSP(float, O_MOD)[(size_t)(l * 9 + v) * 6144 + j0 + cc] = s + p.ada_b[l * 6144 + j0 + cc];
        }
        __syncthreads();
    }
}

__device__ __forceinline__ void st_rownorm(int mode) {
    STAGE_PARAMS();
    typedef float f32x4v __attribute__((ext_vector_type(4)));
    const int lane = tid_ & 63, wave = tid_ >> 6;
    const int gw = bid_ * 8 + wave, NGW = G_ * 8;
    const int nrows = mode == 2 ? NLAT : NROWS;
    f32x4v vn[4]; uint4 sn0 = make_uint4(0u, 0u, 0u, 0u), sn1 = sn0;
#define RN_SRC(r) (mode == 0 ? ((r) >= NLAT ? p.ctx + (size_t)((r) - NLAT) * DM : p.x + (size_t)(r) * DM) : (const float*)xrow_ptr(p, (r)))
    if (gw < nrows) { const float* src = RN_SRC(gw);
#pragma unroll
        for (int j = 0; j < 4; ++j) vn[j] = ((const f32x4v*)src)[lane + 64 * j];
        if (mode != 0) { const uint4* sl = (const uint4*)(WSP(const short, O_SLOT) + (size_t)gw * 16); sn0 = sl[0]; sn1 = sl[1]; } }
    for (int row = gw; row < nrows; row += NGW) {
        const RowInfo ri = row_info(row);
        f32x4v v[4];
#pragma unroll
        for (int j = 0; j < 4; ++j) v[j] = vn[j];
        const unsigned sw[8] = {sn0.x, sn0.y, sn0.z, sn0.w, sn1.x, sn1.y, sn1.z, sn1.w};
        const int nrow = row + NGW;
        if (nrow < nrows) { const float* src = RN_SRC(nrow);
#pragma unroll
            for (int j = 0; j < 4; ++j) vn[j] = ((const f32x4v*)src)[lane + 64 * j];
            if (mode != 0) { const uint4* sl = (const uint4*)(WSP(const short, O_SLOT) + (size_t)nrow * 16); sn0 = sl[0]; sn1 = sl[1]; } }
        f32x4v pg5[4], pg1[4], psc[4], psh[4];
        {   const float* g5p = mode != 0 ? mod_ptr(p, mode - 1, ri.bv, 5) : p.final_g;
            const float* g1p = mode == 2 ? p.final_g : p.norm1_g + mode * 1024;
            const float* shp = mode == 2 ? p.final_g : mod_ptr(p, mode, ri.bv, 0); const float* scp = mode == 2 ? p.final_g : mod_ptr(p, mode, ri.bv, 1);
#pragma unroll
            for (int j = 0; j < 4; ++j) { if (mode != 0) pg5[j] = ((const f32x4v*)g5p)[lane + 64 * j]; pg1[j] = ((const f32x4v*)g1p)[lane + 64 * j];
                if (mode != 2) { psc[j] = ((const f32x4v*)scp)[lane + 64 * j]; psh[j] = ((const f32x4v*)shp)[lane + 64 * j]; } } }
        __builtin_amdgcn_sched_barrier(0);
        if (mode != 0) {
            const int lprev = mode - 1;
            f32x4v a[4];
#pragma unroll
            for (int j = 0; j < 4; ++j) a[j] = (f32x4v){0.f, 0.f, 0.f, 0.f};
#pragma unroll
            for (int g8 = 0; g8 < 4; ++g8) {
                uint2 yb[4][4];
#pragma unroll
                for (int k = 0; k < 4; ++k) { const int e = 4 * g8 + k;
                    const int s = (int)(short)((e & 1) ? (sw[e >> 1] >> 16) : (sw[e >> 1] & 0xffffu));
                    if (s >= 0) {
                        const bf16_t* yr = ri.isctx ? WSP(const bf16_t, O_YSC) + ((size_t)e * 256 + ri.b * 32 + s) * 1024
                                                    : WSP(const bf16_t, O_YS) + ((size_t)(ri.b * 16 + e) * 512 + s) * 1024;
#pragma unroll
                        for (int j = 0; j < 4; ++j) yb[k][j] = ((const uint2*)yr)[lane + 64 * j];
                    } }
                __builtin_amdgcn_sched_barrier(0);
#pragma unroll
                for (int k = 0; k < 4; ++k) { const int e = 4 * g8 + k;
                    const int s = (int)(short)((e & 1) ? (sw[e >> 1] >> 16) : (sw[e >> 1] & 0xffffu));
                    if (s >= 0) {
#pragma unroll
                        for (int j = 0; j < 4; ++j) { const uint2 u = yb[k][j]; a[j].x += bflo(u.x); a[j].y += bfhi(u.x); a[j].z += bflo(u.y); a[j].w += bfhi(u.y); }
                    } }
            }
            float* dst = xrow_ptr(p, row);
#pragma unroll
            for (int j = 0; j < 4; ++j) {
                v[j] += pg5[j] * a[j];
                if (mode == 1) ((f32x4v*)dst)[lane + 64 * j] = v[j];
            }
        }
        float ss = 0.f;
#pragma unroll
        for (int j = 0; j < 4; ++j) ss += v[j].x * v[j].x + v[j].y * v[j].y + v[j].z * v[j].z + v[j].w * v[j].w;
        ss = wave_sum(ss);
        const float rstd = rsqrtf(ss * (1.f / 1024.f) + 1e-6f);
        if (mode == 2) {
#pragma unroll
            for (int j = 0; j < 4; ++j) ((f32x4v*)(p.out + (size_t)row * DM))[lane + 64 * j] = v[j] * rstd * pg1[j];
        } else {
            const int layer = mode;
            bf16_t* hx = WSP(bf16_t, O_HX) + (size_t)row * DM;
#pragma unroll
            for (int j = 0; j < 4; ++j) {
                const f32x4v h = v[j] * rstd * pg1[j] * (psc[j] + 1.f) + psh[j];
                ((uint2*)hx)[lane + 64 * j] = make_uint2(pk2(h.x, h.y), pk2(h.z, h.w));
            }
        }
    }
#undef RN_SRC
}

__device__ __forceinline__ int opq(int v) { asm volatile("" : "+v"(v)); return v; }


__device__ __forceinline__ void st_norm2_router(int layer, char* smem, bool canon) {
    STAGE_PARAMS();
    typedef float f32x4v __attribute__((ext_vector_type(4)));
    typedef short bf16x8v __attribute__((ext_vector_type(8)));
    typedef unsigned u32x4v __attribute__((ext_vector_type(4)));
    LAS unsigned char* lds = (LAS unsigned char*)(LAS char*)smem;
    constexpr int WS = 2064;
    LAS unsigned short* whi = (LAS unsigned short*)lds; LAS unsigned short* wlo = (LAS unsigned short*)(lds + 16 * WS);
    LAS float* gg = (LAS float*)(lds + 32 * WS); LAS float* s4 = gg + 1024;
    const int tid = tid_, lane = tid & 63, wave = tid >> 6, r16 = lane & 15, kg = lane >> 4;
    const int nrows = layer == 0 ? NROWS : NLAT;
    { const float* RW = p.router_w + (size_t)layer * 1024 * 16;
      for (int i = tid; i < 1024 * 16; i += 512) { const float w = RW[i]; const unsigned hi = f2bf(w); const unsigned lo = f2bf(w - __uint_as_float(hi << 16));
          whi[(i & 15) * (WS / 2) + (i >> 4)] = (unsigned short)hi; wlo[(i & 15) * (WS / 2) + (i >> 4)] = (unsigned short)lo; } }
    const float* g2 = p.norm2_g + layer * 1024;
    const int cx = vcu_of(bid_, G_), xj = cx & 31, xx = cx >> 5;
    const int nmine = canon ? 1 + ((layer == 0 && (xj == 2 || xj == 3)) ? 1 : 0) : (nrows / 128 - bid_ + G_ - 1) / G_;
    for (int kk = 0; kk < nmine; ++kk) {
        int chunk;
        if (canon) { const int mt = kk == 0 ? xj >> 1 : 16, pm = mt < 8 ? 8 * xx + mt : (mt < 16 ? 64 + 8 * xx + (mt - 8) : 128 + xx); chunk = pm * 2 + (xj & 1);
            if (tid == 0) { const unsigned* dw = WSP(const unsigned, O_DEPX) + (layer * 136 + pm) * 8;
                for (unsigned spins = 0; __hip_atomic_load(dw, __ATOMIC_RELAXED, __HIP_MEMORY_SCOPE_AGENT) < 32u && spins < (1u << 24); ++spins) __builtin_amdgcn_s_sleep(2);
                __builtin_amdgcn_fence(__ATOMIC_ACQUIRE, "agent"); asm volatile("s_waitcnt vmcnt(0)" ::: "memory"); } }
        else chunk = bid_ + kk * G_;
        const int row0 = chunk * 128; const RowInfo ri = row_info(row0);
        __syncthreads();
        { const float* sh = mod_ptr(p, layer, ri.bv, 3); const float* sc = mod_ptr(p, layer, ri.bv, 4);
          for (int i = tid; i < 1024; i += 512) { gg[i] = g2[i] * (1.f + sc[i]); s4[i] = sh[i]; } }
        __syncthreads();
        const int row = row0 + wave * 16 + r16;
        const f32x4v* xr = (const f32x4v*)xrow_ptr(p, row) + 2 * kg;
        float ss;
        { const float* sq = WSP(const float, O_SSQ) + (size_t)(4 * kg) * NROWS + row; ss = (sq[0] + sq[NROWS]) + (sq[2 * (size_t)NROWS] + sq[3 * (size_t)NROWS]); }
        ss += __int_as_float(__builtin_amdgcn_ds_swizzle(__float_as_int(ss), (16 << 10) | 0x1f));
        { const auto rr = __builtin_amdgcn_permlane32_swap(__float_as_uint(ss), __float_as_uint(ss), false, false); ss = __uint_as_float(rr[0]) + __uint_as_float(rr[1]); }
        const float rstd = rsqrtf(ss * (1.f / 1024.f) + 1e-6f);
        bf16_t* h2 = WSP(bf16_t, O_HX) + (size_t)row * DM + 8 * kg;
        const LAS unsigned char* wb = lds + r16 * WS + 16 * kg;
        f32x4v acc = (f32x4v){0.f, 0.f, 0.f, 0.f};
        f32x4v xa[4], xb[4];
#pragma unroll
        for (int j = 0; j < 4; ++j) { xa[j] = xr[8 * j]; xb[j] = xr[8 * j + 1]; }
#pragma unroll 1
        for (int sg = 0; sg < 32; sg += 4) {
          f32x4v ca[4], cb[4];
#pragma unroll
          for (int j = 0; j < 4; ++j) { ca[j] = xa[j]; cb[j] = xb[j]; }
          if (sg + 4 < 32) {
#pragma unroll
              for (int j = 0; j < 4; ++j) { xa[j] = xr[8 * (sg + 4 + j)]; xb[j] = xr[8 * (sg + 4 + j) + 1]; } }
          __builtin_amdgcn_sched_barrier(0);
#pragma unroll
          for (int j = 0; j < 4; ++j) {
            const int s = sg + j;
            const f32x4v a = ca[j], b = cb[j];
            const f32x4v ga = *(const LAS f32x4v*)(gg + 32 * s + 8 * kg), gb = *(const LAS f32x4v*)(gg + 32 * s + 8 * kg + 4), sa = *(const LAS f32x4v*)(s4 + 32 * s + 8 * kg), sb = *(const LAS f32x4v*)(s4 + 32 * s + 8 * kg + 4);
            const f32x4v ha = a * rstd * ga + sa, hb = b * rstd * gb + sb;
            u32x4v hi, lo;
            hi.x = pk2(ha.x, ha.y); hi.y = pk2(ha.z, ha.w); hi.z = pk2(hb.x, hb.y); hi.w = pk2(hb.z, hb.w);
            lo.x = pk2(ha.x - bflo(hi.x), ha.y - bfhi(hi.x)); lo.y = pk2(ha.z - bflo(hi.y), ha.w - bfhi(hi.y));
            lo.z = pk2(hb.x - bflo(hi.z), hb.y - bfhi(hi.z)); lo.w = pk2(hb.z - bflo(hi.w), hb.w - bfhi(hi.w));
            *(u32x4v*)(h2 + 32 * s) = hi;
            const bf16x8v wh = *(const LAS bf16x8v*)(wb + 64 * s), wl = *(const LAS bf16x8v*)(wb + 16 * WS + 64 * s);
            const bf16x8v hiv = __builtin_bit_cast(bf16x8v, hi), lov = __builtin_bit_cast(bf16x8v, lo);
            acc = __builtin_amdgcn_mfma_f32_16x16x32_bf16(hiv, wh, acc, 0, 0, 0);
            acc = __builtin_amdgcn_mfma_f32_16x16x32_bf16(hiv, wl, acc, 0, 0, 0);
            acc = __builtin_amdgcn_mfma_f32_16x16x32_bf16(lov, wh, acc, 0, 0, 0);
          }
        }
#pragma unroll
        for (int q = 0; q < 4; ++q) {
            float mx = acc[q];
            mx = fmaxf(mx, __int_as_float(__builtin_amdgcn_ds_swizzle(__float_as_int(mx), (1 << 10) | 0x1f)));
            mx = fmaxf(mx, __int_as_float(__builtin_amdgcn_ds_swizzle(__float_as_int(mx), (2 << 10) | 0x1f)));
            mx = fmaxf(mx, __int_as_float(__builtin_amdgcn_ds_swizzle(__float_as_int(mx), (4 << 10) | 0x1f)));
            mx = fmaxf(mx, __int_as_float(__builtin_amdgcn_ds_swizzle(__float_as_int(mx), (8 << 10) | 0x1f)));
            const float ex = expf(acc[q] - mx);
            float sm = ex;
            sm += __int_as_float(__builtin_amdgcn_ds_swizzle(__float_as_int(sm), (1 << 10) | 0x1f));
            sm += __int_as_float(__builtin_amdgcn_ds_swizzle(__float_as_int(sm), (2 << 10) | 0x1f));
            sm += __int_as_float(__builtin_amdgcn_ds_swizzle(__float_as_int(sm), (4 << 10) | 0x1f));
            sm += __int_as_float(__builtin_amdgcn_ds_swizzle(__float_as_int(sm), (8 << 10) | 0x1f));
            WSP(float, O_AFF)[(size_t)(row0 + wave * 16 + 4 * kg + q) * 16 + r16] = ex / sm;
        }
    }
    __syncthreads();
}

__device__ __forceinline__ void st_topk(int layer, char* smem) {
    STAGE_PARAMS();
    float* wcnt = (float*)smem;
    unsigned* wsum = (unsigned*)(wcnt + 24);
    const int tid = tid_, lane = tid & 63, wave = tid >> 6;
    const int nprob = layer == 0 ? 256 : 128;
    const float* AFF = WSP(const float, O_AFF);
    for (int pr = bid_; pr < nprob; pr += G_) {
        const bool isctx = pr >= 128; const int be = pr & 127, b = be >> 4, e = be & 15;
        const int n = isctx ? CTXL : SEQ, kk = isctx ? CAPC : CAP;
        const size_t row0 = isctx ? (size_t)NLAT + b * CTXL : (size_t)b * SEQ;
        unsigned kx[8];
#pragma unroll
        for (int u = 0; u < 8; ++u) { const int t = tid * 8 + u; kx[u] = (t < n) ? __float_as_uint(AFF[(row0 + t) * 16 + e]) : 0u; }
        __syncthreads();
        unsigned T = 0u; int par = 0;
        for (int bit = 29; bit >= -1; --bit) {
            const unsigned cand = bit >= 0 ? (T | (1u << bit)) : T + 1u;
            float c = 0.f;
#pragma unroll
            for (int u = 0; u < 8; ++u) c += (kx[u] >= cand) ? 1.f : 0.f;
            c = wave_sum(c);
            if (lane == 0) wcnt[par * 8 + wave] = c;
            __syncthreads();
            float tot = 0.f;
#pragma unroll
            for (int w = 0; w < 8; ++w) tot += wcnt[par * 8 + w];
            par ^= 1;
            if (bit >= 0) { if (tot >= (float)kk) T = cand; }
            else wcnt[16 + 0] = tot;
        }
        __syncthreads();
        const int krem = kk - (int)wcnt[16];
        unsigned cg = 0u, ce = 0u;
#pragma unroll
        for (int u = 0; u < 8; ++u) { cg += (kx[u] > T) ? 1u : 0u; ce += (kx[u] == T) ? 1u : 0u; }
        const unsigned packed = cg | (ce << 16);
        unsigned incl = packed;
#pragma unroll
        for (int o = 1; o < 64; o <<= 1) { const unsigned t2 = (unsigned)__builtin_amdgcn_ds_bpermute(((lane - o) & 63) << 2, (int)incl); if (lane >= o) incl += t2; }
        if (lane == 63) wsum[wave] = incl;
        __syncthreads();
        unsigned off = 0u;
        for (int w = 0; w < wave; ++w) off += wsum[w];
        const unsigned excl = incl - packed + off;
        unsigned gpre = excl & 0xFFFFu, epre = excl >> 16;
        int* IDX = isctx ? WSP(int, O_IDXC) + e * 256 + b * CAPC : WSP(int, O_IDX) + be * CAP;
        float* GT = isctx ? WSP(float, O_GATEC) + e * 256 + b * CAPC : WSP(float, O_GATE) + be * CAP;
        short* SL = WSP(short, O_SLOT);
#pragma unroll
        for (int u = 0; u < 8; ++u) {
            const int t = tid * 8 + u;
            if (t < n) {
                const unsigned k = kx[u]; const bool g = k > T, eq = k == T;
                const bool sel = g || (eq && (int)epre < krem);
                const int slot = (int)gpre + ((int)epre < krem ? (int)epre : krem);
                if (sel) { IDX[slot] = (int)row0 + t; GT[slot] = __uint_as_float(k); }
                SL[(row0 + t) * 16 + e] = sel ? (short)slot : (short)-1;
                gpre += g ? 1u : 0u; epre += eq ? 1u : 0u;
            }
        }
        __syncthreads();
    }
}


namespace pg {
typedef short bf16x8 __attribute__((ext_vector_type(8)));
typedef float f32x4 __attribute__((ext_vector_type(4)));
typedef unsigned u32x4 __attribute__((ext_vector_type(4)));
constexpr int BM = 256, BK = 64, HALF = 128, HTB = HALF * BK * 2, STAGE_BYTES = 8 * HTB;
__device__ __forceinline__ int lds_byte(int r, int c) { const int st = (r >> 4) * 2 + (c >> 5), rr = r & 15, cc = c & 31, ob = rr * 64 + cc * 2; return st * 1024 + (ob ^ (((ob >> 9) & 1) << 5)); }
__device__ __forceinline__ void stage_rc(int b, int& R, int& C) { const int st = b / 1024, sb = b % 1024, swz = sb ^ (((sb >> 9) & 1) << 5); R = (st >> 1) * 16 + swz / 64; C = (st & 1) * 32 + (swz % 64) / 2; }
__device__ __forceinline__ int perm32(int rho) { const int n = rho >> 4, i = rho & 15; return 8 * (i >> 2) + 4 * n + (i & 3); }
__device__ __forceinline__ unsigned cvt_pk_bf16(float lo, float hi) { unsigned r; asm volatile("v_cvt_pk_bf16_f32 %0, %1, %2" : "=v"(r) : "v"(lo), "v"(hi)); return r; }

template <bool GATHER, class Epi, class Sched>
__device__ __forceinline__ void gemm_run(LAS unsigned char* lds, const int K, const Sched& S, const Epi& E, const int tid) {
    typedef typename Sched::Unit Unit;
    const int wid = __builtin_amdgcn_readfirstlane(tid >> 6), lane = tid & 63, wr = wid >> 2, wc = wid & 3, fr = lane & 15, fq = lane >> 4;
    const int nt = K / BK;
    int Rs[2], Cs[2]; unsigned voffB[2], voffA[2];
#pragma unroll
    for (int i = 0; i < 2; ++i) { stage_rc(tid * 16 + i * 8192, Rs[i], Cs[i]); const int Rb = (Rs[i] & ~31) + perm32(Rs[i] & 31); voffB[i] = (unsigned)(Rb * K + Cs[i]) * 2u; voffA[i] = (unsigned)(Rs[i] * K + Cs[i]) * 2u; }
    const size_t kstep = (size_t)(BK * 2);
    const size_t hstepB = (size_t)HALF * K * 2;
    const unsigned ldsw = (unsigned)wid * 1024u;
    const int aoff = lds_byte(wr * 64 + fr, fq * 8), boff = lds_byte(wc * 32 + fr, fq * 8);
#define PG_SA(b, h) (((b) * 2 + (h)) * HTB)
#define PG_SB(b, h) ((4 + (b) * 2 + (h)) * HTB)
#define PG_STAGE_B(bufoff, gbase) do { _Pragma("unroll") for (int _i = 0; _i < 2; ++_i) \
        __builtin_amdgcn_global_load_lds((const unsigned*)((const char*)(gbase) + voffB[_i]), (LAS unsigned*)(lds + (bufoff) + ldsw + _i * 8192), 16, 0, 0); } while (0)
#define PG_GLDS(src_, dst_) __builtin_amdgcn_global_load_lds((const unsigned*)(src_), (LAS unsigned*)(dst_), 16, 0, 0)
#define PG_STAGE_A(bufoff, gbase, h, NXT) do { \
        if constexpr (GATHER) { if (NXT) { PG_GLDS((const char*)(gbase) + ((h) ? on10 : on00), lds + (bufoff) + ldsw); PG_GLDS((const char*)(gbase) + ((h) ? on11 : on01), lds + (bufoff) + ldsw + 8192); } \
                                else     { PG_GLDS((const char*)(gbase) + ((h) ? oc10 : oc00), lds + (bufoff) + ldsw); PG_GLDS((const char*)(gbase) + ((h) ? oc11 : oc01), lds + (bufoff) + ldsw + 8192); } } \
        else { PG_GLDS((const char*)(gbase) + (size_t)(h) * hstepB + voffA[0], lds + (bufoff) + ldsw); PG_GLDS((const char*)(gbase) + (size_t)(h) * hstepB + voffA[1], lds + (bufoff) + ldsw + 8192); } } while (0)
#define PG_LDA(dst, b, h) do { _Pragma("unroll") for (int m = 0; m < 4; ++m) _Pragma("unroll") for (int k = 0; k < 2; ++k) dst[m][k] = *(const LAS bf16x8*)(lds + PG_SA(b, h) + aoff + m * 2048 + k * 1024); } while (0)
#define PG_LDB(dst, b, h) do { _Pragma("unroll") for (int n = 0; n < 2; ++n) _Pragma("unroll") for (int k = 0; k < 2; ++k) dst[n][k] = *(const LAS bf16x8*)(lds + PG_SB(b, h) + boff + n * 2048 + k * 1024); } while (0)
#define PG_MMA(ai, bj, At, Bt) do { __builtin_amdgcn_s_setprio(1); _Pragma("unroll") for (int m = 0; m < 4; ++m) _Pragma("unroll") for (int n = 0; n < 2; ++n) _Pragma("unroll") for (int k = 0; k < 2; ++k) \
        acc[ai][bj][m][n] = __builtin_amdgcn_mfma_f32_16x16x32_bf16(Bt[n][k], At[m][k], acc[ai][bj][m][n], 0, 0, 0); __builtin_amdgcn_s_setprio(0); } while (0)
#define PG_WAIT_V(n) asm volatile("s_waitcnt vmcnt(" #n ")" ::: "memory")
#define PG_WAIT_L(n) asm volatile("s_waitcnt lgkmcnt(" #n ")" ::: "memory")
#define PG_BAR __builtin_amdgcn_s_barrier()
#define PG_SCHED __builtin_amdgcn_sched_barrier(0)
    Unit cur, nxt; int ui = 0;
    if (!S.next(0, cur)) return;
    f32x4 acc[2][2][4][2];
#pragma unroll
    for (int a = 0; a < 2; ++a)
#pragma unroll
        for (int b = 0; b < 2; ++b)
#pragma unroll
            for (int m = 0; m < 4; ++m)
#pragma unroll
                for (int n = 0; n < 2; ++n) acc[a][b][m][n] = (f32x4){0.f, 0.f, 0.f, 0.f};
    bf16x8 At[4][2], B0[2][2], B1[2][2];
    unsigned oc00 = 0, oc01 = 0, oc10 = 0, oc11 = 0, on00 = 0, on01 = 0, on10 = 0, on11 = 0;
    if constexpr (GATHER) { oc00 = S.a_off(cur, Rs[0]) + (unsigned)Cs[0] * 2u; oc01 = S.a_off(cur, Rs[1]) + (unsigned)Cs[1] * 2u;
        oc10 = S.a_off(cur, HALF + Rs[0]) + (unsigned)Cs[0] * 2u; oc11 = S.a_off(cur, HALF + Rs[1]) + (unsigned)Cs[1] * 2u; }
    const char* cA = S.a_base(cur); const char* cB = S.b_base(cur);
    PG_STAGE_B(PG_SB(0, 0), cB); PG_STAGE_B(PG_SB(0, 1), cB + hstepB); PG_STAGE_A(PG_SA(0, 0), cA, 0, false); PG_STAGE_A(PG_SA(0, 1), cA, 1, false);
    if (wr == 1) PG_BAR;
    PG_WAIT_V(2); PG_BAR;
    PG_STAGE_B(PG_SB(1, 0), cB + kstep); PG_STAGE_A(PG_SA(1, 0), cA + kstep, 0, false); PG_STAGE_B(PG_SB(1, 1), cB + hstepB + kstep);
    PG_WAIT_V(6); PG_BAR;
    int psig = -1;
    for (;;) {
        const bool has_next = S.next(ui + 1, nxt);
        const char* nA = cA; const char* nB = cB;
        if (has_next) { nA = S.a_base(nxt); nB = S.b_base(nxt); }
        for (int t = 0; t < nt; t += 2) {
            const bool last = (t == nt - 2);
            if constexpr (GATHER) { if (last) {
                const Unit& nu = has_next ? nxt : cur;
                on00 = S.a_off(nu, Rs[0]) + (unsigned)Cs[0] * 2u; on01 = S.a_off(nu, Rs[1]) + (unsigned)Cs[1] * 2u;
                on10 = S.a_off(nu, HALF + Rs[0]) + (unsigned)Cs[0] * 2u; on11 = S.a_off(nu, HALF + Rs[1]) + (unsigned)Cs[1] * 2u; } }
            const char* a1 = cA + (size_t)(t + 1) * kstep;
            const char* a2 = last ? nA : cA + (size_t)(t + 2) * kstep; const char* b2 = last ? nB : cB + (size_t)(t + 2) * kstep;
            const char* a3 = a2 + kstep; const char* b3 = b2 + kstep;
            PG_LDB(B0, 0, 0); PG_LDB(B1, 0, 1); PG_SCHED; PG_LDA(At, 0, 0); PG_STAGE_A(PG_SA(1, 1), a1, 1, false);
            PG_WAIT_V(8); PG_WAIT_L(0); PG_BAR; PG_MMA(0, 0, At, B0); PG_MMA(0, 1, At, B1); PG_BAR; PG_SCHED;
            PG_LDA(At, 0, 1); PG_STAGE_B(PG_SB(0, 0), b2); PG_STAGE_B(PG_SB(0, 1), b2 + hstepB); PG_STAGE_A(PG_SA(0, 0), a2, 0, last);
            PG_WAIT_V(8); PG_WAIT_L(0); PG_BAR; PG_MMA(1, 0, At, B0); PG_MMA(1, 1, At, B1); PG_BAR; PG_SCHED;
            PG_LDB(B0, 1, 0); PG_LDB(B1, 1, 1); PG_SCHED; PG_LDA(At, 1, 0); PG_STAGE_A(PG_SA(0, 1), a2, 1, last);
            PG_WAIT_V(8); PG_WAIT_L(0); PG_BAR; PG_MMA(0, 0, At, B0); PG_MMA(0, 1, At, B1); PG_BAR; PG_SCHED;
            PG_LDA(At, 1, 1); PG_STAGE_B(PG_SB(1, 0), b3); PG_STAGE_B(PG_SB(1, 1), b3 + hstepB); PG_STAGE_A(PG_SA(1, 0), a3, 0, last);
            PG_WAIT_V(8); PG_WAIT_L(0); PG_BAR; PG_MMA(1, 0, At, B0); PG_MMA(1, 1, At, B1); PG_BAR; PG_SCHED;
        }
        if (wr == 0) PG_BAR;
        if (psig >= 0) E.signal(psig, lane);
        E(acc, cur, wr, wc, fr, fq);
        psig = __builtin_amdgcn_readfirstlane(E.sig(cur));
        if (!has_next) break;
#pragma unroll
        for (int a = 0; a < 2; ++a)
#pragma unroll
            for (int b = 0; b < 2; ++b)
#pragma unroll
                for (int m = 0; m < 4; ++m)
#pragma unroll
                    for (int n = 0; n < 2; ++n) acc[a][b][m][n] = (f32x4){0.f, 0.f, 0.f, 0.f};
        cur = nxt; cA = nA; cB = nB; if constexpr (GATHER) { oc00 = on00; oc01 = on01; oc10 = on10; oc11 = on11; } ++ui;
        if (wr == 1) PG_BAR;
    }
    PG_WAIT_V(0);
    if (psig >= 0) E.signal(psig, lane);
    PG_BAR;
#undef PG_SA
#undef PG_SB
#undef PG_STAGE_A
#undef PG_GLDS
#undef PG_STAGE_B
#undef PG_LDA
#undef PG_LDB
#undef PG_MMA
#undef PG_WAIT_V
#undef PG_WAIT_L
#undef PG_BAR
#undef PG_SCHED
}
}

__device__ __forceinline__ void transpose_item(const float* W, int K, int N, bf16_t* WT, int row_off, LAS float* scr, int item, int lane) {
    typedef float f32x4v __attribute__((ext_vector_type(4)));
    const int nblk = N / 32, kb = item / nblk, nb = item % nblk, k0 = 64 * kb, n0 = 32 * nb;
    const int kk = lane >> 3, n4 = (lane & 7) * 4;
    f32x4v v[8];
#pragma unroll
    for (int i = 0; i < 8; ++i) v[i] = *(const f32x4v*)(W + (size_t)(k0 + 8 * i + kk) * N + n0 + n4);
#pragma unroll
    for (int i = 0; i < 8; ++i) *(LAS f32x4v*)(scr + (8 * i + kk) * 36 + n4) = v[i];
    asm volatile("s_waitcnt lgkmcnt(0)" ::: "memory");
    const int n = lane & 31;
#pragma unroll
    for (int j = 0; j < 4; ++j) { const int c = (lane >> 5) + 2 * j; const LAS float* s = scr + (8 * c) * 36 + n;
        uint4 o; o.x = pk2(s[0 * 36], s[1 * 36]); o.y = pk2(s[2 * 36], s[3 * 36]); o.z = pk2(s[4 * 36], s[5 * 36]); o.w = pk2(s[6 * 36], s[7 * 36]);
        *(uint4*)(WT + (size_t)(row_off + n0 + n) * K + k0 + 8 * c) = o; }
    asm volatile("s_waitcnt lgkmcnt(0)" ::: "memory");
}
__device__ __forceinline__ void st_prep_weights(int which, int layer, char* smem, int vb, int nb) {
    STAGE_PARAMS();
    if (vb < 0) return;
    const int lane = tid_ & 63, wave = tid_ >> 6;
    LAS float* scr = (LAS float*)(LAS char*)smem + wave * (64 * 36);
    const int gw = vb * 8 + wave, NGW = nb * 8;
    if (which == 0) {
        constexpr int I_IN = 16 * 61, I_OUT = 16 * 32;
        for (int it = gw; it < 2 * (I_IN + I_OUT); it += NGW) {
            const int l = it / (I_IN + I_OUT); int r = it % (I_IN + I_OUT);
            if (r < I_IN) transpose_item(p.w_in + (size_t)l * 1024 * PCOLS, 1024, PCOLS, WSP(bf16_t, O_WINT) + (size_t)l * 2048 * 1024, 0, scr, r, lane);
            else transpose_item(p.w_out + (size_t)l * 1024 * 1024, 1024, 1024, WSP(bf16_t, O_WOUTT) + (size_t)l * 1024 * 1024, 0, scr, r - I_IN, lane);
        }
        for (int it = gw; it < 2 * 640; it += NGW) {
            const int l = it / 640, r = it % 640;
            const float* W; int N, n, s_; bf16_t* dst;
            if (r < 384) { const int f = r, hd = f / 48, nb = (f / 16) % 3; s_ = f % 16; W = p.mla_w_uq + (size_t)l * 256 * 768; N = 768; n = 96 * hd + 32 * nb + (lane & 31); dst = WSP(bf16_t, O_WUQT) + (size_t)l * 768 * 256 + (size_t)f * 512; }
            else { const int f = (r - 384) & 127, hd = f / 16, nb = (f / 8) & 1; s_ = f % 8; const bool isv = r >= 512; W = (isv ? p.mla_w_uv : p.mla_w_uk) + (size_t)l * 128 * 512; N = 512; n = 64 * hd + 32 * nb + (lane & 31);
                dst = WSP(bf16_t, isv ? O_WUVT : O_WUKT) + (size_t)l * 512 * 128 + (size_t)f * 512; }
            const float* src = W + (size_t)(16 * s_ + 8 * (lane >> 5)) * N + n;
            float v[8];
#pragma unroll
            for (int j = 0; j < 8; ++j) v[j] = src[(size_t)j * N];
            *(uint4*)(dst + lane * 8) = make_uint4(pk2(v[0], v[1]), pk2(v[2], v[3]), pk2(v[4], v[5]), pk2(v[6], v[7]));
        }
        for (int i = gw * 64 + lane; i < 2 * 96 * 128; i += NGW * 64) { const int l = i / (96 * 128), r = i % (96 * 128);
            ((uint4*)(WSP(bf16_t, O_WINT) + ((size_t)l * 2048 + 1952) * 1024))[r] = make_uint4(0u, 0u, 0u, 0u); }
    } else {
        constexpr int I_G = 16 * 24, I_D = 12 * 32;
        for (int it = gw; it < 16 * (2 * I_G + I_D); it += NGW) {
            const int e = it / (2 * I_G + I_D); int r = it % (2 * I_G + I_D);
            const size_t le = (size_t)(layer * 16 + e);
            if (r < 2 * I_G) {
                const bool up = r >= I_G; if (up) r -= I_G;
                const int nb = r % 24;
                const int n0 = nb * 32, dst0 = (n0 >> 7) * 256 + (up ? 128 : 0) + (n0 & 127);
                transpose_item((up ? p.exp_w_up : p.exp_w_gate) + le * 1024 * FF, 1024, FF, WSP(bf16_t, O_WGUT) + (size_t)e * 1536 * 1024, dst0 - n0, scr, r, lane);
            } else transpose_item(p.exp_w_down + le * FF * 1024, FF, 1024, WSP(bf16_t, O_WDT) + (size_t)e * 1024 * FF, 0, scr, r - 2 * I_G, lane);
        }
    }
}

struct SchedWin {
    struct Unit { int pm, pn; };
    const char* A; const char* B; int G, c; bool canon;
    __device__ __forceinline__ bool next(int i, Unit& u) const { const int L = i * G + c;
        if (canon && L >= 1024) { if (L >= 1280 || (c & 31) >= 8) return false; u.pm = 128 + (c >> 5); u.pn = c & 7; return true; }
        if (L >= 136 * 8) return false; u.pm = L >> 3; u.pn = L & 7; return true; }
    __device__ __forceinline__ const char* a_base(const Unit& u) const { return A + (size_t)u.pm * 256 * 2048; }
    __device__ __forceinline__ unsigned a_off(const Unit&, int) const { return 0u; }
    __device__ __forceinline__ const char* b_base(const Unit& u) const { return B + (size_t)u.pn * 256 * 2048; }
};
struct EpiWin {
    bf16_t* P; unsigned* dep; bool plain;
    __device__ __forceinline__ void operator()(const pg::f32x4 (&acc)[2][2][4][2], const SchedWin::Unit& u, int wr, int wc, int fr, int fq) const {
        fr = opq(fr); fq = opq(fq);
#pragma unroll
        for (int ai = 0; ai < 2; ++ai)
#pragma unroll
            for (int m = 0; m < 4; ++m) { bf16_t* rowp = P + (size_t)(u.pm * 256 + ai * 128 + wr * 64 + m * 16 + fr) * PLD + u.pn * 256 + wc * 32 + 8 * fq;
#pragma unroll
                for (int bj = 0; bj < 2; ++bj) { const pg::f32x4 v0 = acc[ai][bj][m][0], v1 = acc[ai][bj][m][1];
                    pg::u32x4 w; w.x = pg::cvt_pk_bf16(v0[0], v0[1]); w.y = pg::cvt_pk_bf16(v0[2], v0[3]); w.z = pg::cvt_pk_bf16(v1[0], v1[1]); w.w = pg::cvt_pk_bf16(v1[2], v1[3]);
                    if (plain) *(pg::u32x4*)(rowp + bj * 128) = w;
                    else asm volatile("global_store_dwordx4 %0, %1, off sc1\n\ts_nop 1" :: "v"(rowp + bj * 128), "v"(w) : "memory"); } }
    }
    __device__ __forceinline__ int sig(const SchedWin::Unit& u) const { return u.pm * 8; }
    __device__ __forceinline__ void signal(int i, int lane) const { if (lane == 0) __hip_atomic_fetch_add(dep + i, 1u, __ATOMIC_RELAXED, __HIP_MEMORY_SCOPE_AGENT); }
};
__device__ __forceinline__ void st_gemm_win_fast(int layer, char* smem, bool canon) {
    STAGE_PARAMS();
    SchedWin S{(const char*)WSP(bf16_t, O_HX), (const char*)(WSP(bf16_t, O_WINT) + (size_t)layer * 2048 * 1024), G_, vcu_of(bid_, G_), canon};
    EpiWin E{WSP(bf16_t, O_P), WSP(unsigned, O_DEPW) + layer * 136 * 8, canon};
    pg::gemm_run<false>((LAS unsigned char*)(LAS char*)smem, 1024, S, E, tid_);
}
struct SchedWout {
    struct Unit { int pm, pn; };
    const char* A; const char* B; int G, c, nunits; bool canon;
    __device__ __forceinline__ bool next(int i, Unit& u) const { const int L = i * G + c;
        if (canon && L >= 512) { if (L >= 768 || nunits <= 512 || (c & 31) >= 4) return false; u.pm = 128 + (c >> 5); u.pn = c & 3; return true; }
        if (L >= nunits) return false; u.pm = L >> 2; u.pn = L & 3; return true; }
    __device__ __forceinline__ const char* a_base(const Unit& u) const { return A + (size_t)u.pm * 256 * 2048; }
    __device__ __forceinline__ unsigned a_off(const Unit&, int) const { return 0u; }
    __device__ __forceinline__ const char* b_base(const Unit& u) const { return B + (size_t)u.pn * 256 * 2048; }
};
struct EpiWout {
    const float* xin_lat; const float* xin_ctx; float* xo_lat; float* xo_ctx; const float* mod2; LAS float* stage; float* ssq; unsigned* dep; bool canon;
    __device__ __forceinline__ void operator()(const pg::f32x4 (&acc)[2][2][4][2], const SchedWout::Unit& u, int wr, int wc, int fr, int fq) const {
        fr = opq(fr); fq = opq(fq);
        const bool isctx = u.pm >= 128; const int bv = isctx ? 8 : (u.pm >> 4);
        const float* xin = isctx ? xin_ctx + (size_t)(u.pm - 128) * 256 * DM : xin_lat + (size_t)u.pm * 256 * DM;
        float* xo = isctx ? xo_ctx + (size_t)(u.pm - 128) * 256 * DM : xo_lat + (size_t)u.pm * 256 * DM;
        const float* g = mod2 + (size_t)bv * 6144 + u.pn * 256 + wc * 32 + 8 * fq;
        pg::f32x4 gv[2][2];
#pragma unroll
        for (int bj = 0; bj < 2; ++bj)
#pragma unroll
            for (int n = 0; n < 2; ++n) gv[bj][n] = *(const pg::f32x4*)(g + bj * 128 + 4 * n);
        LAS float* st = stage + (wr * 4 + wc) * 576;
        const int lane = fr + 16 * fq, sr = lane >> 3, sc = (lane & 7) * 4;
#pragma unroll
        for (int ai = 0; ai < 2; ++ai)
        {
            pg::f32x4 xs[4][2][2];
#pragma unroll
            for (int m = 0; m < 4; ++m)
#pragma unroll
                for (int bj = 0; bj < 2; ++bj) { const size_t off = (size_t)(ai * 128 + wr * 64 + m * 16) * DM + u.pn * 256 + wc * 32 + bj * 128;
                    xs[m][bj][0] = *(const pg::f32x4*)(xin + off + (size_t)sr * DM + sc); xs[m][bj][1] = *(const pg::f32x4*)(xin + off + (size_t)(sr + 8) * DM + sc); }
            __builtin_amdgcn_sched_barrier(0);
#pragma unroll
            for (int m = 0; m < 4; ++m) {
                float q0 = 0.f, q1 = 0.f;
#pragma unroll
                for (int bj = 0; bj < 2; ++bj) {
                    const size_t off = (size_t)(ai * 128 + wr * 64 + m * 16) * DM + u.pn * 256 + wc * 32 + bj * 128;
                    *(LAS pg::f32x4*)(st + fr * 36 + 8 * fq) = gv[bj][0] * acc[ai][bj][m][0];
                    *(LAS pg::f32x4*)(st + fr * 36 + 8 * fq + 4) = gv[bj][1] * acc[ai][bj][m][1];
                    const pg::f32x4 x0 = xs[m][bj][0], x1 = xs[m][bj][1];
                    asm volatile("s_waitcnt lgkmcnt(0)" ::: "memory");
                    const pg::f32x4 r0 = x0 + *(const LAS pg::f32x4*)(st + sr * 36 + sc), r1 = x1 + *(const LAS pg::f32x4*)(st + (sr + 8) * 36 + sc);
                    *(pg::f32x4*)(xo + off + (size_t)sr * DM + sc) = r0;
                    *(pg::f32x4*)(xo + off + (size_t)(sr + 8) * DM + sc) = r1;
                    q0 += r0[0] * r0[0] + r0[1] * r0[1] + r0[2] * r0[2] + r0[3] * r0[3]; q1 += r1[0] * r1[0] + r1[1] * r1[1] + r1[2] * r1[2] + r1[3] * r1[3];
                    asm volatile("s_waitcnt lgkmcnt(0)" ::: "memory");
                }
#define EW_RED(x_) q0 += __int_as_float(__builtin_amdgcn_ds_swizzle(__float_as_int(q0), ((x_) << 10) | 0x1f)); q1 += __int_as_float(__builtin_amdgcn_ds_swizzle(__float_as_int(q1), ((x_) << 10) | 0x1f));
                EW_RED(1) EW_RED(2) EW_RED(4)
#undef EW_RED
                if ((lane & 7) == 0) { float* d = ssq + (size_t)(u.pn * 4 + wc) * NROWS + u.pm * 256 + ai * 128 + wr * 64 + m * 16 + sr; d[0] = q0; d[8] = q1; }
            }
        }
    }
    __device__ __forceinline__ int sig(const SchedWout::Unit& u) const { return canon ? u.pm * 8 : -1; }
    __device__ __forceinline__ void signal(int i, int lane) const { if (lane == 0) __hip_atomic_fetch_add(dep + i, 1u, __ATOMIC_RELAXED, __HIP_MEMORY_SCOPE_AGENT); }
};
__device__ __forceinline__ void st_gemm_wout_fast(int layer, char* smem, bool canon) {
    STAGE_PARAMS();
    SchedWout S{(const char*)WSP(bf16_t, O_HX), (const char*)(WSP(bf16_t, O_WOUTT) + (size_t)layer * 1024 * 1024), G_, vcu_of(bid_, G_), (layer == 0 ? 136 : 128) * 4, canon};
    EpiWout E{layer == 0 ? p.x : p.out, layer == 0 ? p.ctx : WSP(float, O_XC), p.out, WSP(float, O_XC), WSP(float, O_MOD) + (size_t)layer * 9 * 6144 + 2 * 1024, (LAS float*)((LAS char*)smem + 131072), WSP(float, O_SSQ), WSP(unsigned, O_DEPX) + layer * 136 * 8, canon};
    pg::gemm_run<false>((LAS unsigned char*)(LAS char*)smem, 1024, S, E, tid_);
}
struct SchedMoeUp {
    struct Unit { int be, pm, pn, isctx; };
    const char* H2; const char* B; const int* idx; const int* idxc; int G, c, nunits;
    __device__ __forceinline__ bool next(int i, Unit& u) const { const int L = i * G + c; if (L >= nunits) return false;
        const bool ic = L >= 1536; const int q = ic ? L - 1536 : L; const int r = ic ? q % 6 : q % 12;
        const int i12 = q / 12;
        u.be = ic ? q / 6 : (i12 & 7) * 16 + (i12 >> 3); u.pm = ic ? 0 : r / 6; u.pn = r % 6; u.isctx = ic ? 1 : 0; return true; }
    __device__ __forceinline__ const char* a_base(const Unit&) const { return H2; }
    __device__ __forceinline__ unsigned a_off(const Unit& u, int r) const { const int* ri = u.isctx ? idxc + u.be * 256 : idx + u.be * CAP + u.pm * 256; return (unsigned)ri[r] * 2048u; }
    __device__ __forceinline__ const char* b_base(const Unit& u) const { return B + ((size_t)(u.isctx ? u.be : (u.be & 15)) * 1536 + (size_t)u.pn * 256) * 2048; }
};
struct EpiMoeUp {
    bf16_t* hid; bf16_t* hidc;
    __device__ __forceinline__ void operator()(const pg::f32x4 (&acc)[2][2][4][2], const SchedMoeUp::Unit& u, int wr, int wc, int fr, int fq) const {
        fr = opq(fr); fq = opq(fq);
        bf16_t* base = u.isctx ? hidc + (size_t)u.be * 256 * FF : hid + ((size_t)u.be * CAP + u.pm * 256) * FF;
#pragma unroll
        for (int ai = 0; ai < 2; ++ai)
#pragma unroll
            for (int m = 0; m < 4; ++m) { bf16_t* rowp = base + (size_t)(ai * 128 + wr * 64 + m * 16 + fr) * FF + u.pn * 128 + wc * 32 + 8 * fq;
                float h[8];
#pragma unroll
                for (int n = 0; n < 2; ++n)
#pragma unroll
                    for (int j = 0; j < 4; ++j) { const float gt = acc[ai][0][m][n][j], up = acc[ai][1][m][n][j]; h[n * 4 + j] = gt * __builtin_amdgcn_rcpf(1.f + __builtin_amdgcn_exp2f(-gt * LOG2E)) * up; }
                pg::u32x4 w; w.x = pg::cvt_pk_bf16(h[0], h[1]); w.y = pg::cvt_pk_bf16(h[2], h[3]); w.z = pg::cvt_pk_bf16(h[4], h[5]); w.w = pg::cvt_pk_bf16(h[6], h[7]);
                *(pg::u32x4*)rowp = w; }
    }
    __device__ __forceinline__ int sig(const SchedMoeUp::Unit&) const { return -1; }
    __device__ __forceinline__ void signal(int, int) const {}
};
__device__ __forceinline__ void st_moe_up_fast(int layer, char* smem) {
    STAGE_PARAMS();
    SchedMoeUp S{(const char*)WSP(bf16_t, O_HX), (const char*)WSP(bf16_t, O_WGUT), WSP(const int, O_IDX), WSP(const int, O_IDXC), G_, vcu_of(bid_, G_), 1536 + (layer == 0 ? 96 : 0)};
    EpiMoeUp E{WSP(bf16_t, O_HID), WSP(bf16_t, O_HIDC)};
    pg::gemm_run<true>((LAS unsigned char*)(LAS char*)smem, 1024, S, E, tid_);
}
struct SchedMoeDown {
    struct Unit { int be, pm, pn, isctx; };
    const char* hid; const char* hidc; const char* B; int G, c, nunits;
    __device__ __forceinline__ bool next(int i, Unit& u) const { const int L = i * G + c; if (L >= nunits) return false;
        const bool ic = L >= 1024; const int q = ic ? L - 1024 : L;
        const int i8 = q >> 3;
        u.be = ic ? (q >> 2) : (i8 & 7) * 16 + (i8 >> 3); u.pm = ic ? 0 : ((q & 7) >> 2); u.pn = q & 3; u.isctx = ic ? 1 : 0; return true; }
    __device__ __forceinline__ const char* a_base(const Unit& u) const { return u.isctx ? hidc + (size_t)u.be * 256 * FF * 2 : hid + ((size_t)u.be * CAP + u.pm * 256) * FF * 2; }
    __device__ __forceinline__ unsigned a_off(const Unit&, int r) const { return (unsigned)r * (FF * 2); }
    __device__ __forceinline__ const char* b_base(const Unit& u) const { return B + ((size_t)(u.isctx ? u.be : (u.be & 15)) * 1024 + (size_t)u.pn * 256) * (FF * 2); }
};
struct EpiMoeDown {
    bf16_t* ys; bf16_t* ysc; const float* gate; const float* gatec;
    __device__ __forceinline__ void operator()(const pg::f32x4 (&acc)[2][2][4][2], const SchedMoeDown::Unit& u, int wr, int wc, int fr, int fq) const {
        fr = opq(fr); fq = opq(fq);
        bf16_t* base = u.isctx ? ysc + (size_t)u.be * 256 * DM : ys + ((size_t)u.be * CAP + u.pm * 256) * DM;
        float gvs[2][4];
        { const float* gp = (u.isctx ? gatec + u.be * 256 : gate + u.be * CAP + u.pm * 256) + wr * 64 + fr;
#pragma unroll
          for (int ai = 0; ai < 2; ++ai)
#pragma unroll
              for (int m = 0; m < 4; ++m) gvs[ai][m] = gp[ai * 128 + m * 16]; }
        __builtin_amdgcn_sched_barrier(0);
#pragma unroll
        for (int ai = 0; ai < 2; ++ai)
#pragma unroll
            for (int m = 0; m < 4; ++m) { const int r = ai * 128 + wr * 64 + m * 16 + fr;
                const float gv = gvs[ai][m];
                bf16_t* rowp = base + (size_t)r * DM + u.pn * 256 + wc * 32 + 8 * fq;
#pragma unroll
                for (int bj = 0; bj < 2; ++bj) { const pg::f32x4 v0 = acc[ai][bj][m][0] * gv, v1 = acc[ai][bj][m][1] * gv;
                    pg::u32x4 w; w.x = pg::cvt_pk_bf16(v0[0], v0[1]); w.y = pg::cvt_pk_bf16(v0[2], v0[3]); w.z = pg::cvt_pk_bf16(v1[0], v1[1]); w.w = pg::cvt_pk_bf16(v1[2], v1[3]);
                    *(pg::u32x4*)(rowp + bj * 128) = w; } }
    }
    __device__ __forceinline__ int sig(const SchedMoeDown::Unit&) const { return -1; }
    __device__ __forceinline__ void signal(int, int) const {}
};
__device__ __forceinline__ void st_moe_down_fast(int layer, char* smem) {
    STAGE_PARAMS();
    SchedMoeDown S{(const char*)WSP(bf16_t, O_HID), (const char*)WSP(bf16_t, O_HIDC), (const char*)WSP(bf16_t, O_WDT), G_, vcu_of(bid_, G_), 1024 + (layer == 0 ? 64 : 0)};
    EpiMoeDown E{WSP(bf16_t, O_YS), WSP(bf16_t, O_YSC), WSP(const float, O_GATE), WSP(const float, O_GATEC)};
    pg::gemm_run<false>((LAS unsigned char*)(LAS char*)smem, FF, S, E, tid_);
}

namespace fa {
typedef short bf16x8 __attribute__((ext_vector_type(8)));
typedef short bf16x4 __attribute__((ext_vector_type(4)));
typedef float f32x16 __attribute__((ext_vector_type(16)));
typedef unsigned u32x4 __attribute__((ext_vector_type(4)));
typedef unsigned u32x2 __attribute__((ext_vector_type(2)));
constexpr int VSTRIDE = 136;
__device__ __forceinline__ unsigned cvt_pk(float lo, float hi) { unsigned r; asm volatile("v_cvt_pk_bf16_f32 %0, %1, %2" : "=v"(r) : "v"(lo), "v"(hi)); return r; }
__device__ __forceinline__ float xhalf_max(float v) { const auto rr = __builtin_amdgcn_permlane32_swap(__float_as_uint(v), __float_as_uint(v), false, false); return fmaxf(__uint_as_float(rr[0]), __uint_as_float(rr[1])); }
__device__ __forceinline__ float xhalf_sum(float v) { const auto rr = __builtin_amdgcn_permlane32_swap(__float_as_uint(v), __float_as_uint(v), false, false); return __uint_as_float(rr[0]) + __uint_as_float(rr[1]); }
typedef short s16x4 __attribute__((ext_vector_type(4)));
__device__ __forceinline__ int vtr_st(int k, int c) { return ((k >> 3) * 2 + (c >> 5)) * 512 + ((k & 7) * 32 + (c & 31)) * 2; }
__device__ __forceinline__ int vtr_base(int lane) { return ((lane & 3) << 3) | (((lane >> 2) & 3) << 6) | (((lane >> 4) & 1) << 5) | (((lane >> 5) & 1) << 8); }
constexpr int vtr_off(int d0, int ks, int half) { return d0 * 512 + ks * 2048 + half * 1024; }
template <int OFF> __device__ __forceinline__ u32x2 vtr_read(int vb) { s16x4 r; asm volatile("ds_read_b64_tr_b16 %0, %1 offset:%2" : "=&v"(r) : "v"(vb), "i"(OFF) : "memory"); return __builtin_bit_cast(u32x2, r); }
#define VTR_READ_ALL(va_, vb_) do { \
    va_[0][0] = vtr_read<vtr_off(0, 0, 0)>(vb_); va_[0][1] = vtr_read<vtr_off(0, 0, 1)>(vb_); va_[0][2] = vtr_read<vtr_off(1, 0, 0)>(vb_); va_[0][3] = vtr_read<vtr_off(1, 0, 1)>(vb_); \
    va_[1][0] = vtr_read<vtr_off(0, 1, 0)>(vb_); va_[1][1] = vtr_read<vtr_off(0, 1, 1)>(vb_); va_[1][2] = vtr_read<vtr_off(1, 1, 0)>(vb_); va_[1][3] = vtr_read<vtr_off(1, 1, 1)>(vb_); \
    va_[2][0] = vtr_read<vtr_off(0, 2, 0)>(vb_); va_[2][1] = vtr_read<vtr_off(0, 2, 1)>(vb_); va_[2][2] = vtr_read<vtr_off(1, 2, 0)>(vb_); va_[2][3] = vtr_read<vtr_off(1, 2, 1)>(vb_); \
    va_[3][0] = vtr_read<vtr_off(0, 3, 0)>(vb_); va_[3][1] = vtr_read<vtr_off(0, 3, 1)>(vb_); va_[3][2] = vtr_read<vtr_off(1, 3, 0)>(vb_); va_[3][3] = vtr_read<vtr_off(1, 3, 1)>(vb_); } while (0)

__device__ __forceinline__ float max3f(float a, float b, float c) { float r; asm("v_max3_f32 %0, %1, %2, %3" : "=v"(r) : "v"(a), "v"(b), "v"(c)); return r; }
template <int DQK, bool WIN, bool QS = false, bool VTR = false>
__device__ __forceinline__ void attn_unit(LAS unsigned char* lds, const int tid, const bf16_t* Qp, const int qstride, const bf16_t* Kp, const bf16_t* Vt, const int vt_stride,
                                          const int ntiles, const int nfirst, const int second0, const int qtok0, const float sink_l2, bf16_t* Yp, const int ystride, const float sink_l2b = 0.f, const bf16_t* Vc = nullptr) {
    constexpr int KSTRIDE = DQK * 2 + 16, KCH = DQK / 8, KBUF = 64 * KSTRIDE, VBUF = 64 * VSTRIDE, NKS = DQK / 16;
    constexpr float THR = 8.f;
    const int lane = tid & 63, wave = __builtin_amdgcn_readfirstlane(tid >> 6), q32 = lane & 31, hh = lane >> 5;
    const int wrow = QS ? (wave & 3) * 32 : wave * 32, hoff = QS ? (wave >> 2) * 64 : 0;
    const int kr0 = tid / KCH, kc0 = tid % KCH, kr1 = (tid + 512) / KCH, kc1 = (tid + 512) % KCH; const bool k2 = (tid + 512) < 64 * KCH;
    const int vd = tid >> 3, vc = tid & 7;
    const unsigned kl0 = kr0 * KSTRIDE + kc0 * 16, kl1 = kr1 * KSTRIDE + kc1 * 16, vl = VTR ? vtr_st(vd, vc * 8) : vd * VSTRIDE + vc * 16;
#define FA_KEY0(i) ((i) < nfirst ? 64 * (i) : second0 + 64 * ((i) - nfirst))
    bf16x8 qf[NKS];
    { const bf16_t* qr = Qp + (size_t)(wrow + q32) * qstride + hoff + 8 * hh;
#pragma unroll
      for (int s = 0; s < NKS; ++s) qf[s] = *(const bf16x8*)(qr + 16 * s); }
    f32x16 o0, o1, o2, negm;
#pragma unroll
    for (int r = 0; r < 16; ++r) { o0[r] = 0.f; o1[r] = 0.f; o2[r] = 0.f; negm[r] = 0.f; }
    float mref = 0.f;
    const bf16x8 ones = (bf16x8){16256, 16256, 16256, 16256, 16256, 16256, 16256, 16256};
    u32x4 ak0, ak1 = (u32x4){0u, 0u, 0u, 0u}, av;
#define FA_LOAD(k0_, k1_, v_, ti_) do { const int key0_ = FA_KEY0(ti_); \
        k0_ = *(const u32x4*)(Kp + (size_t)(key0_ + kr0) * DQK + kc0 * 8); if (k2) k1_ = *(const u32x4*)(Kp + (size_t)(key0_ + kr1) * DQK + kc1 * 8); \
        if (VTR) v_ = *(const u32x4*)((key0_ < 256 ? Vc : Vt) + (size_t)(key0_ + vd) * vt_stride + vc * 8); else v_ = *(const u32x4*)(Vt + (size_t)vd * vt_stride + key0_ + vc * 8); } while (0)
#define FA_STORE(k0_, k1_, v_, b_) do { *(LAS u32x4*)(lds + (b_) * KBUF + kl0) = k0_; if (k2) *(LAS u32x4*)(lds + (b_) * KBUF + kl1) = k1_; \
        if (VTR) *(LAS u32x4*)(lds + 2 * KBUF + (b_) * VBUF + vl) = v_; else { *(LAS u32x2*)(lds + 2 * KBUF + (b_) * VBUF + vl) = (u32x2){v_.x, v_.y}; *(LAS u32x2*)(lds + 2 * KBUF + (b_) * VBUF + vl + 8) = (u32x2){v_.z, v_.w}; } } while (0)
#define FA_BAR() do { asm volatile("s_waitcnt lgkmcnt(0)" ::: "memory"); __syncthreads(); } while (0)
    FA_LOAD(ak0, ak1, av, 0);
    FA_BAR();
    FA_STORE(ak0, ak1, av, 0);
    for (int t = 0; t < ntiles; ++t) {
        const int buf = t & 1;
        FA_BAR();
        const bool more = (t + 1) < ntiles;
        if (more) FA_LOAD(ak0, ak1, av, t + 1);
        {
        const int key0 = FA_KEY0(t);
        bool active = true;
        if (WIN) { if ((t) >= nfirst) { const int kt0 = key0 - 256, qw0 = qtok0 + wrow; active = (kt0 <= qw0 + 31 + 128) && (kt0 + 63 >= qw0 - 128); } }
        if (active) {
            const LAS unsigned char* kb = lds + buf * KBUF + q32 * KSTRIDE + 16 * hh;
            const LAS unsigned char* vb = lds + 2 * KBUF + buf * VBUF + q32 * VSTRIDE + 8 * hh;
            bf16x8 kf0[NKS / 2], kf1[NKS / 2];
#pragma unroll
            for (int s = 0; s < NKS / 2; ++s) { kf0[s] = *(const LAS bf16x8*)(kb + 32 * s); kf1[s] = *(const LAS bf16x8*)(kb + 32 * KSTRIDE + 32 * s); }
            __builtin_amdgcn_sched_barrier(0);
            f32x16 p0 = __builtin_amdgcn_mfma_f32_32x32x16_bf16(kf0[0], qf[0], negm, 0, 0, 0), p1 = __builtin_amdgcn_mfma_f32_32x32x16_bf16(kf1[0], qf[0], negm, 0, 0, 0);
#pragma unroll
            for (int s = 1; s < NKS / 2; ++s) {
                p0 = __builtin_amdgcn_mfma_f32_32x32x16_bf16(kf0[s], qf[s], p0, 0, 0, 0);
                p1 = __builtin_amdgcn_mfma_f32_32x32x16_bf16(kf1[s], qf[s], p1, 0, 0, 0);
            }
            __builtin_amdgcn_sched_barrier(0);
#pragma unroll
            for (int s = 0; s < NKS / 2; ++s) { kf0[s] = *(const LAS bf16x8*)(kb + 32 * (s + NKS / 2)); kf1[s] = *(const LAS bf16x8*)(kb + 32 * KSTRIDE + 32 * (s + NKS / 2)); }
            __builtin_amdgcn_sched_barrier(0);
#pragma unroll
            for (int s = 0; s < NKS / 2; ++s) {
                p0 = __builtin_amdgcn_mfma_f32_32x32x16_bf16(kf0[s], qf[s + NKS / 2], p0, 0, 0, 0);
                p1 = __builtin_amdgcn_mfma_f32_32x32x16_bf16(kf1[s], qf[s + NKS / 2], p1, 0, 0, 0);
            }
            u32x2 va[4][4];
            if (VTR) { const int vtb = (int)(unsigned)(size_t)(lds + 2 * KBUF + buf * VBUF) + vtr_base(lane); VTR_READ_ALL(va, vtb); }
            else {
#pragma unroll
            for (int s = 0; s < 4; ++s) { va[s][0] = *(const LAS u32x2*)(vb + 32 * s); va[s][1] = *(const LAS u32x2*)(vb + 32 * s + 16);
                va[s][2] = *(const LAS u32x2*)(vb + 32 * VSTRIDE + 32 * s); va[s][3] = *(const LAS u32x2*)(vb + 32 * VSTRIDE + 32 * s + 16); } }
            __builtin_amdgcn_sched_barrier(0);
            asm volatile("s_nop 15\n\ts_nop 7" : "+v"(p0), "+v"(p1));
            if (WIN) { if ((t) >= nfirst) { const int qi = qtok0 + wrow + q32, kb0 = key0 - 256 + 4 * hh;
#pragma unroll
                for (int r = 0; r < 16; ++r) { const int kj = kb0 + (r & 3) + 8 * (r >> 2); const int d0 = kj - qi, d1 = d0 + 32;
                    if (d0 > 128 || d0 < -128) p0[r] = -1e30f; if (d1 > 128 || d1 < -128) p1[r] = -1e30f; } } }
            float mxa = max3f(p0[0], p0[1], p1[0]), mxb = max3f(p0[2], p0[3], p1[1]); mxa = max3f(mxa, p1[2], p1[3]);
#pragma unroll
            for (int r = 4; r < 16; r += 4) { mxa = max3f(mxa, p0[r], p0[r + 1]); mxb = max3f(mxb, p0[r + 2], p0[r + 3]); mxa = max3f(mxa, p1[r], p1[r + 1]); mxb = max3f(mxb, p1[r + 2], p1[r + 3]); }
            const float mx = xhalf_max(max3f(mxa, mxb, mxb));
            if ((t == 0) || __any(mx > THR)) {
                const float dl = ((t == 0)) ? mx : fmaxf(mx, 0.f), f = __builtin_amdgcn_exp2f(-dl);
                mref += dl; o2[0] *= f;
#pragma unroll
                for (int r = 0; r < 16; ++r) { o0[r] *= f; o1[r] *= f; p0[r] -= dl; p1[r] -= dl; negm[r] = -mref; }
            }
#pragma unroll
            for (int r = 0; r < 16; ++r) { p0[r] = __builtin_amdgcn_exp2f(p0[r]); p1[r] = __builtin_amdgcn_exp2f(p1[r]); }
            {
                float q0 = p0[0] + p1[0], q1 = p0[1] + p1[1], q2 = p0[2] + p1[2], q3 = p0[3] + p1[3];
#pragma unroll
                for (int r = 4; r < 16; r += 4) { q0 += p0[r] + p1[r]; q1 += p0[r + 1] + p1[r + 1]; q2 += p0[r + 2] + p1[r + 2]; q3 += p0[r + 3] + p1[r + 3]; }
                o2[0] += (q0 + q1) + (q2 + q3);
            }
            bf16x8 pf[4];
#pragma unroll
            for (int s = 0; s < 4; ++s) { unsigned w[4];
#pragma unroll
                for (int j = 0; j < 4; ++j) { const int r = 8 * (s & 1) + 2 * j; w[j] = (s < 2) ? cvt_pk(p0[r], p0[r + 1]) : cvt_pk(p1[r], p1[r + 1]); }
                const u32x4 u = (u32x4){w[0], w[1], w[2], w[3]}; pf[s] = __builtin_bit_cast(bf16x8, u); }
            if (VTR) { asm volatile("s_waitcnt lgkmcnt(0)" ::: "memory"); __builtin_amdgcn_sched_barrier(0); }
#pragma unroll
            for (int s = 0; s < 4; ++s) {
                const u32x4 u0 = (u32x4){va[s][0].x, va[s][0].y, va[s][1].x, va[s][1].y}, u1 = (u32x4){va[s][2].x, va[s][2].y, va[s][3].x, va[s][3].y};
                o0 = __builtin_amdgcn_mfma_f32_32x32x16_bf16(__builtin_bit_cast(bf16x8, u0), pf[s], o0, 0, 0, 0);
                o1 = __builtin_amdgcn_mfma_f32_32x32x16_bf16(__builtin_bit_cast(bf16x8, u1), pf[s], o1, 0, 0, 0);
            }
        }
        }
        if (more) FA_STORE(ak0, ak1, av, buf ^ 1);
    }
#undef FA_LOAD
#undef FA_STORE
#undef FA_BAR
#undef FA_KEY0
    float lt = xhalf_sum(o2[0]);
    if (WIN) lt += __builtin_amdgcn_exp2f(((QS && wave >= 4) ? sink_l2b : sink_l2) - mref);
    const float inv = 1.f / lt;
    bf16_t* yr = Yp + (size_t)(wrow + q32) * ystride + hoff + 4 * hh;
#pragma unroll
    for (int g = 0; g < 4; ++g) {
        *(uint2*)(yr + 8 * g) = make_uint2(cvt_pk(o0[4 * g] * inv, o0[4 * g + 1] * inv), cvt_pk(o0[4 * g + 2] * inv, o0[4 * g + 3] * inv));
        *(uint2*)(yr + 32 + 8 * g) = make_uint2(cvt_pk(o1[4 * g] * inv, o1[4 * g + 1] * inv), cvt_pk(o1[4 * g + 2] * inv, o1[4 * g + 3] * inv));
    }
}
}

__device__ __forceinline__ void st_mla_fast(int layer, char* smem) {
    STAGE_PARAMS();
    LAS unsigned char* lds = (LAS unsigned char*)(LAS char*)smem;
    const int c = vcu_of(bid_, G_);
    const int nunits = 1024 + (layer == 0 ? 64 : 0);
    const bf16_t* QM = WSP(const bf16_t, O_QM); const bf16_t* KM = WSP(const bf16_t, O_KM); const bf16_t* VT = WSP(const bf16_t, O_VT); bf16_t* Y = WSP(bf16_t, O_HX);
    if (tid_ >= 256) __builtin_amdgcn_s_setprio(1);
    for (int L = c; L < nunits; L += G_) {
        int bh, row0, ntiles;
        if (L < 1024) { bh = L >> 4; row0 = (bh >> 3) * SEQ + (L & 15) * 256; ntiles = NKEYS / 64; }
        else { bh = L - 1024; row0 = NLAT + (bh >> 3) * CTXL; ntiles = CTXL / 64; }
        const int h = bh & 7;
        fa::attn_unit<96, false>(lds, tid_, QM + ((size_t)row0 * 8 + h) * 96, 768, KM + (size_t)bh * NKEYS * 96, VT + (size_t)bh * 64 * NKEYS, NKEYS,
                                 ntiles, ntiles, 0, 0, 0.f, Y + (size_t)row0 * DM + 256 + h * 64, DM);
    }
    __builtin_amdgcn_s_setprio(0);
}

template <int NC>
__device__ __forceinline__ void tile_transpose(const bf16_t* P, int row0, int c0, bf16_t* dst, int NH, int b, int key0, LAS unsigned short* scr, int tid) {
    constexpr int LDW = NC + 2;
    for (int id = tid; id < 64 * (NC / 8); id += 512) { const int r = id / (NC / 8), ch = id % (NC / 8);
        const uint4 u = *(const uint4*)(P + (size_t)(row0 + r) * PLD + c0 + ch * 8);
        LAS unsigned* d = (LAS unsigned*)(scr + r * LDW + ch * 8); d[0] = u.x; d[1] = u.y; d[2] = u.z; d[3] = u.w; }
    __syncthreads();
    for (int id = tid; id < NC * 8; id += 512) { const int col = id >> 3, c8 = id & 7;
        unsigned w[4];
#pragma unroll
        for (int j = 0; j < 4; ++j) w[j] = (unsigned)scr[(c8 * 8 + 2 * j) * LDW + col] | ((unsigned)scr[(c8 * 8 + 2 * j + 1) * LDW + col] << 16);
        *(uint4*)(dst + ((size_t)(b * NH + (col >> 6)) * 64 + (col & 63)) * NKEYS + key0 + c8 * 8) = make_uint4(w[0], w[1], w[2], w[3]); }
    __syncthreads();
}
__device__ __forceinline__ int chunk_row0(int b, int ck) { return ck < 2 ? NLAT + b * CTXL + ck * 128 : b * SEQ + (ck - 2) * 128; }
template <class PT>
__device__ __forceinline__ void ret_kv_item(const PT& p, int layer, int item, char* smem, int tid) {
    using namespace fa;
    LAS unsigned char* lds = (LAS unsigned char*)(LAS char*)smem;
    constexpr int IMG = 16384, OFF_KF = IMG, OFF_KB = 2 * IMG;
    const bf16_t* P = WSP(const bf16_t, O_P);
    const int ck = item % 34, bh = item / 34, h = bh & 3, b = bh >> 2;
    const int row0 = chunk_row0(b, ck);
    const float lgf = WSP(const float, O_RETLG)[layer * 8 + h], lgb = WSP(const float, O_RETLG)[layer * 8 + 4 + h];
    {
        u32x4 uk[2], uv[2];
#pragma unroll
        for (int i = 0; i < 2; ++i) { const int id = tid + 512 * i, r = id >> 3, ch = id & 7;
            uk[i] = *(const u32x4*)(P + (size_t)(row0 + r) * PLD + C_RK + h * 64 + ch * 8); uv[i] = *(const u32x4*)(P + (size_t)(row0 + r) * PLD + C_RV + h * 64 + ch * 8); }
#pragma unroll
        for (int i = 0; i < 2; ++i) { const int id = tid + 512 * i, r = id >> 3, ch = id & 7;
            const float wf = __builtin_amdgcn_exp2f(lgf * (float)(127 - r)), wb = __builtin_amdgcn_exp2f(lgb * (float)r);
            const unsigned kw[4] = {uk[i].x, uk[i].y, uk[i].z, uk[i].w};
            u32x4 kf, kbw;
#pragma unroll
            for (int j = 0; j < 4; ++j) { const float k0 = bflo(kw[j]), k1 = bfhi(kw[j]); kf[j] = cvt_pk(k0 * wf, k1 * wf); kbw[j] = cvt_pk(k0 * wb, k1 * wb); }
            const unsigned la = (r >> 6) * 8192 + vtr_st(r & 63, ch * 8);
            *(LAS u32x4*)(lds + la) = uv[i]; *(LAS u32x4*)(lds + OFF_KF + la) = kf; *(LAS u32x4*)(lds + OFF_KB + la) = kbw;
        }
    }
    asm volatile("s_waitcnt lgkmcnt(0)" ::: "memory"); __syncthreads();
    {
        const int lane = tid & 63, wave = __builtin_amdgcn_readfirstlane(tid >> 6), l31 = lane & 31, hh = lane >> 5;
        const int dir = wave >> 2, dvb = (wave >> 1) & 1, dkb = wave & 1;
        const int vab = (int)(unsigned)(size_t)lds + vtr_base(lane) + dvb * 512;
        const int kbb = (int)(unsigned)(size_t)lds + (dir ? OFF_KB : OFF_KF) + vtr_base(lane) + dkb * 512;
        u32x2 fa_[8][2], fb_[8][2];
#define RK_RD(s_) fa_[s_][0] = vtr_read<vtr_off(0, (s_) & 3, 0) + ((s_) >> 2) * 8192>(vab); fa_[s_][1] = vtr_read<vtr_off(0, (s_) & 3, 1) + ((s_) >> 2) * 8192>(vab); \
                  fb_[s_][0] = vtr_read<vtr_off(0, (s_) & 3, 0) + ((s_) >> 2) * 8192>(kbb); fb_[s_][1] = vtr_read<vtr_off(0, (s_) & 3, 1) + ((s_) >> 2) * 8192>(kbb);
        RK_RD(0) RK_RD(1) RK_RD(2) RK_RD(3) RK_RD(4) RK_RD(5) RK_RD(6) RK_RD(7)
#undef RK_RD
        asm volatile("s_waitcnt lgkmcnt(0)" ::: "memory"); __builtin_amdgcn_sched_barrier(0);
        f32x16 acc;
#pragma unroll
        for (int r = 0; r < 16; ++r) acc[r] = 0.f;
#pragma unroll
        for (int s = 0; s < 8; ++s) { const u32x4 ua = (u32x4){fa_[s][0].x, fa_[s][0].y, fa_[s][1].x, fa_[s][1].y}, ub = (u32x4){fb_[s][0].x, fb_[s][0].y, fb_[s][1].x, fb_[s][1].y};
            acc = __builtin_amdgcn_mfma_f32_32x32x16_bf16(__builtin_bit_cast(bf16x8, ua), __builtin_bit_cast(bf16x8, ub), acc, 0, 0, 0); }
        float* o = WSP(float, dir ? O_KVB : O_KVF) + ((size_t)bh * 34 + ck) * 4096 + (size_t)(32 * dvb + 4 * hh) * 64 + 32 * dkb + l31;
#pragma unroll
        for (int r = 0; r < 16; ++r) o[((r & 3) + 8 * (r >> 2)) * 64] = acc[r];
    }
    asm volatile("s_waitcnt lgkmcnt(0)" ::: "memory"); __syncthreads();
}
__device__ __forceinline__ void st_ret_scan(int layer) {
    STAGE_PARAMS();
    for (int g = bid_ * 512 + tid_; g < 32 * 2 * 4096; g += G_ * 512) {
        const int e = g & 4095, dir = (g >> 12) & 1, bh = g >> 13, h = bh & 3;
        const float lg = WSP(const float, O_RETLG)[layer * 8 + dir * 4 + h];
        const float gch = exp2f(lg * 128.f);
        const float* kv = WSP(const float, dir ? O_KVB : O_KVF) + (size_t)bh * 34 * 4096 + e;
        bf16_t* sp = WSP(bf16_t, dir ? O_SPB : O_SPF) + (size_t)bh * 34 * 4096 + e;
        float s = 0.f;
#pragma unroll 1
        for (int c0 = 0; c0 < 34; c0 += 17) {
            float kvv[17];
#pragma unroll
            for (int i = 0; i < 17; ++i) { const int ii = c0 + i, ck = dir ? (ii < 2 ? 1 - ii : 35 - ii) : ii; kvv[i] = kv[(size_t)ck * 4096]; }
#pragma unroll
            for (int i = 0; i < 17; ++i) { const int ii = c0 + i, ck = dir ? (ii < 2 ? 1 - ii : 35 - ii) : ii; sp[(size_t)ck * 4096] = (bf16_t)f2bf(s); s = gch * s + kvv[i]; }
        }
    }
}

__device__ __forceinline__ void st_phase_c(int layer, char* smem, bool canon) {
    STAGE_PARAMS();
    using namespace fa;
    LAS unsigned char* lds = (LAS unsigned char*)(LAS char*)smem;
    constexpr int A1S = 528, A2S = 272, OFF_A2 = 64 * A1S, OFF_TM = OFF_A2 + 64 * A2S, OFF_TW = OFF_TM + 64 * 8 * 8, OFF_TR = OFF_TW + 64 * 16 * 8;
    typedef float f32x2v __attribute__((ext_vector_type(2)));
    LAS f32x2v* tabm = (LAS f32x2v*)(lds + OFF_TM);
    LAS f32x2v* tabw = (LAS f32x2v*)(lds + OFF_TW);
    const int tid = tid_, lane = tid & 63, wave = __builtin_amdgcn_readfirstlane(tid >> 6), l31 = lane & 31, hh = lane >> 5;
    for (int i = tid; i < 64 * 24; i += 512) { const int pos = i / 24, f = i % 24; float sn, cs;
        if (f < 8) { sincos_acc((float)pos * ROPE_INV8[f], sn, cs); tabm[pos * 8 + f] = (f32x2v){cs, sn}; }
        else { sincos_acc((float)pos * ROPE_INV16[f - 8], sn, cs); tabw[pos * 16 + f - 8] = (f32x2v){cs, sn}; } }
    const bf16_t* P = WSP(const bf16_t, O_P);
    const bf16_t* WUQ = WSP(const bf16_t, O_WUQT) + (size_t)layer * 768 * 256;
    const bf16_t* WUK = WSP(const bf16_t, O_WUKT) + (size_t)layer * 512 * 128;
    const bf16_t* WUV = WSP(const bf16_t, O_WUVT) + (size_t)layer * 512 * 128;
    bf16_t* QM = WSP(bf16_t, O_QM); bf16_t* KM = WSP(bf16_t, O_KM); bf16_t* VT = WSP(bf16_t, O_VT);
    const float qscale = 0.10206207261596575f * LOG2E, wscale = 0.125f * LOG2E;
    __syncthreads();
    LAS int* qslot = (LAS int*)(lds + 150016);
    LAS unsigned char* stg = lds + 96512 + (tid >> 6) * 6656;
    for (;;) {
        __syncthreads();
        if (tid == 0) {
            int it;
            if (canon) {
                const int x = vcu_of(bid_, G_) >> 5;
                const int q = (int)__hip_atomic_fetch_add(WSP(unsigned, O_QXCD) + (layer * 8 + x) * 64, 1u, __ATOMIC_RELAXED, __HIP_MEMORY_SCOPE_AGENT);
                if (q >= 204) it = NROWS / 64 + 8 * 4 * 34;
                else { const int mt = q < 68 ? q >> 2 : (q - 68) >> 3, pm = mt < 16 ? 32 * (mt >> 2) + 4 * x + (mt & 3) : 128 + x;
                    if (q < 68) it = pm * 4 + (q & 3);
                    else { const int sub = (q - 68) & 7, chunk = sub >> 2, hd = sub & 3, b = pm < 128 ? pm >> 4 : pm - 128, ck = pm < 128 ? 2 + (pm & 15) * 2 + chunk : chunk;
                        it = NROWS / 64 + (b * 4 + hd) * 34 + ck; } }
            } else it = (int)__hip_atomic_fetch_add(WSP(unsigned, O_QCNT) + layer * 64, 1u, __ATOMIC_RELAXED, __HIP_MEMORY_SCOPE_AGENT);
            if (it < NROWS / 64 + 8 * 4 * 34) {
                int r0 = it * 64;
                if (it >= NROWS / 64) { const int q = it - NROWS / 64; r0 = chunk_row0((q / 34) >> 2, q % 34); }
                const unsigned* dw = WSP(const unsigned, O_DEPW) + (layer * 136 + (r0 >> 8)) * 8;
                for (unsigned spins = 0; __hip_atomic_load(dw, __ATOMIC_RELAXED, __HIP_MEMORY_SCOPE_AGENT) < 64u && spins < (1u << 24); ++spins) __builtin_amdgcn_s_sleep(2);
                __builtin_amdgcn_fence(__ATOMIC_ACQUIRE, "agent");
                asm volatile("s_waitcnt vmcnt(0)" ::: "memory");
            }
            *qslot = it;
        }
        __syncthreads();
        const int item = *qslot;
        if (item >= NROWS / 64 + 8 * 4 * 34) break;
        if (item >= NROWS / 64) { ret_kv_item(p, layer, item - NROWS / 64, smem, tid); continue; }
        const int row0 = item * 64; const RowInfo ri = row_info(row0);
        const int key0 = ri.key, rowpos = ri.t >> 6; const bool isctx = ri.isctx != 0; const bool need_q = !(isctx && layer != 0);
        uint2 uqs[8]; unsigned uks[8];
#pragma unroll
        for (int rr = 0; rr < 8; ++rr) { const bf16_t* pr = P + (size_t)(row0 + wave * 8 + rr) * PLD; uqs[rr] = *(const uint2*)(pr + C_CQ + lane * 4); uks[rr] = *(const unsigned*)(pr + C_CKV + lane * 2); }
        const float4 gq = ((const float4*)(p.mla_qnorm_g + layer * 256))[lane]; const float2 gk = ((const float2*)(p.mla_kvnorm_g + layer * 128))[lane];
        __builtin_amdgcn_sched_barrier(0);
#pragma unroll
        for (int rr = 0; rr < 8; ++rr) { const int r = wave * 8 + rr;
            const uint2 uq = uqs[rr]; const unsigned uk = uks[rr];
            const float q0 = bflo(uq.x), q1 = bfhi(uq.x), q2 = bflo(uq.y), q3 = bfhi(uq.y), k0 = bflo(uk), k1 = bfhi(uk);
            const float rq = rsqrtf(wave_sum(q0 * q0 + q1 * q1 + q2 * q2 + q3 * q3) * (1.f / 256.f) + 1e-6f), rk = rsqrtf(wave_sum(k0 * k0 + k1 * k1) * (1.f / 128.f) + 1e-6f);
            *(LAS u32x2*)(lds + r * A1S + lane * 8) = (u32x2){cvt_pk(q0 * rq * gq.x, q1 * rq * gq.y), cvt_pk(q2 * rq * gq.z, q3 * rq * gq.w)};
            *(LAS unsigned*)(lds + OFF_A2 + r * A2S + lane * 4) = cvt_pk(k0 * rk * gk.x, k1 * rk * gk.y); }
        __syncthreads();
        if (need_q) {
            f32x16 acc[3][2];
#pragma unroll
            for (int nb = 0; nb < 3; ++nb)
#pragma unroll
                for (int tb = 0; tb < 2; ++tb)
#pragma unroll
                    for (int r = 0; r < 16; ++r) acc[nb][tb][r] = 0.f;
            const __attribute__((address_space(1))) bf16_t* wq = (const __attribute__((address_space(1))) bf16_t*)(WUQ + (size_t)(wave * 48) * 512 + lane * 8);
            asm volatile("" : "+v"(wq));
            const LAS unsigned char* ab = lds + l31 * A1S + 16 * hh;
            bf16x8 wA[2][3], wB[2][3];
#define PC_LDW(w_, s0_) do { _Pragma("unroll") for (int j = 0; j < 2; ++j) _Pragma("unroll") for (int nb = 0; nb < 3; ++nb) w_[j][nb] = *(const __attribute__((address_space(1))) bf16x8*)(wq + (size_t)(nb * 16 + (s0_) + j) * 512); } while (0)
#define PC_MMA(w_, s0_) do { _Pragma("unroll") for (int j = 0; j < 2; ++j) { const bf16x8 b0 = *(const LAS bf16x8*)(ab + 32 * ((s0_) + j)), b1 = *(const LAS bf16x8*)(ab + 32 * A1S + 32 * ((s0_) + j)); \
                _Pragma("unroll") for (int nb = 0; nb < 3; ++nb) { acc[nb][0] = __builtin_amdgcn_mfma_f32_32x32x16_bf16(w_[j][nb], b0, acc[nb][0], 0, 0, 0); acc[nb][1] = __builtin_amdgcn_mfma_f32_32x32x16_bf16(w_[j][nb], b1, acc[nb][1], 0, 0, 0); } } } while (0)
            PC_LDW(wA, 0); __builtin_amdgcn_sched_barrier(0);
#pragma unroll
            for (int c = 0; c < 16; c += 4) {
                PC_LDW(wB, c + 2); __builtin_amdgcn_sched_barrier(0);
                PC_MMA(wA, c); __builtin_amdgcn_sched_barrier(0);
                if (c + 4 < 16) { PC_LDW(wA, c + 4); __builtin_amdgcn_sched_barrier(0); }
                PC_MMA(wB, c + 2); __builtin_amdgcn_sched_barrier(0);
            }
#undef PC_LDW
#undef PC_MMA
#pragma unroll
            for (int tb = 0; tb < 2; ++tb) {
                if (!isctx) {
#pragma unroll
                    for (int r = 0; r < 4; ++r) {
                        const f32x2v cr = tabm[rowpos * 8 + 4 * hh + r], cc = tabm[(32 * tb + l31) * 8 + 4 * hh + r];
                        const float x1 = acc[2][tb][r], x2 = acc[2][tb][r + 4], y1 = acc[2][tb][r + 8], y2 = acc[2][tb][r + 12];
                        acc[2][tb][r] = x1 * cr.x - x2 * cr.y; acc[2][tb][r + 4] = x1 * cr.y + x2 * cr.x;
                        acc[2][tb][r + 8] = y1 * cc.x - y2 * cc.y; acc[2][tb][r + 12] = y1 * cc.y + y2 * cc.x; }
                }
#pragma unroll
                for (int nb = 0; nb < 3; ++nb)
#pragma unroll
                    for (int g = 0; g < 4; ++g) *(LAS u32x2*)(stg + opq(l31 * 208 + 8 * hh) + (32 * nb + 8 * g) * 2) = (u32x2){cvt_pk(acc[nb][tb][4 * g] * qscale, acc[nb][tb][4 * g + 1] * qscale), cvt_pk(acc[nb][tb][4 * g + 2] * qscale, acc[nb][tb][4 * g + 3] * qscale)};
                asm volatile("s_waitcnt lgkmcnt(0)" ::: "memory");
#pragma unroll
                for (int ps = 0; ps < 6; ++ps) { const int idx = opq(lane) + 64 * ps, rw = idx / 12, ch = idx % 12;
                    const u32x4 v = *(const LAS u32x4*)(stg + rw * 208 + ch * 16);
                    *(u32x4*)(QM + ((size_t)(row0 + 32 * tb + rw) * 8 + wave) * 96 + ch * 8) = v; }
                asm volatile("s_waitcnt lgkmcnt(0)" ::: "memory");
            }
        }
        {
            f32x16 ak[2][2], av[2][2];
#pragma unroll
            for (int nb = 0; nb < 2; ++nb)
#pragma unroll
                for (int tb = 0; tb < 2; ++tb)
#pragma unroll
                    for (int r = 0; r < 16; ++r) { ak[nb][tb][r] = 0.f; av[nb][tb][r] = 0.f; }
            const __attribute__((address_space(1))) bf16_t* wk = (const __attribute__((address_space(1))) bf16_t*)(WUK + (size_t)(wave * 16) * 512 + lane * 8);
            const __attribute__((address_space(1))) bf16_t* wv = (const __attribute__((address_space(1))) bf16_t*)(WUV + (size_t)(wave * 16) * 512 + lane * 8);
            asm volatile("" : "+v"(wk), "+v"(wv));
            const LAS unsigned char* ab = lds + OFF_A2 + l31 * A2S + 16 * hh;
            bf16x8 uA[2][2], uB[2][2];
#define PC_LDW(w_, s_) do { _Pragma("unroll") for (int nb = 0; nb < 2; ++nb) { w_[nb][0] = *(const __attribute__((address_space(1))) bf16x8*)(wk + (size_t)(nb * 8 + (s_)) * 512); w_[nb][1] = *(const __attribute__((address_space(1))) bf16x8*)(wv + (size_t)(nb * 8 + (s_)) * 512); } } while (0)
#define PC_MMA(w_, s_) do { const bf16x8 b0 = *(const LAS bf16x8*)(ab + 32 * (s_)), b1 = *(const LAS bf16x8*)(ab + 32 * A2S + 32 * (s_)); \
                _Pragma("unroll") for (int nb = 0; nb < 2; ++nb) { \
                    ak[nb][0] = __builtin_amdgcn_mfma_f32_32x32x16_bf16(w_[nb][0], b0, ak[nb][0], 0, 0, 0); ak[nb][1] = __builtin_amdgcn_mfma_f32_32x32x16_bf16(w_[nb][0], b1, ak[nb][1], 0, 0, 0); \
                    av[nb][0] = __builtin_amdgcn_mfma_f32_32x32x16_bf16(b0, w_[nb][1], av[nb][0], 0, 0, 0); av[nb][1] = __builtin_amdgcn_mfma_f32_32x32x16_bf16(b1, w_[nb][1], av[nb][1], 0, 0, 0); } } while (0)
            PC_LDW(uA, 0); __builtin_amdgcn_sched_barrier(0);
#pragma unroll
            for (int c = 0; c < 8; c += 2) {
                PC_LDW(uB, c + 1); __builtin_amdgcn_sched_barrier(0);
                PC_MMA(uA, c); __builtin_amdgcn_sched_barrier(0);
                if (c + 2 < 8) { PC_LDW(uA, c + 2); __builtin_amdgcn_sched_barrier(0); }
                PC_MMA(uB, c + 1); __builtin_amdgcn_sched_barrier(0);
            }
#undef PC_LDW
#undef PC_MMA
            const size_t bhw = (size_t)(ri.b * 8 + wave);
#pragma unroll
            for (int tb = 0; tb < 2; ++tb) {
#pragma unroll
                for (int nb = 0; nb < 2; ++nb)
#pragma unroll
                    for (int g = 0; g < 4; ++g) *(LAS u32x2*)(stg + opq(l31 * 144 + 8 * hh) + (32 * nb + 8 * g) * 2) = (u32x2){cvt_pk(ak[nb][tb][4 * g], ak[nb][tb][4 * g + 1]), cvt_pk(ak[nb][tb][4 * g + 2], ak[nb][tb][4 * g + 3])};
                asm volatile("s_waitcnt lgkmcnt(0)" ::: "memory");
#pragma unroll
                for (int ps = 0; ps < 4; ++ps) { const int idx = opq(lane) + 64 * ps, rw = idx >> 3, ch = idx & 7;
                    const u32x4 v = *(const LAS u32x4*)(stg + rw * 144 + ch * 16);
                    *(u32x4*)(KM + (bhw * NKEYS + key0 + 32 * tb + rw) * 96 + ch * 8) = v; }
                asm volatile("s_waitcnt lgkmcnt(0)" ::: "memory");
            }
#pragma unroll
            for (int nb = 0; nb < 2; ++nb) {
#pragma unroll
                for (int tb = 0; tb < 2; ++tb)
#pragma unroll
                    for (int g = 0; g < 4; ++g) *(LAS u32x2*)(stg + opq(l31 * 144 + 8 * hh) + (32 * tb + 8 * g) * 2) = (u32x2){cvt_pk(av[nb][tb][4 * g], av[nb][tb][4 * g + 1]), cvt_pk(av[nb][tb][4 * g + 2], av[nb][tb][4 * g + 3])};
                asm volatile("s_waitcnt lgkmcnt(0)" ::: "memory");
#pragma unroll
                for (int ps = 0; ps < 4; ++ps) { const int idx = opq(lane) + 64 * ps, rw = idx >> 3, ch = idx & 7;
                    const u32x4 v = *(const LAS u32x4*)(stg + rw * 144 + ch * 16);
                    *(u32x4*)(VT + (bhw * 64 + 32 * nb + rw) * NKEYS + key0 + ch * 8) = v; }
                asm volatile("s_waitcnt lgkmcnt(0)" ::: "memory");
            }
        }
        {
#pragma unroll
            for (int ps = 0; ps < 4; ++ps) { const int id = opq(tid) + 512 * ps, cc = id & 3, tk = (id >> 2) & 63, hd = id >> 8;
                const bf16_t* pr = P + (size_t)(row0 + tk) * PLD + C_KR;
                const uint4 uo = ((const uint4*)pr)[cc], up = ((const uint4*)pr)[cc ^ 1];
                const unsigned wo[4] = {uo.x, uo.y, uo.z, uo.w}, wp[4] = {up.x, up.y, up.z, up.w};
                float y[8];
#pragma unroll
                for (int j = 0; j < 8; ++j) { const float xo = (j & 1) ? bfhi(wo[j >> 1]) : bflo(wo[j >> 1]), xp = (j & 1) ? bfhi(wp[j >> 1]) : bflo(wp[j >> 1]);
                    if (isctx) y[j] = xo;
                    else { const f32x2v cs = tabm[((cc & 2) ? tk : rowpos) * 8 + j]; y[j] = (cc & 1) ? xp * cs.y + xo * cs.x : xo * cs.x - xp * cs.y; } }
                *(uint4*)(KM + ((size_t)(ri.b * 8 + hd) * NKEYS + key0 + tk) * 96 + 64 + cc * 8) = make_uint4(cvt_pk(y[0], y[1]), cvt_pk(y[2], y[3]), cvt_pk(y[4], y[5]), cvt_pk(y[6], y[7]));
            }
        }
        {
#pragma unroll 1
            for (int pg3 = 0; pg3 < 2; ++pg3) {
                uint4 uo3[3], up3[3];
#pragma unroll
                for (int q3 = 0; q3 < 3; ++q3) { const int ps = 3 * pg3 + q3; const bool isq = ps < 4; const int id = opq(tid) + 512 * (isq ? ps : ps - 4);
                    const int ch = isq ? (id & 31) : (id & 7), tk = isq ? (id >> 5) : ((id >> 3) & 63), hdk = id >> 9, cc = ch & 3;
                    const bf16_t* pr = P + (size_t)(row0 + tk) * PLD + (isq ? C_WQ : C_WK + hdk * 64) + (ch >> 2) * 32;
                    uo3[q3] = ((const uint4*)pr)[cc]; up3[q3] = ((const uint4*)pr)[cc ^ 2]; }
                __builtin_amdgcn_sched_barrier(0);
#pragma unroll
                for (int q3 = 0; q3 < 3; ++q3) { const int ps = 3 * pg3 + q3; const bool isq = ps < 4; const int id = opq(tid) + 512 * (isq ? ps : ps - 4);
                    const int ch = isq ? (id & 31) : (id & 7), tk = isq ? (id >> 5) : ((id >> 3) & 63), hdk = id >> 9;
                    const int cc = ch & 3, half = (ch >> 2) & 1;
                    const uint4 uo = uo3[q3], up = up3[q3];
                    const unsigned wo[4] = {uo.x, uo.y, uo.z, uo.w}, wp[4] = {up.x, up.y, up.z, up.w};
                    const float sc = isq ? wscale : 1.f;
                    float y[8];
#pragma unroll
                    for (int j = 0; j < 8; ++j) { const float xo = (j & 1) ? bfhi(wo[j >> 1]) : bflo(wo[j >> 1]), xp = (j & 1) ? bfhi(wp[j >> 1]) : bflo(wp[j >> 1]);
                        if (isctx) y[j] = xo * sc;
                        else { const f32x2v cs = tabw[(half == 0 ? rowpos : tk) * 16 + (cc & 1) * 8 + j]; y[j] = ((cc & 2) ? xp * cs.y + xo * cs.x : xo * cs.x - xp * cs.y) * sc; } }
                    bf16_t* o = isq ? WSP(bf16_t, O_WQ) + (size_t)(row0 + tk) * 256 + ch * 8 : WSP(bf16_t, O_WK) + ((size_t)(ri.b * 2 + hdk) * NKEYS + key0 + tk) * 64 + ch * 8;
                    *(uint4*)o = make_uint4(cvt_pk(y[0], y[1]), cvt_pk(y[2], y[3]), cvt_pk(y[4], y[5]), cvt_pk(y[6], y[7]));
                }
            }
        }
    }
}

__device__ __forceinline__ void st_win_fast(int layer, char* smem) {
    STAGE_PARAMS();
    LAS unsigned char* lds = (LAS unsigned char*)(LAS char*)smem;
    const int c = (vcu_of(bid_, G_) + G_ - 64 % G_) % G_;
    const int nunits = 512 + (layer == 0 ? 32 : 0);
    const bf16_t* WQ = WSP(const bf16_t, O_WQ); const bf16_t* WK = WSP(const bf16_t, O_WK); const bf16_t* WVT = WSP(const bf16_t, O_WVT); bf16_t* Y = WSP(bf16_t, O_HX);
    if (tid_ >= 256) __builtin_amdgcn_s_setprio(1);
    for (int L = c; L < nunits; L += G_) {
        int b, hk, row0, ntiles, second0 = 0, qtok0 = 0;
        if (L < 512) { const int bk = L >> 5, qb = L & 31; b = bk >> 1; hk = bk & 1; qtok0 = qb * 128; row0 = b * SEQ + qtok0;
            const int lo = qtok0 - 128 < 0 ? 0 : qtok0 - 128, hi = qtok0 + 255 > SEQ - 1 ? SEQ - 1 : qtok0 + 255;
            ntiles = 4 + (hi + 1 - lo) / 64; second0 = 256 + lo; }
        else { const int q = L - 512; b = q >> 2; hk = (q >> 1) & 1; row0 = NLAT + b * CTXL + (q & 1) * 128; ntiles = 4; }
        const bf16_t* Pv = WSP(const bf16_t, O_P) + C_WV + hk * 64;
        fa::attn_unit<64, true, true, true>(lds, tid_, WQ + (size_t)row0 * 256 + hk * 128, 256, WK + (size_t)(b * 2 + hk) * NKEYS * 64, Pv + ((long)b * SEQ - 256) * (long)PLD, PLD,
                                      ntiles, 4, second0, qtok0, p.win_sink[layer * 4 + 2 * hk] * LOG2E, Y + (size_t)row0 * DM + 768 + hk * 128, DM, p.win_sink[layer * 4 + 2 * hk + 1] * LOG2E,
                                      Pv + ((size_t)NLAT + (size_t)b * CTXL) * PLD);
    }
    __builtin_amdgcn_s_setprio(0);
}
__device__ __forceinline__ void st_ret_fast(int layer, char* smem) {
    STAGE_PARAMS();
    using namespace fa;
    LAS unsigned char* lds = (LAS unsigned char*)(LAS char*)smem;
    constexpr int KSTR = 144, VSTR = 520, KB = 256 * KSTR;
    const int tid = tid_, lane = tid & 63, wave = __builtin_amdgcn_readfirstlane(tid >> 6), q32 = lane & 31, hh = lane >> 5;
    const int c = (vcu_of(bid_, G_) + G_ - 96 % G_) % G_;
    const int npair = layer == 0 ? 17 : 16, nunits = 32 * npair;
    const bf16_t* P = WSP(const bf16_t, O_P); const bf16_t* RVT = WSP(const bf16_t, O_RVT); bf16_t* Y = WSP(bf16_t, O_HX);
    for (int L = c; L < nunits; L += G_) {
        const int bh = L / npair, pr = L % npair + (layer == 0 ? 0 : 1), b = bh >> 2, h = bh & 3;
        const int row0 = chunk_row0(b, 2 * pr), key0 = pr == 0 ? 0 : 256 + (2 * pr - 2) * 128;
        const float lgf = WSP(const float, O_RETLG)[layer * 8 + h], lgb = WSP(const float, O_RETLG)[layer * 8 + 4 + h];
        __syncthreads();
        const int ckl = wave >> 2, ck = 2 * pr + ckl, cpos = opq(32 * (wave & 3) + q32);
        const int row = row0 + wave * 32 + q32;
        u32x4 uk4[4], uv4[4];
#pragma unroll
        for (int i = 0; i < 4; ++i) { const int id = tid + 512 * i; uk4[i] = *(const u32x4*)(P + (size_t)(row0 + (id >> 3)) * PLD + C_RK + h * 64 + (id & 7) * 8);
            uv4[i] = *(const u32x4*)(P + (size_t)(row0 + (id >> 3)) * PLD + C_RV + h * 64 + (id & 7) * 8); }
        bf16x8 qf[4];
#pragma unroll
        for (int s = 0; s < 4; ++s) qf[s] = *(const bf16x8*)(P + (size_t)row * PLD + C_RQ + h * 64 + 16 * s + 8 * hh);
        uint2 gga[4], ggb[4];
        { const bf16_t* gr0 = P + (size_t)row * PLD + C_RG + h * 64 + 4 * hh;
#pragma unroll
          for (int g = 0; g < 4; ++g) { gga[g] = *(const uint2*)(gr0 + 8 * g); ggb[g] = *(const uint2*)(gr0 + 32 + 8 * g); } }
        bf16x8 spf[2][4][2];
#pragma unroll
        for (int dir = 0; dir < 2; ++dir) { const bf16_t* sp = WSP(const bf16_t, dir ? O_SPB : O_SPF) + ((size_t)bh * 34 + ck) * 4096 + (size_t)q32 * 64 + 8 * hh;
#pragma unroll
            for (int s = 0; s < 4; ++s) { spf[dir][s][0] = *(const bf16x8*)(sp + 16 * s); spf[dir][s][1] = *(const bf16x8*)(sp + 32 * 64 + 16 * s); } }
        __builtin_amdgcn_sched_barrier(0);
#pragma unroll
        for (int i = 0; i < 4; ++i) { const int id = tid + 512 * i; const int r = id >> 3, ch = id & 7;
            *(LAS u32x4*)(lds + r * KSTR + ch * 16) = uk4[i]; }
#pragma unroll
        for (int i = 0; i < 4; ++i) { const int id = tid + 512 * i; const int r = id >> 3, ch = id & 7;
            *(LAS u32x4*)(lds + KB + (r >> 6) * 8192 + vtr_st(r & 63, ch * 8)) = uv4[i]; }
        f32x16 o0, o1;
#pragma unroll
        for (int r = 0; r < 16; ++r) { o0[r] = 0.f; o1[r] = 0.f; }
#pragma unroll
        for (int dir = 0; dir < 2; ++dir) {
            f32x16 r0, r1;
#pragma unroll
            for (int r = 0; r < 16; ++r) { r0[r] = 0.f; r1[r] = 0.f; }
#pragma unroll
            for (int s = 0; s < 4; ++s) {
                const bf16x8 a0 = spf[dir][s][0], a1 = spf[dir][s][1];
                r0 = __builtin_amdgcn_mfma_f32_32x32x16_bf16(a0, qf[s], r0, 0, 0, 0);
                r1 = __builtin_amdgcn_mfma_f32_32x32x16_bf16(a1, qf[s], r1, 0, 0, 0);
            }
            const float wq = __builtin_amdgcn_exp2f(dir ? lgb * (float)(128 - cpos) : lgf * (float)(cpos + 1));
#pragma unroll
            for (int r = 0; r < 16; ++r) { o0[r] += wq * r0[r]; o1[r] += wq * r1[r]; }
        }
        __syncthreads();
#pragma unroll
        for (int tt = 0; tt < 2; ++tt) {
            const int kbase = ckl * 128 + tt * 64;
            const LAS unsigned char* kb = lds + (kbase + q32) * KSTR + 16 * hh;
            f32x16 p0, p1;
#pragma unroll
            for (int r = 0; r < 16; ++r) { p0[r] = 0.f; p1[r] = 0.f; }
#pragma unroll
            for (int s = 0; s < 4; ++s) {
                const bf16x8 a0 = *(const LAS bf16x8*)(kb + 32 * s), a1 = *(const LAS bf16x8*)(kb + 32 * KSTR + 32 * s);
                p0 = __builtin_amdgcn_mfma_f32_32x32x16_bf16(a0, qf[s], p0, 0, 0, 0);
                p1 = __builtin_amdgcn_mfma_f32_32x32x16_bf16(a1, qf[s], p1, 0, 0, 0);
            }
#pragma unroll
            for (int r = 0; r < 16; ++r) { const int mp = tt * 64 + 4 * hh + (r & 3) + 8 * (r >> 2); const int d0 = cpos - mp, d1 = d0 - 32;
                p0[r] *= __builtin_amdgcn_exp2f(((d0 >= 0) ? lgf : -lgb) * (float)d0);
                p1[r] *= __builtin_amdgcn_exp2f(((d1 >= 0) ? lgf : -lgb) * (float)d1); }
            bf16x8 pf[4];
#pragma unroll
            for (int s = 0; s < 4; ++s) { unsigned w[4];
#pragma unroll
                for (int j = 0; j < 4; ++j) { const int r = 8 * (s & 1) + 2 * j; w[j] = (s < 2) ? cvt_pk(p0[r], p0[r + 1]) : cvt_pk(p1[r], p1[r + 1]); }
                const u32x4 u = (u32x4){w[0], w[1], w[2], w[3]}; pf[s] = __builtin_bit_cast(bf16x8, u); }
            u32x2 va[4][4];
            { const int vtb = (int)(unsigned)(size_t)(lds + KB + (kbase >> 6) * 8192) + vtr_base(lane); VTR_READ_ALL(va, vtb); }
            asm volatile("s_waitcnt lgkmcnt(0)" ::: "memory"); __builtin_amdgcn_sched_barrier(0);
#pragma unroll
            for (int s = 0; s < 4; ++s) {
                const u32x2 a00 = va[s][0], a01 = va[s][1], a10 = va[s][2], a11 = va[s][3];
                const u32x4 u0 = (u32x4){a00.x, a00.y, a01.x, a01.y}, u1 = (u32x4){a10.x, a10.y, a11.x, a11.y};
                o0 = __builtin_amdgcn_mfma_f32_32x32x16_bf16(__builtin_bit_cast(bf16x8, u0), pf[s], o0, 0, 0, 0);
                o1 = __builtin_amdgcn_mfma_f32_32x32x16_bf16(__builtin_bit_cast(bf16x8, u1), pf[s], o1, 0, 0, 0);
            }
        }
        float sm = 0.f;
#pragma unroll
        for (int r = 0; r < 16; ++r) { o0[r] *= 0.125f; o1[r] *= 0.125f; sm += o0[r] + o1[r]; }
        const float mu = xhalf_sum(sm) * (1.f / 64.f);
        float sq = 0.f;
#pragma unroll
        for (int r = 0; r < 16; ++r) { o0[r] -= mu; o1[r] -= mu; sq += o0[r] * o0[r] + o1[r] * o1[r]; }
        const float rstd = rsqrtf(xhalf_sum(sq) * (1.f / 64.f) + 1e-5f);
        bf16_t* yr = Y + (size_t)row * DM + h * 64 + 4 * hh;
#pragma unroll
        for (int g = 0; g < 4; ++g) {
            const uint2 ga = gga[g], gb = ggb[g];
            const float g0[4] = {bflo(ga.x), bfhi(ga.x), bflo(ga.y), bfhi(ga.y)}, g1[4] = {bflo(gb.x), bfhi(gb.x), bflo(gb.y), bfhi(gb.y)};
            float y0[4], y1[4];
#pragma unroll
            for (int j = 0; j < 4; ++j) { y0[j] = o0[4 * g + j] * rstd * g0[j] * __builtin_amdgcn_rcpf(1.f + __builtin_amdgcn_exp2f(-g0[j] * LOG2E)); y1[j] = o1[4 * g + j] * rstd * g1[j] * __builtin_amdgcn_rcpf(1.f + __builtin_amdgcn_exp2f(-g1[j] * LOG2E)); }
            *(uint2*)(yr + 8 * g) = make_uint2(cvt_pk(y0[0], y0[1]), cvt_pk(y0[2], y0[3]));
            *(uint2*)(yr + 32 + 8 * g) = make_uint2(cvt_pk(y1[0], y1[1]), cvt_pk(y1[2], y1[3]));
        }
    }
}

#define XB_TMO      128
#define XB_XCNT(j)  (256  + 64 * (j))
#define XB_XSUB(j)  (1280 + 64 * (j))
#define XB_XGEN(j)  (2304 + 64 * (j))
#define XB_TOP      3328
#define XB_TOPGEN   3392
#define XCD_BAR_WORDS 3456
#define XB_SPIN_CAP (1u << 18)

__device__ __forceinline__ unsigned xb_ld(unsigned* p)              { return __hip_atomic_load(p, __ATOMIC_RELAXED, __HIP_MEMORY_SCOPE_AGENT); }
__device__ __forceinline__ unsigned xb_add(unsigned* p, unsigned v) { return __hip_atomic_fetch_add(p, v, __ATOMIC_RELAXED, __HIP_MEMORY_SCOPE_AGENT); }
__device__ __forceinline__ unsigned xb_xcc_id() { return (unsigned)__builtin_amdgcn_s_getreg((3 << 11) | 20) & 0xFu; }
#define XB_SPIN(cond, bar) do { unsigned _sp = 0; while (cond) { __builtin_amdgcn_s_sleep(1); \
    if ((++_sp & 255u) == 0u) { if (xb_ld(&(bar)[XB_TMO])) break; if (_sp > XB_SPIN_CAP) { atomicAdd(&(bar)[XB_TMO], 1u); break; } } } } while (0)

struct XcdBarrier {
    unsigned* bar; unsigned x;
    volatile LAS unsigned* st;
};

__device__ __forceinline__ XcdBarrier xcd_barrier_post(unsigned* bar, volatile LAS unsigned* st) {
    XcdBarrier b; b.bar = bar; b.x = xb_xcc_id(); b.st = st;
    if (threadIdx.x == 0) (void)xb_add(&bar[XB_XCNT(b.x)], 1u);
    return b;
}
__device__ __forceinline__ void xcd_barrier_complete(unsigned* bar, unsigned x, unsigned& nloc, unsigned& nx) {
    const unsigned G = gridDim.x * gridDim.y * gridDim.z;
    unsigned sum, cnt, mine, sp = 0u;
    for (;;) {
        sum = 0u; cnt = 0u; mine = 0u;
#pragma unroll
        for (unsigned j = 0; j < 16; ++j) { const unsigned c = xb_ld(&bar[XB_XCNT(j)]); sum += c; cnt += (c > 0u) ? 1u : 0u; mine = (j == x) ? c : mine; }
        if (sum == G) break;
        __builtin_amdgcn_s_sleep(1);
        if ((++sp & 255u) == 0u) { if (xb_ld(&bar[XB_TMO])) break; if (sp > XB_SPIN_CAP) { atomicAdd(&bar[XB_TMO], 1u); break; } }
    }
    nloc = mine > 0u ? mine : 1u; nx = cnt > 0u ? cnt : 1u;
}

__device__ __forceinline__ void xcd_barrier(const XcdBarrier& b) {
    asm volatile("s_waitcnt vmcnt(0)" ::: "memory");
    __syncthreads();
    if (threadIdx.x == 0) {
        unsigned* bar = b.bar; unsigned bx = b.x; asm volatile("" : "+s"(bar), "+s"(bx));
        __builtin_amdgcn_s_waitcnt(0);
        unsigned nloc = b.st[0], nx = b.st[1];
        if (nloc == 0u) { xcd_barrier_complete(bar, bx, nloc, nx); b.st[0] = nloc; b.st[1] = nx; }
        const unsigned old = xb_add(&bar[XB_XSUB(bx)], 1u);
        const unsigned gen = old / nloc;
        if (old + 1u == (gen + 1u) * nloc) {
            __builtin_amdgcn_fence(__ATOMIC_RELEASE, "agent");
            asm volatile("s_waitcnt vmcnt(0)" ::: "memory");
            const unsigned og = xb_add(&bar[XB_TOP], 1u);
            const unsigned tg = og / nx;
            if (og + 1u == (tg + 1u) * nx) xb_add(&bar[XB_TOPGEN], 1u);
            else XB_SPIN(xb_ld(&bar[XB_TOPGEN]) == tg, bar);
            __builtin_amdgcn_fence(__ATOMIC_ACQUIRE, "agent");
            asm volatile("s_waitcnt vmcnt(0)" ::: "memory");
        } else {
            XB_SPIN(xb_ld(&bar[XB_TOPGEN]) == gen, bar);
            __builtin_amdgcn_fence(__ATOMIC_ACQUIRE, "agent");
            asm volatile("s_waitcnt vmcnt(0)" ::: "memory");
        }
    }
    __syncthreads();
}

constexpr int MK_LDS = 151552;
constexpr size_t CW_BAR = 4096;
__global__ void __launch_bounds__(512, 2) k_mega(Params p, int pad0, int pad1) {
    extern __shared__ __attribute__((aligned(16))) char smem[];
    volatile LAS unsigned* misc = (volatile LAS unsigned*)(smem + MK_LDS - 64);
    if (threadIdx.x < 16) misc[threadIdx.x] = 0u;
    __syncthreads();
    XcdBarrier bar = xcd_barrier_post(WSP(unsigned, O_CTL) + CW_BAR, misc);
#define GRID_BAR() xcd_barrier(bar)
    { const int myx = __builtin_amdgcn_readfirstlane((int)xb_xcc_id()), wantx = __builtin_amdgcn_readfirstlane((int)(blockIdx.x & 7u)), g256 = __builtin_amdgcn_readfirstlane((int)gridDim.x);
      unsigned mismv = (unsigned)(myx != wantx) | (unsigned)(g256 != 256);
      if (threadIdx.x == 0) __hip_atomic_fetch_or(WSP(unsigned, O_CANON), mismv, __ATOMIC_RELAXED, __HIP_MEMORY_SCOPE_AGENT); }
    st_mods(smem);
    st_prep_weights(0, 0, smem, (int)blockIdx.x, (int)gridDim.x);
    GRID_BAR();
    int canon_i = (int)__hip_atomic_load(WSP(unsigned, O_CANON), __ATOMIC_RELAXED, __HIP_MEMORY_SCOPE_AGENT); canon_i = __builtin_amdgcn_readfirstlane(canon_i); asm volatile("" : "+s"(canon_i));
    const bool canon = canon_i == 0;
    for (int l = 0; l < 2; ++l) {
        st_rownorm(l);
        GRID_BAR();
        st_gemm_win_fast(l, smem, canon);
        st_phase_c(l, smem, canon);
        GRID_BAR();
        st_ret_scan(l);
        GRID_BAR();
        st_mla_fast(l, smem); st_win_fast(l, smem); st_ret_fast(l, smem);
        GRID_BAR();
        st_gemm_wout_fast(l, smem, canon);
        if (!canon) GRID_BAR();
        st_norm2_router(l, smem, canon);
        {   const int G = (int)gridDim.x; int vb = (int)blockIdx.x, nb = G;
            if (l == 0) { if (canon) { const int cc = vcu_of((int)blockIdx.x, G); vb = (cc & 31) >= 4 ? (cc >> 5) * 28 + (cc & 31) - 4 : -1; nb = G - 32; } else { const int extra = 272 % G; vb = (int)blockIdx.x - extra; nb = G - extra; } }
            st_prep_weights(1, l, smem, vb, nb); }
        GRID_BAR();
        st_topk(l, smem);
        GRID_BAR();
        st_moe_up_fast(l, smem);
        GRID_BAR();
        st_moe_down_fast(l, smem);
        GRID_BAR();
    }
    st_rownorm(2);
}
}

extern "C" void kernel_launch(void* const* d_in, const int* in_sizes, int n_in, void* d_out, int out_size, void* d_ws, size_t ws_size, hipStream_t stream) {
    if (n_in != 23 || ws_size < O_END4) { fprintf(stderr, "kernel_launch: unexpected n_in %d or ws_size %zu (< %zu)\n", n_in, ws_size, (size_t)O_END4); return; }
    Params p{};
    const float** dst = (const float**)&p;
    for (int i = 0; i < 23; ++i) dst[i] = (const float*)d_in[i];
    p.out = (float*)d_out; p.ws = (unsigned char*)d_ws;
    static int grid = 0;
    if (grid == 0) {
        int dev = 0, cus = 0, per_cu = 0;
        if (hipGetDevice(&dev) != hipSuccess || hipDeviceGetAttribute(&cus, hipDeviceAttributeMultiprocessorCount, dev) != hipSuccess) { fprintf(stderr, "kernel_launch: device query failed\n"); grid = -1; return; }
        (void)hipFuncSetAttribute((const void*)k_mega, hipFuncAttributeMaxDynamicSharedMemorySize, MK_LDS);
        if (hipOccupancyMaxActiveBlocksPerMultiprocessor(&per_cu, (const void*)k_mega, 512, MK_LDS) != hipSuccess || per_cu < 1) { fprintf(stderr, "kernel_launch: occupancy query says %d\n", per_cu); per_cu = 1; }
        (void)hipGetLastError();
        grid = cus;
    }
    if (grid < 0) return;
    (void)hipMemsetAsync((char*)d_ws + O_CTL, 0, 65536, stream);
    hipLaunchKernelGGL(k_mega, dim3(grid), dim3(512), MK_LDS, stream, p, 0, 0);
}
```

```cpp
#include <hip/hip_runtime.h>
#include <stdint.h>
#include <stdio.h>

namespace {
typedef unsigned short bf16_t;
#define LAS __attribute__((address_space(3)))
constexpr int NB = 8, SEQ = 4096, CTXL = 256, DM = 1024;
constexpr int NLAT = NB * SEQ;
constexpr int NCTX = NB * CTXL;
constexpr int NROWS = NLAT + NCTX;
constexpr int NKEYS = CTXL + SEQ;
constexpr int PCOLS = 1952, PLD = 2048;
constexpr int C_RQ = 0, C_RK = 256, C_RV = 512, C_RG = 768, C_CQ = 1024, C_CKV = 1280, C_KR = 1408, C_WQ = 1440, C_WK = 1696, C_WV = 1824;
constexpr int NEXP = 16, FF = 768, CAP = 512, CAPC = 32;
constexpr float LOG2E = 1.4426950408889634f;

constexpr size_t O_CTL = 0;
constexpr size_t O_QCNT = 49152 + 1024;
constexpr size_t O_DEPW = 0;
constexpr size_t O_CANON = 49152 + 512;
constexpr size_t O_QXCD = 49152 + 4096;
constexpr size_t O_DEPX = 32768;
constexpr size_t O_DEPH = 49152 + 1024 + 512;
constexpr size_t O_RETLG = 49152;
constexpr size_t O_MOD = 65536;
constexpr size_t O_XC = 524288;
constexpr size_t O_AFF = O_XC + 8388608;
constexpr size_t O_IDX = O_AFF + 2228224;
constexpr size_t O_GATE = O_IDX + 262144;
constexpr size_t O_IDXC = O_GATE + 262144;
constexpr size_t O_GATEC = O_IDXC + 16384;
constexpr size_t O_SLOT = O_GATEC + 16384;
constexpr size_t O_WQ = O_SLOT + 1114112;
constexpr size_t O_WK = O_WQ + 17825792;
constexpr size_t O_WV = O_WK + 8912896;
constexpr size_t O_HX = O_WV + 8912896;
constexpr size_t O_P = O_HX + 71303168;
constexpr size_t O_QM = O_P + 142606336;
constexpr size_t O_KM = O_QM + 53477376;
constexpr size_t O_VM = O_KM + 53477376;
constexpr size_t O_END = O_VM + 35651584;
constexpr size_t O_WINT = O_END;
constexpr size_t O_WOUTT = O_WINT + 2 * 2048 * 1024 * 2;
constexpr size_t O_WGUT = O_WOUTT + 2 * 1024 * 1024 * 2;
constexpr size_t O_WDT = O_WGUT + (size_t)16 * 1536 * 1024 * 2;
constexpr size_t O_END2 = O_WDT + (size_t)16 * 1024 * 768 * 2;

constexpr size_t O_VT = O_END2;
constexpr size_t O_END3 = O_VT + 35651584;
constexpr size_t O_WVT = O_WV;
constexpr size_t O_RVT = O_WGUT;
constexpr size_t O_KVF = O_RVT + 17825792;
constexpr size_t O_KVB = O_KVF + 17825792;
constexpr size_t O_SPF = O_KVB + 17825792;
constexpr size_t O_SPB = O_SPF + 8912896;
static_assert(O_SPB + 8912896 <= O_WDT + (size_t)16 * 1024 * 768 * 2, "retention buffers fit in the expert-weight region");
constexpr size_t O_WUQT = O_END3;
constexpr size_t O_WUKT = O_WUQT + 2 * 768 * 256 * 2;
constexpr size_t O_WUVT = O_WUKT + 2 * 512 * 128 * 2;
constexpr size_t O_END4 = O_WUVT + 2 * 512 * 128 * 2;
constexpr size_t O_SSQ = O_WQ;
constexpr size_t O_HID = O_P;
constexpr size_t O_HIDC = O_P + 100663296;
constexpr size_t O_YS = O_QM;
constexpr size_t O_YSC = O_QM + 134217728;

struct Params {
    const float *x, *c, *ctx, *c_ctx, *norm1_g, *norm2_g, *ada_w, *ada_b, *w_in, *ret_decay_f, *ret_decay_b,
        *mla_qnorm_g, *mla_kvnorm_g, *mla_w_uq, *mla_w_uk, *mla_w_uv, *win_sink, *w_out, *router_w,
        *exp_w_gate, *exp_w_up, *exp_w_down, *final_g;
    float* out; unsigned char* ws;
};

typedef const __attribute__((address_space(4))) Params KParams;
__device__ __forceinline__ int opaque_tid() { int t = (int)threadIdx.x; asm volatile("" : "+v"(t)); return t; }
#define STAGE_PARAMS() KParams* pp_ = (KParams*)__builtin_amdgcn_kernarg_segment_ptr(); asm volatile("" : "+s"(pp_)); KParams& p = *pp_; const int tid_ = opaque_tid(); int bid_ = (int)blockIdx.x, G_ = (int)gridDim.x; asm volatile("" : "+s"(bid_), "+s"(G_))
__device__ __forceinline__ float bf2f(bf16_t v) { return __uint_as_float(((unsigned)v) << 16); }
__device__ __forceinline__ float bflo(unsigned v) { return __uint_as_float(v << 16); }
__device__ __forceinline__ float bfhi(unsigned v) { return __uint_as_float(v & 0xffff0000u); }
__device__ __forceinline__ unsigned f2bf(float f) { unsigned u = __float_as_uint(f); return (u + 0x7fffu + ((u >> 16) & 1u)) >> 16; }
__device__ __forceinline__ unsigned pk2(float lo, float hi) { return f2bf(lo) | (f2bf(hi) << 16); }
__device__ __forceinline__ float wave_sum(float v) {
    v += __int_as_float(__builtin_amdgcn_ds_swizzle(__float_as_int(v), (1 << 10) | 0x1f));
    v += __int_as_float(__builtin_amdgcn_ds_swizzle(__float_as_int(v), (2 << 10) | 0x1f));
    v += __int_as_float(__builtin_amdgcn_ds_swizzle(__float_as_int(v), (4 << 10) | 0x1f));
    v += __int_as_float(__builtin_amdgcn_ds_swizzle(__float_as_int(v), (8 << 10) | 0x1f));
    v += __int_as_float(__builtin_amdgcn_ds_swizzle(__float_as_int(v), (16 << 10) | 0x1f));
    const auto rr = __builtin_amdgcn_permlane32_swap(__float_as_uint(v), __float_as_uint(v), false, false);
    return __uint_as_float(rr[0]) + __uint_as_float(rr[1]);
}
__device__ __forceinline__ float wave_max(float v) {
    v = fmaxf(v, __int_as_float(__builtin_amdgcn_ds_swizzle(__float_as_int(v), (1 << 10) | 0x1f)));
    v = fmaxf(v, __int_as_float(__builtin_amdgcn_ds_swizzle(__float_as_int(v), (2 << 10) | 0x1f)));
    v = fmaxf(v, __int_as_float(__builtin_amdgcn_ds_swizzle(__float_as_int(v), (4 << 10) | 0x1f)));
    v = fmaxf(v, __int_as_float(__builtin_amdgcn_ds_swizzle(__float_as_int(v), (8 << 10) | 0x1f)));
    v = fmaxf(v, __int_as_float(__builtin_amdgcn_ds_swizzle(__float_as_int(v), (16 << 10) | 0x1f)));
    const auto rr = __builtin_amdgcn_permlane32_swap(__float_as_uint(v), __float_as_uint(v), false, false);
    return fmaxf(__uint_as_float(rr[0]), __uint_as_float(rr[1]));
}
__device__ __forceinline__ float lane_bcast(float v, int srclane  ) { return __uint_as_float(__builtin_amdgcn_readlane(__float_as_uint(v), srclane)); }
__device__ __forceinline__ float silu_f(float v) { return v / (1.f + expf(-v)); }

#define WSP(T, off) ((T*)(p.ws + (off)))
template <class PT> __device__ __forceinline__ float* xrow_ptr(const PT& p, int row) { return row < NLAT ? p.out + (size_t)row * DM : WSP(float, O_XC) + (size_t)(row - NLAT) * DM; }
template <class PT> __device__ __forceinline__ const float* mod_ptr(const PT& p, int layer, int bv, int chunk) { return WSP(const float, O_MOD) + ((size_t)(layer * 9 + bv) * 6 + chunk) * 1024; }
struct RowInfo { int b, t, isctx, bv, key; };
__device__ __forceinline__ RowInfo row_info(int row) {
    RowInfo r;
    if (row < NLAT) { r.b = row >> 12; r.t = row & 4095; r.isctx = 0; r.bv = r.b; r.key = 256 + r.t; }
    else { const int q = row - NLAT; r.b = q >> 8; r.t = q & 255; r.isctx = 1; r.bv = 8; r.key = r.t; }
    return r;
}

__constant__ float ROPE_INV8[8] = {1.f, 0.31622776601683794f, 0.1f, 0.031622776601683794f, 0.01f, 0.0031622776601683794f, 0.001f, 0.00031622776601683794f};
__constant__ float ROPE_INV16[16] = {1.f, 0.5623413251903491f, 0.31622776601683794f, 0.1778279410038923f, 0.1f, 0.05623413251903491f, 0.031622776601683794f, 0.01778279410038923f,
                                     0.01f, 0.005623413251903491f, 0.0031622776601683794f, 0.001778279410038923f, 0.001f, 0.0005623413251903491f, 0.00031622776601683794f, 0.0001778279410038923f};
__device__ __forceinline__ void sincos_acc(float ang, float& s, float& c) {
    float rev = ang * 0.15915494309189535f;
    rev -= floorf(rev);
    s = __builtin_amdgcn_sinf(rev); c = __builtin_amdgcn_cosf(rev);
}

__device__ __forceinline__ int vcu_of(int bid, int G) { return (G % 8 == 0) ? (bid % 8) * (G / 8) + bid / 8 : bid; }
__device__ __forceinline__ void st_mods(char* smem) {
    STAGE_PARAMS();
    float* sv = (float*)smem;
    float* red = sv + 9 * 1024;
    const int tid = tid_;
    if (bid_ == 0 && tid < 16) { const int l = tid >> 3, dir = (tid >> 2) & 1, h = tid & 3;
        const double dec = (double)(dir ? p.ret_decay_b : p.ret_decay_f)[l * 4 + h];
        WSP(float, O_RETLG)[tid] = (float)(log1p(-exp2(dec)) * 1.4426950408889634); }
    for (int i = tid; i < 9 * 1024; i += 512) { const int v = i >> 10, k = i & 1023; const float c = v < 8 ? p.c[v * 1024 + k] : p.c_ctx[k]; sv[i] = silu_f(c); }
    __syncthreads();
    for (int item = bid_; item < 2 * 96; item += G_) {
        const int l = item / 96, j0 = (item % 96) * 64, col = tid & 63, kq = tid >> 6;
        float acc[9];
#pragma unroll
        for (int v = 0; v < 9; ++v) acc[v] = 0.f;
        const float* W = p.ada_w + (size_t)l * 1024 * 6144 + j0 + col;
        for (int k = kq * 128; k < kq * 128 + 128; ++k) {
            const float w = W[(size_t)k * 6144];
#pragma unroll
            for (int v = 0; v < 9; ++v) acc[v] += sv[v * 1024 + k] * w;
        }
#pragma unroll
        for (int v = 0; v < 9; ++v) red[(kq * 9 + v) * 64 + col] = acc[v];
        __syncthreads();
        for (int i = tid; i < 576; i += 512) {
            const int v = i >> 6, cc = i & 63; float s = 0.f;
#pragma unroll
            for (int q = 0; q < 8; ++q) s += red[(q * 9 + v) * 64 + cc];
            WSP(float, O_MOD)[(size_t)(l * 9 + v) * 6144 + j0 + cc] = s + p.ada_b[l * 6144 + j0 + cc];
        }
        __syncthreads();
    }
}

__device__ __forceinline__ void st_rownorm(int mode) {
    STAGE_PARAMS();
    typedef float f32x4v __attribute__((ext_vector_type(4)));
    const int lane = tid_ & 63, wave = tid_ >> 6;
    const int gw = bid_ * 8 + wave, NGW = G_ * 8;
    const int nrows = mode == 2 ? NLAT : NROWS;
    f32x4v vn[4]; uint4 sn0 = make_uint4(0u, 0u, 0u, 0u), sn1 = sn0;
#define RN_SRC(r) (mode == 0 ? ((r) >= NLAT ? p.ctx + (size_t)((r) - NLAT) * DM : p.x + (size_t)(r) * DM) : (const float*)xrow_ptr(p, (r)))
    if (gw < nrows) { const float* src = RN_SRC(gw);
#pragma unroll
        for (int j = 0; j < 4; ++j) vn[j] = ((const f32x4v*)src)[lane + 64 * j];
        if (mode != 0) { const uint4* sl = (const uint4*)(WSP(const short, O_SLOT) + (size_t)gw * 16); sn0 = sl[0]; sn1 = sl[1]; } }
    for (int row = gw; row < nrows; row += NGW) {
        const RowInfo ri = row_info(row);
        f32x4v v[4];
#pragma unroll
        for (int j = 0; j < 4; ++j) v[j] = vn[j];
        const unsigned sw[8] = {sn0.x, sn0.y, sn0.z, sn0.w, sn1.x, sn1.y, sn1.z, sn1.w};
        const int nrow = row + NGW;
        if (nrow < nrows) { const float* src = RN_SRC(nrow);
#pragma unroll
            for (int j = 0; j < 4; ++j) vn[j] = ((const f32x4v*)src)[lane + 64 * j];
            if (mode != 0) { const uint4* sl = (const uint4*)(WSP(const short, O_SLOT) + (size_t)nrow * 16); sn0 = sl[0]; sn1 = sl[1]; } }
        f32x4v pg5[4], pg1[4], psc[4], psh[4];
        {   const float* g5p = mode != 0 ? mod_ptr(p, mode - 1, ri.bv, 5) : p.final_g;
            const float* g1p = mode == 2 ? p.final_g : p.norm1_g + mode * 1024;
            const float* shp = mode == 2 ? p.final_g : mod_ptr(p, mode, ri.bv, 0); const float* scp = mode == 2 ? p.final_g : mod_ptr(p, mode, ri.bv, 1);
#pragma unroll
            for (int j = 0; j < 4; ++j) { if (mode != 0) pg5[j] = ((const f32x4v*)g5p)[lane + 64 * j]; pg1[j] = ((const f32x4v*)g1p)[lane + 64 * j];
                if (mode != 2) { psc[j] = ((const f32x4v*)scp)[lane + 64 * j]; psh[j] = ((const f32x4v*)shp)[lane + 64 * j]; } } }
        __builtin_amdgcn_sched_barrier(0);
        if (mode != 0) {
            const int lprev = mode - 1;
            f32x4v a[4];
#pragma unroll
            for (int j = 0; j < 4; ++j) a[j] = (f32x4v){0.f, 0.f, 0.f, 0.f};
#pragma unroll
            for (int g8 = 0; g8 < 4; ++g8) {
                uint2 yb[4][4];
#pragma unroll
                for (int k = 0; k < 4; ++k) { const int e = 4 * g8 + k;
                    const int s = (int)(short)((e & 1) ? (sw[e >> 1] >> 16) : (sw[e >> 1] & 0xffffu));
                    if (s >= 0) {
                        const bf16_t* yr = ri.isctx ? WSP(const bf16_t, O_YSC) + ((size_t)e * 256 + ri.b * 32 + s) * 1024
                                                    : WSP(const bf16_t, O_YS) + ((size_t)(ri.b * 16 + e) * 512 + s) * 1024;
#pragma unroll
                        for (int j = 0; j < 4; ++j) yb[k][j] = ((const uint2*)yr)[lane + 64 * j];
                    } }
                __builtin_amdgcn_sched_barrier(0);
#pragma unroll
                for (int k = 0; k < 4; ++k) { const int e = 4 * g8 + k;
                    const int s = (int)(short)((e & 1) ? (sw[e >> 1] >> 16) : (sw[e >> 1] & 0xffffu));
                    if (s >= 0) {
#pragma unroll
                        for (int j = 0; j < 4; ++j) { const uint2 u = yb[k][j]; a[j].x += bflo(u.x); a[j].y += bfhi(u.x); a[j].z += bflo(u.y); a[j].w += bfhi(u.y); }
                    } }
            }
            float* dst = xrow_ptr(p, row);
#pragma unroll
            for (int j = 0; j < 4; ++j) {
                v[j] += pg5[j] * a[j];
                if (mode == 1) ((f32x4v*)dst)[lane + 64 * j] = v[j];
            }
        }
        float ss = 0.f;
#pragma unroll
        for (int j = 0; j < 4; ++j) ss += v[j].x * v[j].x + v[j].y * v[j].y + v[j].z * v[j].z + v[j].w * v[j].w;
        ss = wave_sum(ss);
        const float rstd = rsqrtf(ss * (1.f / 1024.f) + 1e-6f);
        if (mode == 2) {
#pragma unroll
            for (int j = 0; j < 4; ++j) ((f32x4v*)(p.out + (size_t)row * DM))[lane + 64 * j] = v[j] * rstd * pg1[j];
        } else {
            const int layer = mode;
            bf16_t* hx = WSP(bf16_t, O_HX) + (size_t)row * DM;
#pragma unroll
            for (int j = 0; j < 4; ++j) {
                const f32x4v h = v[j] * rstd * pg1[j] * (psc[j] + 1.f) + psh[j];
                ((uint2*)hx)[lane + 64 * j] = make_uint2(pk2(h.x, h.y), pk2(h.z, h.w));
            }
        }
    }
#undef RN_SRC
}

__device__ __forceinline__ int opq(int v) { asm volatile("" : "+v"(v)); return v; }


__device__ __forceinline__ void st_norm2_router(int layer, char* smem, bool canon) {
    STAGE_PARAMS();
    typedef float f32x4v __attribute__((ext_vector_type(4)));
    typedef short bf16x8v __attribute__((ext_vector_type(8)));
    typedef unsigned u32x4v __attribute__((ext_vector_type(4)));
    LAS unsigned char* lds = (LAS unsigned char*)(LAS char*)smem;
    constexpr int WS = 2064;
    LAS unsigned short* whi = (LAS unsigned short*)lds; LAS unsigned short* wlo = (LAS unsigned short*)(lds + 16 * WS);
    LAS float* gg = (LAS float*)(lds + 32 * WS); LAS float* s4 = gg + 1024;
    const int tid = tid_, lane = tid & 63, wave = tid >> 6, r16 = lane & 15, kg = lane >> 4;
    const int nrows = layer == 0 ? NROWS : NLAT;
    { const float* RW = p.router_w + (size_t)layer * 1024 * 16;
      for (int i = tid; i < 1024 * 16; i += 512) { const float w = RW[i]; const unsigned hi = f2bf(w); const unsigned lo = f2bf(w - __uint_as_float(hi << 16));
          whi[(i & 15) * (WS / 2) + (i >> 4)] = (unsigned short)hi; wlo[(i & 15) * (WS / 2) + (i >> 4)] = (unsigned short)lo; } }
    const float* g2 = p.norm2_g + layer * 1024;
    const int cx = vcu_of(bid_, G_), xj = cx & 31, xx = cx >> 5;
    const int nmine = canon ? 1 + ((layer == 0 && (xj == 2 || xj == 3)) ? 1 : 0) : (nrows / 128 - bid_ + G_ - 1) / G_;
    for (int kk = 0; kk < nmine; ++kk) {
        int chunk;
        if (canon) { const int mt = kk == 0 ? xj >> 1 : 16, pm = mt < 8 ? 8 * xx + mt : (mt < 16 ? 64 + 8 * xx + (mt - 8) : 128 + xx); chunk = pm * 2 + (xj & 1);
            if (tid == 0) { const unsigned* dw = WSP(const unsigned, O_DEPX) + (layer * 136 + pm) * 8;
                for (unsigned spins = 0; __hip_atomic_load(dw, __ATOMIC_RELAXED, __HIP_MEMORY_SCOPE_AGENT) < 32u && spins < (1u << 24); ++spins) __builtin_amdgcn_s_sleep(2);
                __builtin_amdgcn_fence(__ATOMIC_ACQUIRE, "agent"); asm volatile("s_waitcnt vmcnt(0)" ::: "memory"); } }
        else chunk = bid_ + kk * G_;
        const int row0 = chunk * 128; const RowInfo ri = row_info(row0);
        __syncthreads();
        { const float* sh = mod_ptr(p, layer, ri.bv, 3); const float* sc = mod_ptr(p, layer, ri.bv, 4);
          for (int i = tid; i < 1024; i += 512) { gg[i] = g2[i] * (1.f + sc[i]); s4[i] = sh[i]; } }
        __syncthreads();
        const int row = row0 + wave * 16 + r16;
        const f32x4v* xr = (const f32x4v*)xrow_ptr(p, row) + 2 * kg;
        float ss;
        { const float* sq = WSP(const float, O_SSQ) + (size_t)(4 * kg) * NROWS + row; ss = (sq[0] + sq[NROWS]) + (sq[2 * (size_t)NROWS] + sq[3 * (size_t)NROWS]); }
        ss += __int_as_float(__builtin_amdgcn_ds_swizzle(__float_as_int(ss), (16 << 10) | 0x1f));
        { const auto rr = __builtin_amdgcn_permlane32_swap(__float_as_uint(ss), __float_as_uint(ss), false, false); ss = __uint_as_float(rr[0]) + __uint_as_float(rr[1]); }
        const float rstd = rsqrtf(ss * (1.f / 1024.f) + 1e-6f);
        bf16_t* h2 = WSP(bf16_t, O_HX) + (size_t)row * DM + 8 * kg;
        const LAS unsigned char* wb = lds + r16 * WS + 16 * kg;
        f32x4v acc = (f32x4v){0.f, 0.f, 0.f, 0.f};
        f32x4v xa[4], xb[4];
#pragma unroll
        for (int j = 0; j < 4; ++j) { xa[j] = xr[8 * j]; xb[j] = xr[8 * j + 1]; }
#pragma unroll 1
        for (int sg = 0; sg < 32; sg += 4) {
          f32x4v ca[4], cb[4];
#pragma unroll
          for (int j = 0; j < 4; ++j) { ca[j] = xa[j]; cb[j] = xb[j]; }
          if (sg + 4 < 32) {
#pragma unroll
              for (int j = 0; j < 4; ++j) { xa[j] = xr[8 * (sg + 4 + j)]; xb[j] = xr[8 * (sg + 4 + j) + 1]; } }
          __builtin_amdgcn_sched_barrier(0);
#pragma unroll
          for (int j = 0; j < 4; ++j) {
            const int s = sg + j;
            const f32x4v a = ca[j], b = cb[j];
            const f32x4v ga = *(const LAS f32x4v*)(gg + 32 * s + 8 * kg), gb = *(const LAS f32x4v*)(gg + 32 * s + 8 * kg + 4), sa = *(const LAS f32x4v*)(s4 + 32 * s + 8 * kg), sb = *(const LAS f32x4v*)(s4 + 32 * s + 8 * kg + 4);
            const f32x4v ha = a * rstd * ga + sa, hb = b * rstd * gb + sb;
            u32x4v hi, lo;
            hi.x = pk2(ha.x, ha.y); hi.y = pk2(ha.z, ha.w); hi.z = pk2(hb.x, hb.y); hi.w = pk2(hb.z, hb.w);
            lo.x = pk2(ha.x - bflo(hi.x), ha.y - bfhi(hi.x)); lo.y = pk2(ha.z - bflo(hi.y), ha.w - bfhi(hi.y));
            lo.z = pk2(hb.x - bflo(hi.z), hb.y - bfhi(hi.z)); lo.w = pk2(hb.z - bflo(hi.w), hb.w - bfhi(hi.w));
            *(u32x4v*)(h2 + 32 * s) = hi;
            const bf16x8v wh = *(const LAS bf16x8v*)(wb + 64 * s), wl = *(const LAS bf16x8v*)(wb + 16 * WS + 64 * s);
            const bf16x8v hiv = __builtin_bit_cast(bf16x8v, hi), lov = __builtin_bit_cast(bf16x8v, lo);
            acc = __builtin_amdgcn_mfma_f32_16x16x32_bf16(hiv, wh, acc, 0, 0, 0);
            acc = __builtin_amdgcn_mfma_f32_16x16x32_bf16(hiv, wl, acc, 0, 0, 0);
            acc = __builtin_amdgcn_mfma_f32_16x16x32_bf16(lov, wh, acc, 0, 0, 0);
          }
        }
#pragma unroll
        for (int q = 0; q < 4; ++q) {
            float mx = acc[q];
            mx = fmaxf(mx, __int_as_float(__builtin_amdgcn_ds_swizzle(__float_as_int(mx), (1 << 10) | 0x1f)));
            mx = fmaxf(mx, __int_as_float(__builtin_amdgcn_ds_swizzle(__float_as_int(mx), (2 << 10) | 0x1f)));
            mx = fmaxf(mx, __int_as_float(__builtin_amdgcn_ds_swizzle(__float_as_int(mx), (4 << 10) | 0x1f)));
            mx = fmaxf(mx, __int_as_float(__builtin_amdgcn_ds_swizzle(__float_as_int(mx), (8 << 10) | 0x1f)));
            const float ex = expf(acc[q] - mx);
            float sm = ex;
            sm += __int_as_float(__builtin_amdgcn_ds_swizzle(__float_as_int(sm), (1 << 10) | 0x1f));
            sm += __int_as_float(__builtin_amdgcn_ds_swizzle(__float_as_int(sm), (2 << 10) | 0x1f));
            sm += __int_as_float(__builtin_amdgcn_ds_swizzle(__float_as_int(sm), (4 << 10) | 0x1f));
            sm += __int_as_float(__builtin_amdgcn_ds_swizzle(__float_as_int(sm), (8 << 10) | 0x1f));
            WSP(float, O_AFF)[(size_t)(row0 + wave * 16 + 4 * kg + q) * 16 + r16] = ex / sm;
        }
    }
    __syncthreads();
}

__device__ __forceinline__ void st_topk(int layer, char* smem) {
    STAGE_PARAMS();
    float* wcnt = (float*)smem;
    unsigned* wsum = (unsigned*)(wcnt + 24);
    const int tid = tid_, lane = tid & 63, wave = tid >> 6;
    const int nprob = layer == 0 ? 256 : 128;
    const float* AFF = WSP(const float, O_AFF);
    for (int pr = bid_; pr < nprob; pr += G_) {
        const bool isctx = pr >= 128; const int be = pr & 127, b = be >> 4, e = be & 15;
        const int n = isctx ? CTXL : SEQ, kk = isctx ? CAPC : CAP;
        const size_t row0 = isctx ? (size_t)NLAT + b * CTXL : (size_t)b * SEQ;
        unsigned kx[8];
#pragma unroll
        for (int u = 0; u < 8; ++u) { const int t = tid * 8 + u; kx[u] = (t < n) ? __float_as_uint(AFF[(row0 + t) * 16 + e]) : 0u; }
        __syncthreads();
        unsigned T = 0u; int par = 0;
        for (int bit = 29; bit >= -1; --bit) {
            const unsigned cand = bit >= 0 ? (T | (1u << bit)) : T + 1u;
            float c = 0.f;
#pragma unroll
            for (int u = 0; u < 8; ++u) c += (kx[u] >= cand) ? 1.f : 0.f;
            c = wave_sum(c);
            if (lane == 0) wcnt[par * 8 + wave] = c;
            __syncthreads();
            float tot = 0.f;
#pragma unroll
            for (int w = 0; w < 8; ++w) tot += wcnt[par * 8 + w];
            par ^= 1;
            if (bit >= 0) { if (tot >= (float)kk) T = cand; }
            else wcnt[16 + 0] = tot;
        }
        __syncthreads();
        const int krem = kk - (int)wcnt[16];
        unsigned cg = 0u, ce = 0u;
#pragma unroll
        for (int u = 0; u < 8; ++u) { cg += (kx[u] > T) ? 1u : 0u; ce += (kx[u] == T) ? 1u : 0u; }
        const unsigned packed = cg | (ce << 16);
        unsigned incl = packed;
#pragma unroll
        for (int o = 1; o < 64; o <<= 1) { const unsigned t2 = (unsigned)__builtin_amdgcn_ds_bpermute(((lane - o) & 63) << 2, (int)incl); if (lane >= o) incl += t2; }
        if (lane == 63) wsum[wave] = incl;
        __syncthreads();
        unsigned off = 0u;
        for (int w = 0; w < wave; ++w) off += wsum[w];
        const unsigned excl = incl - packed + off;
        unsigned gpre = excl & 0xFFFFu, epre = excl >> 16;
        int* IDX = isctx ? WSP(int, O_IDXC) + e * 256 + b * CAPC : WSP(int, O_IDX) + be * CAP;
        float* GT = isctx ? WSP(float, O_GATEC) + e * 256 + b * CAPC : WSP(float, O_GATE) + be * CAP;
        short* SL = WSP(short, O_SLOT);
#pragma unroll
        for (int u = 0; u < 8; ++u) {
            const int t = tid * 8 + u;
            if (t < n) {
                const unsigned k = kx[u]; const bool g = k > T, eq = k == T;
                const bool sel = g || (eq && (int)epre < krem);
                const int slot = (int)gpre + ((int)epre < krem ? (int)epre : krem);
                if (sel) { IDX[slot] = (int)row0 + t; GT[slot] = __uint_as_float(k); }
                SL[(row0 + t) * 16 + e] = sel ? (short)slot : (short)-1;
                gpre += g ? 1u : 0u; epre += eq ? 1u : 0u;
            }
        }
        __syncthreads();
    }
}


namespace pg {
typedef short bf16x8 __attribute__((ext_vector_type(8)));
typedef float f32x4 __attribute__((ext_vector_type(4)));
typedef unsigned u32x4 __attribute__((ext_vector_type(4)));
constexpr int BM = 256, BK = 64, HALF = 128, HTB = HALF * BK * 2, STAGE_BYTES = 8 * HTB;
__device__ __forceinline__ int lds_byte(int r, int c) { const int st = (r >> 4) * 2 + (c >> 5), rr = r & 15, cc = c & 31, ob = rr * 64 + cc * 2; return st * 1024 + (ob ^ (((ob >> 9) & 1) << 5)); }
__device__ __forceinline__ void stage_rc(int b, int& R, int& C) { const int st = b / 1024, sb = b % 1024, swz = sb ^ (((sb >> 9) & 1) << 5); R = (st >> 1) * 16 + swz / 64; C = (st & 1) * 32 + (swz % 64) / 2; }
__device__ __forceinline__ int perm32(int rho) { const int n = rho >> 4, i = rho & 15; return 8 * (i >> 2) + 4 * n + (i & 3); }
__device__ __forceinline__ unsigned cvt_pk_bf16(float lo, float hi) { unsigned r; asm volatile("v_cvt_pk_bf16_f32 %0, %1, %2" : "=v"(r) : "v"(lo), "v"(hi)); return r; }

template <bool GATHER, class Epi, class Sched>
__device__ __forceinline__ void gemm_run(LAS unsigned char* lds, const int K, const Sched& S, const Epi& E, const int tid) {
    typedef typename Sched::Unit Unit;
    const int wid = __builtin_amdgcn_readfirstlane(tid >> 6), lane = tid & 63, wr = wid >> 2, wc = wid & 3, fr = lane & 15, fq = lane >> 4;
    const int nt = K / BK;
    int Rs[2], Cs[2]; unsigned voffB[2], voffA[2];
#pragma unroll
    for (int i = 0; i < 2; ++i) { stage_rc(tid * 16 + i * 8192, Rs[i], Cs[i]); const int Rb = (Rs[i] & ~31) + perm32(Rs[i] & 31); voffB[i] = (unsigned)(Rb * K + Cs[i]) * 2u; voffA[i] = (unsigned)(Rs[i] * K + Cs[i]) * 2u; }
    const size_t kstep = (size_t)(BK * 2);
    const size_t hstepB = (size_t)HALF * K * 2;
    const unsigned ldsw = (unsigned)wid * 1024u;
    const int aoff = lds_byte(wr * 64 + fr, fq * 8), boff = lds_byte(wc * 32 + fr, fq * 8);
#define PG_SA(b, h) (((b) * 2 + (h)) * HTB)
#define PG_SB(b, h) ((4 + (b) * 2 + (h)) * HTB)
#define PG_STAGE_B(bufoff, gbase) do { _Pragma("unroll") for (int _i = 0; _i < 2; ++_i) \
        __builtin_amdgcn_global_load_lds((const unsigned*)((const char*)(gbase) + voffB[_i]), (LAS unsigned*)(lds + (bufoff) + ldsw + _i * 8192), 16, 0, 0); } while (0)
#define PG_GLDS(src_, dst_) __builtin_amdgcn_global_load_lds((const unsigned*)(src_), (LAS unsigned*)(dst_), 16, 0, 0)
#define PG_STAGE_A(bufoff, gbase, h, NXT) do { \
        if constexpr (GATHER) { if (NXT) { PG_GLDS((const char*)(gbase) + ((h) ? on10 : on00), lds + (bufoff) + ldsw); PG_GLDS((const char*)(gbase) + ((h) ? on11 : on01), lds + (bufoff) + ldsw + 8192); } \
                                else     { PG_GLDS((const char*)(gbase) + ((h) ? oc10 : oc00), lds + (bufoff) + ldsw); PG_GLDS((const char*)(gbase) + ((h) ? oc11 : oc01), lds + (bufoff) + ldsw + 8192); } } \
        else { PG_GLDS((const char*)(gbase) + (size_t)(h) * hstepB + voffA[0], lds + (bufoff) + ldsw); PG_GLDS((const char*)(gbase) + (size_t)(h) * hstepB + voffA[1], lds + (bufoff) + ldsw + 8192); } } while (0)
#define PG_LDA(dst, b, h) do { _Pragma("unroll") for (int m = 0; m < 4; ++m) _Pragma("unroll") for (int k = 0; k < 2; ++k) dst[m][k] = *(const LAS bf16x8*)(lds + PG_SA(b, h) + aoff + m * 2048 + k * 1024); } while (0)
#define PG_LDB(dst, b, h) do { _Pragma("unroll") for (int n = 0; n < 2; ++n) _Pragma("unroll") for (int k = 0; k < 2; ++k) dst[n][k] = *(const LAS bf16x8*)(lds + PG_SB(b, h) + boff + n * 2048 + k * 1024); } while (0)
#define PG_MMA(ai, bj, At, Bt) do { __builtin_amdgcn_s_setprio(1); _Pragma("unroll") for (int m = 0; m < 4; ++m) _Pragma("unroll") for (int n = 0; n < 2; ++n) _Pragma("unroll") for (int k = 0; k < 2; ++k) \
        acc[ai][bj][m][n] = __builtin_amdgcn_mfma_f32_16x16x32_bf16(Bt[n][k], At[m][k], acc[ai][bj][m][n], 0, 0, 0); __builtin_amdgcn_s_setprio(0); } while (0)
#define PG_WAIT_V(n) asm volatile("s_waitcnt vmcnt(" #n ")" ::: "memory")
#define PG_WAIT_L(n) asm volatile("s_waitcnt lgkmcnt(" #n ")" ::: "memory")
#define PG_BAR __builtin_amdgcn_s_barrier()
#define PG_SCHED __builtin_amdgcn_sched_barrier(0)
    Unit cur, nxt; int ui = 0;
    if (!S.next(0, cur)) return;
    f32x4 acc[2][2][4][2];
#pragma unroll
    for (int a = 0; a < 2; ++a)
#pragma unroll
        for (int b = 0; b < 2; ++b)
#pragma unroll
            for (int m = 0; m < 4; ++m)
#pragma unroll
                for (int n = 0; n < 2; ++n) acc[a][b][m][n] = (f32x4){0.f, 0.f, 0.f, 0.f};
    bf16x8 At[4][2], B0[2][2], B1[2][2];
    unsigned oc00 = 0, oc01 = 0, oc10 = 0, oc11 = 0, on00 = 0, on01 = 0, on10 = 0, on11 = 0;
    if constexpr (GATHER) { oc00 = S.a_off(cur, Rs[0]) + (unsigned)Cs[0] * 2u; oc01 = S.a_off(cur, Rs[1]) + (unsigned)Cs[1] * 2u;
        oc10 = S.a_off(cur, HALF + Rs[0]) + (unsigned)Cs[0] * 2u; oc11 = S.a_off(cur, HALF + Rs[1]) + (unsigned)Cs[1] * 2u; }
    const char* cA = S.a_base(cur); const char* cB = S.b_base(cur);
    PG_STAGE_B(PG_SB(0, 0), cB); PG_STAGE_B(PG_SB(0, 1), cB + hstepB); PG_STAGE_A(PG_SA(0, 0), cA, 0, false); PG_STAGE_A(PG_SA(0, 1), cA, 1, false);
    if (wr == 1) PG_BAR;
    PG_WAIT_V(2); PG_BAR;
    PG_STAGE_B(PG_SB(1, 0), cB + kstep); PG_STAGE_A(PG_SA(1, 0), cA + kstep, 0, false); PG_STAGE_B(PG_SB(1, 1), cB + hstepB + kstep);
    PG_WAIT_V(6); PG_BAR;
    int psig = -1;
    for (;;) {
        const bool has_next = S.next(ui + 1, nxt);
        const char* nA = cA; const char* nB = cB;
        if (has_next) { nA = S.a_base(nxt); nB = S.b_base(nxt); }
        for (int t = 0; t < nt; t += 2) {
            const bool last = (t == nt - 2);
            if constexpr (GATHER) { if (last) {
                const Unit& nu = has_next ? nxt : cur;
                on00 = S.a_off(nu, Rs[0]) + (unsigned)Cs[0] * 2u; on01 = S.a_off(nu, Rs[1]) + (unsigned)Cs[1] * 2u;
                on10 = S.a_off(nu, HALF + Rs[0]) + (unsigned)Cs[0] * 2u; on11 = S.a_off(nu, HALF + Rs[1]) + (unsigned)Cs[1] * 2u; } }
            const char* a1 = cA + (size_t)(t + 1) * kstep;
            const char* a2 = last ? nA : cA + (size_t)(t + 2) * kstep; const char* b2 = last ? nB : cB + (size_t)(t + 2) * kstep;
            const char* a3 = a2 + kstep; const char* b3 = b2 + kstep;
            PG_LDB(B0, 0, 0); PG_LDB(B1, 0, 1); PG_SCHED; PG_LDA(At, 0, 0); PG_STAGE_A(PG_SA(1, 1), a1, 1, false);
            PG_WAIT_V(8); PG_WAIT_L(0); PG_BAR; PG_MMA(0, 0, At, B0); PG_MMA(0, 1, At, B1); PG_BAR; PG_SCHED;
            PG_LDA(At, 0, 1); PG_STAGE_B(PG_SB(0, 0), b2); PG_STAGE_B(PG_SB(0, 1), b2 + hstepB); PG_STAGE_A(PG_SA(0, 0), a2, 0, last);
            PG_WAIT_V(8); PG_WAIT_L(0); PG_BAR; PG_MMA(1, 0, At, B0); PG_MMA(1, 1, At, B1); PG_BAR; PG_SCHED;
            PG_LDB(B0, 1, 0); PG_LDB(B1, 1, 1); PG_SCHED; PG_LDA(At, 1, 0); PG_STAGE_A(PG_SA(0, 1), a2, 1, last);
            PG_WAIT_V(8); PG_WAIT_L(0); PG_BAR; PG_MMA(0, 0, At, B0); PG_MMA(0, 1, At, B1); PG_BAR; PG_SCHED;
            PG_LDA(At, 1, 1); PG_STAGE_B(PG_SB(1, 0), b3); PG_STAGE_B(PG_SB(1, 1), b3 + hstepB); PG_STAGE_A(PG_SA(1, 0), a3, 0, last);
            PG_WAIT_V(8); PG_WAIT_L(0); PG_BAR; PG_MMA(1, 0, At, B0); PG_MMA(1, 1, At, B1); PG_BAR; PG_SCHED;
        }
        if (wr == 0) PG_BAR;
        if (psig >= 0) E.signal(psig, lane);
        E(acc, cur, wr, wc, fr, fq);
        psig = __builtin_amdgcn_readfirstlane(E.sig(cur));
        if (!has_next) break;
#pragma unroll
        for (int a = 0; a < 2; ++a)
#pragma unroll
            for (int b = 0; b < 2; ++b)
#pragma unroll
                for (int m = 0; m < 4; ++m)
#pragma unroll
                    for (int n = 0; n < 2; ++n) acc[a][b][m][n] = (f32x4){0.f, 0.f, 0.f, 0.f};
        cur = nxt; cA = nA; cB = nB; if constexpr (GATHER) { oc00 = on00; oc01 = on01; oc10 = on10; oc11 = on11; } ++ui;
        if (wr == 1) PG_BAR;
    }
    PG_WAIT_V(0);
    if (psig >= 0) E.signal(psig, lane);
    PG_BAR;
#undef PG_SA
#undef PG_SB
#undef PG_STAGE_A
#undef PG_GLDS
#undef PG_STAGE_B
#undef PG_LDA
#undef PG_LDB
#undef PG_MMA
#undef PG_WAIT_V
#undef PG_WAIT_L
#undef PG_BAR
#undef PG_SCHED
}
}

__device__ __forceinline__ void transpose_item(const float* W, int K, int N, bf16_t* WT, int row_off, LAS float* scr, int item, int lane) {
    typedef float f32x4v __attribute__((ext_vector_type(4)));
    const int nblk = N / 32, kb = item / nblk, nb = item % nblk, k0 = 64 * kb, n0 = 32 * nb;
    const int kk = lane >> 3, n4 = (lane & 7) * 4;
    f32x4v v[8];
#pragma unroll
    for (int i = 0; i < 8; ++i) v[i] = *(const f32x4v*)(W + (size_t)(k0 + 8 * i + kk) * N + n0 + n4);
#pragma unroll
    for (int i = 0; i < 8; ++i) *(LAS f32x4v*)(scr + (8 * i + kk) * 36 + n4) = v[i];
    asm volatile("s_waitcnt lgkmcnt(0)" ::: "memory");
    const int n = lane & 31;
#pragma unroll
    for (int j = 0; j < 4; ++j) { const int c = (lane >> 5) + 2 * j; const LAS float* s = scr + (8 * c) * 36 + n;
        uint4 o; o.x = pk2(s[0 * 36], s[1 * 36]); o.y = pk2(s[2 * 36], s[3 * 36]); o.z = pk2(s[4 * 36], s[5 * 36]); o.w = pk2(s[6 * 36], s[7 * 36]);
        *(uint4*)(WT + (size_t)(row_off + n0 + n) * K + k0 + 8 * c) = o; }
    asm volatile("s_waitcnt lgkmcnt(0)" ::: "memory");
}
__device__ __forceinline__ void st_prep_weights(int which, int layer, char* smem, int vb, int nb) {
    STAGE_PARAMS();
    if (vb < 0) return;
    const int lane = tid_ & 63, wave = tid_ >> 6;
    LAS float* scr = (LAS float*)(LAS char*)smem + wave * (64 * 36);
    const int gw = vb * 8 + wave, NGW = nb * 8;
    if (which == 0) {
        constexpr int I_IN = 16 * 61, I_OUT = 16 * 32;
        for (int it = gw; it < 2 * (I_IN + I_OUT); it += NGW) {
            const int l = it / (I_IN + I_OUT); int r = it % (I_IN + I_OUT);
            if (r < I_IN) transpose_item(p.w_in + (size_t)l * 1024 * PCOLS, 1024, PCOLS, WSP(bf16_t, O_WINT) + (size_t)l * 2048 * 1024, 0, scr, r, lane);
            else transpose_item(p.w_out + (size_t)l * 1024 * 1024, 1024, 1024, WSP(bf16_t, O_WOUTT) + (size_t)l * 1024 * 1024, 0, scr, r - I_IN, lane);
        }
        for (int it = gw; it < 2 * 640; it += NGW) {
            const int l = it / 640, r = it % 640;
            const float* W; int N, n, s_; bf16_t* dst;
            if (r < 384) { const int f = r, hd = f / 48, nb = (f / 16) % 3; s_ = f % 16; W = p.mla_w_uq + (size_t)l * 256 * 768; N = 768; n = 96 * hd + 32 * nb + (lane & 31); dst = WSP(bf16_t, O_WUQT) + (size_t)l * 768 * 256 + (size_t)f * 512; }
            else { const int f = (r - 384) & 127, hd = f / 16, nb = (f / 8) & 1; s_ = f % 8; const bool isv = r >= 512; W = (isv ? p.mla_w_uv : p.mla_w_uk) + (size_t)l * 128 * 512; N = 512; n = 64 * hd + 32 * nb + (lane & 31);
                dst = WSP(bf16_t, isv ? O_WUVT : O_WUKT) + (size_t)l * 512 * 128 + (size_t)f * 512; }
            const float* src = W + (size_t)(16 * s_ + 8 * (lane >> 5)) * N + n;
            float v[8];
#pragma unroll
            for (int j = 0; j < 8; ++j) v[j] = src[(size_t)j * N];
            *(uint4*)(dst + lane * 8) = make_uint4(pk2(v[0], v[1]), pk2(v[2], v[3]), pk2(v[4], v[5]), pk2(v[6], v[7]));
        }
        for (int i = gw * 64 + lane; i < 2 * 96 * 128; i += NGW * 64) { const int l = i / (96 * 128), r = i % (96 * 128);
            ((uint4*)(WSP(bf16_t, O_WINT) + ((size_t)l * 2048 + 1952) * 1024))[r] = make_uint4(0u, 0u, 0u, 0u); }
    } else {
        constexpr int I_G = 16 * 24, I_D = 12 * 32;
        for (int it = gw; it < 16 * (2 * I_G + I_D); it += NGW) {
            const int e = it / (2 * I_G + I_D); int r = it % (2 * I_G + I_D);
            const size_t le = (size_t)(layer * 16 + e);
            if (r < 2 * I_G) {
                const bool up = r >= I_G; if (up) r -= I_G;
                const int nb = r % 24;
                const int n0 = nb * 32, dst0 = (n0 >> 7) * 256 + (up ? 128 : 0) + (n0 & 127);
                transpose_item((up ? p.exp_w_up : p.exp_w_gate) + le * 1024 * FF, 1024, FF, WSP(bf16_t, O_WGUT) + (size_t)e * 1536 * 1024, dst0 - n0, scr, r, lane);
            } else transpose_item(p.exp_w_down + le * FF * 1024, FF, 1024, WSP(bf16_t, O_WDT) + (size_t)e * 1024 * FF, 0, scr, r - 2 * I_G, lane);
        }
    }
}

struct SchedWin {
    struct Unit { int pm, pn; };
    const char* A; const char* B; int G, c; bool canon;
    __device__ __forceinline__ bool next(int i, Unit& u) const { const int L = i * G + c;
        if (canon && L >= 1024) { if (L >= 1280 || (c & 31) >= 8) return false; u.pm = 128 + (c >> 5); u.pn = c & 7; return true; }
        if (L >= 136 * 8) return false; u.pm = L >> 3; u.pn = L & 7; return true; }
    __device__ __forceinline__ const char* a_base(const Unit& u) const { return A + (size_t)u.pm * 256 * 2048; }
    __device__ __forceinline__ unsigned a_off(const Unit&, int) const { return 0u; }
    __device__ __forceinline__ const char* b_base(const Unit& u) const { return B + (size_t)u.pn * 256 * 2048; }
};
struct EpiWin {
    bf16_t* P; unsigned* dep; bool plain;
    __device__ __forceinline__ void operator()(const pg::f32x4 (&acc)[2][2][4][2], const SchedWin::Unit& u, int wr, int wc, int fr, int fq) const {
        fr = opq(fr); fq = opq(fq);
#pragma unroll
        for (int ai = 0; ai < 2; ++ai)
#pragma unroll
            for (int m = 0; m < 4; ++m) { bf16_t* rowp = P + (size_t)(u.pm * 256 + ai * 128 + wr * 64 + m * 16 + fr) * PLD + u.pn * 256 + wc * 32 + 8 * fq;
#pragma unroll
                for (int bj = 0; bj < 2; ++bj) { const pg::f32x4 v0 = acc[ai][bj][m][0], v1 = acc[ai][bj][m][1];
                    pg::u32x4 w; w.x = pg::cvt_pk_bf16(v0[0], v0[1]); w.y = pg::cvt_pk_bf16(v0[2], v0[3]); w.z = pg::cvt_pk_bf16(v1[0], v1[1]); w.w = pg::cvt_pk_bf16(v1[2], v1[3]);
                    if (plain) *(pg::u32x4*)(rowp + bj * 128) = w;
                    else asm volatile("global_store_dwordx4 %0, %1, off sc1\n\ts_nop 1" :: "v"(rowp + bj * 128), "v"(w) : "memory"); } }
    }
    __device__ __forceinline__ int sig(const SchedWin::Unit& u) const { return u.pm * 8; }
    __device__ __forceinline__ void signal(int i, int lane) const { if (lane == 0) __hip_atomic_fetch_add(dep + i, 1u, __ATOMIC_RELAXED, __HIP_MEMORY_SCOPE_AGENT); }
};
__device__ __forceinline__ void st_gemm_win_fast(int layer, char* smem, bool canon) {
    STAGE_PARAMS();
    SchedWin S{(const char*)WSP(bf16_t, O_HX), (const char*)(WSP(bf16_t, O_WINT) + (size_t)layer * 2048 * 1024), G_, vcu_of(bid_, G_), canon};
    EpiWin E{WSP(bf16_t, O_P), WSP(unsigned, O_DEPW) + layer * 136 * 8, canon};
    pg::gemm_run<false>((LAS unsigned char*)(LAS char*)smem, 1024, S, E, tid_);
}
struct SchedWout {
    struct Unit { int pm, pn; };
    const char* A; const char* B; int G, c, nunits; bool canon;
    __device__ __forceinline__ bool next(int i, Unit& u) const { const int L = i * G + c;
        if (canon && L >= 512) { if (L >= 768 || nunits <= 512 || (c & 31) >= 4) return false; u.pm = 128 + (c >> 5); u.pn = c & 3; return true; }
        if (L >= nunits) return false; u.pm = L >> 2; u.pn = L & 3; return true; }
    __device__ __forceinline__ const char* a_base(const Unit& u) const { return A + (size_t)u.pm * 256 * 2048; }
    __device__ __forceinline__ unsigned a_off(const Unit&, int) const { return 0u; }
    __device__ __forceinline__ const char* b_base(const Unit& u) const { return B + (size_t)u.pn * 256 * 2048; }
};
struct EpiWout {
    const float* xin_lat; const float* xin_ctx; float* xo_lat; float* xo_ctx; const float* mod2; LAS float* stage; float* ssq; unsigned* dep; bool canon;
    __device__ __forceinline__ void operator()(const pg::f32x4 (&acc)[2][2][4][2], const SchedWout::Unit& u, int wr, int wc, int fr, int fq) const {
        fr = opq(fr); fq = opq(fq);
        const bool isctx = u.pm >= 128; const int bv = isctx ? 8 : (u.pm >> 4);
        const float* xin = isctx ? xin_ctx + (size_t)(u.pm - 128) * 256 * DM : xin_lat + (size_t)u.pm * 256 * DM;
        float* xo = isctx ? xo_ctx + (size_t)(u.pm - 128) * 256 * DM : xo_lat + (size_t)u.pm * 256 * DM;
        const float* g = mod2 + (size_t)bv * 6144 + u.pn * 256 + wc * 32 + 8 * fq;
        pg::f32x4 gv[2][2];
#pragma unroll
        for (int bj = 0; bj < 2; ++bj)
#pragma unroll
            for (int n = 0; n < 2; ++n) gv[bj][n] = *(const pg::f32x4*)(g + bj * 128 + 4 * n);
        LAS float* st = stage + (wr * 4 + wc) * 576;
        const int lane = fr + 16 * fq, sr = lane >> 3, sc = (lane & 7) * 4;
#pragma unroll
        for (int ai = 0; ai < 2; ++ai)
        {
            pg::f32x4 xs[4][2][2];
#pragma unroll
            for (int m = 0; m < 4; ++m)
#pragma unroll
                for (int bj = 0; bj < 2; ++bj) { const size_t off = (size_t)(ai * 128 + wr * 64 + m * 16) * DM + u.pn * 256 + wc * 32 + bj * 128;
                    xs[m][bj][0] = *(const pg::f32x4*)(xin + off + (size_t)sr * DM + sc); xs[m][bj][1] = *(const pg::f32x4*)(xin + off + (size_t)(sr + 8) * DM + sc); }
            __builtin_amdgcn_sched_barrier(0);
#pragma unroll
            for (int m = 0; m < 4; ++m) {
                float q0 = 0.f, q1 = 0.f;
#pragma unroll
                for (int bj = 0; bj < 2; ++bj) {
                    const size_t off = (size_t)(ai * 128 + wr * 64 + m * 16) * DM + u.pn * 256 + wc * 32 + bj * 128;
                    *(LAS pg::f32x4*)(st + fr * 36 + 8 * fq) = gv[bj][0] * acc[ai][bj][m][0];
                    *(LAS pg::f32x4*)(st + fr * 36 + 8 * fq + 4) = gv[bj][1] * acc[ai][bj][m][1];
                    const pg::f32x4 x0 = xs[m][bj][0], x1 = xs[m][bj][1];
                    asm volatile("s_waitcnt lgkmcnt(0)" ::: "memory");
                    const pg::f32x4 r0 = x0 + *(const LAS pg::f32x4*)(st + sr * 36 + sc), r1 = x1 + *(const LAS pg::f32x4*)(st + (sr + 8) * 36 + sc);
                    *(pg::f32x4*)(xo + off + (size_t)sr * DM + sc) = r0;
                    *(pg::f32x4*)(xo + off + (size_t)(sr + 8) * DM + sc) = r1;
                    q0 += r0[0] * r0[0] + r0[1] * r0[1] + r0[2] * r0[2] + r0[3] * r0[3]; q1 += r1[0] * r1[0] + r1[1] * r1[1] + r1[2] * r1[2] + r1[3] * r1[3];
                    asm volatile("s_waitcnt lgkmcnt(0)" ::: "memory");
                }
#define EW_RED(x_) q0 += __int_as_float(__builtin_amdgcn_ds_swizzle(__float_as_int(q0), ((x_) << 10) | 0x1f)); q1 += __int_as_float(__builtin_amdgcn_ds_swizzle(__float_as_int(q1), ((x_) << 10) | 0x1f));
                EW_RED(1) EW_RED(2) EW_RED(4)
#undef EW_RED
                if ((lane & 7) == 0) { float* d = ssq + (size_t)(u.pn * 4 + wc) * NROWS + u.pm * 256 + ai * 128 + wr * 64 + m * 16 + sr; d[0] = q0; d[8] = q1; }
            }
        }
    }
    __device__ __forceinline__ int sig(const SchedWout::Unit& u) const { return canon ? u.pm * 8 : -1; }
    __device__ __forceinline__ void signal(int i, int lane) const { if (lane == 0) __hip_atomic_fetch_add(dep + i, 1u, __ATOMIC_RELAXED, __HIP_MEMORY_SCOPE_AGENT); }
};
__device__ __forceinline__ void st_gemm_wout_fast(int layer, char* smem, bool canon) {
    STAGE_PARAMS();
    SchedWout S{(const char*)WSP(bf16_t, O_HX), (const char*)(WSP(bf16_t, O_WOUTT) + (size_t)layer * 1024 * 1024), G_, vcu_of(bid_, G_), (layer == 0 ? 136 : 128) * 4, canon};
    EpiWout E{layer == 0 ? p.x : p.out, layer == 0 ? p.ctx : WSP(float, O_XC), p.out, WSP(float, O_XC), WSP(float, O_MOD) + (size_t)layer * 9 * 6144 + 2 * 1024, (LAS float*)((LAS char*)smem + 131072), WSP(float, O_SSQ), WSP(unsigned, O_DEPX) + layer * 136 * 8, canon};
    pg::gemm_run<false>((LAS unsigned char*)(LAS char*)smem, 1024, S, E, tid_);
}
struct SchedMoeUp {
    struct Unit { int be, pm, pn, isctx; };
    const char* H2; const char* B; const int* idx; const int* idxc; int G, c, first, nunits;
    __device__ __forceinline__ bool next(int i, Unit& u) const { const int L = first + i * G + c; if (L >= nunits) return false;
        const bool ic = L >= 1536; const int q = ic ? L - 1536 : L; const int r = ic ? q % 6 : q % 12;
        const int i12 = q / 12;
        u.be = ic ? q / 6 : (i12 & 7) * 16 + (i12 >> 3); u.pm = ic ? 0 : r / 6; u.pn = r % 6; u.isctx = ic ? 1 : 0; return true; }
    __device__ __forceinline__ const char* a_base(const Unit&) const { return H2; }
    __device__ __forceinline__ unsigned a_off(const Unit& u, int r) const { const int* ri = u.isctx ? idxc + u.be * 256 : idx + u.be * CAP + u.pm * 256; return (unsigned)ri[r] * 2048u; }
    __device__ __forceinline__ const char* b_base(const Unit& u) const { return B + ((size_t)(u.isctx ? u.be : (u.be & 15)) * 1536 + (size_t)u.pn * 256) * 2048; }
};
struct EpiMoeUp {
    bf16_t* hid; bf16_t* hidc; unsigned* dep;
    __device__ __forceinline__ void operator()(const pg::f32x4 (&acc)[2][2][4][2], const SchedMoeUp::Unit& u, int wr, int wc, int fr, int fq) const {
        fr = opq(fr); fq = opq(fq);
        bf16_t* base = u.isctx ? hidc + (size_t)u.be * 256 * FF : hid + ((size_t)u.be * CAP + u.pm * 256) * FF;
#pragma unroll
        for (int ai = 0; ai < 2; ++ai)
#pragma unroll
            for (int m = 0; m < 4; ++m) { bf16_t* rowp = base + (size_t)(ai * 128 + wr * 64 + m * 16 + fr) * FF + u.pn * 128 + wc * 32 + 8 * fq;
                float h[8];
#pragma unroll
                for (int n = 0; n < 2; ++n)
#pragma unroll
                    for (int j = 0; j < 4; ++j) { const float gt = acc[ai][0][m][n][j], up = acc[ai][1][m][n][j]; h[n * 4 + j] = gt * __builtin_amdgcn_rcpf(1.f + __builtin_amdgcn_exp2f(-gt * LOG2E)) * up; }
                pg::u32x4 w; w.x = pg::cvt_pk_bf16(h[0], h[1]); w.y = pg::cvt_pk_bf16(h[2], h[3]); w.z = pg::cvt_pk_bf16(h[4], h[5]); w.w = pg::cvt_pk_bf16(h[6], h[7]);
                if (u.isctx) asm volatile("global_store_dwordx4 %0, %1, off sc1\n\ts_nop 1" :: "v"(rowp), "v"(w) : "memory"); else *(pg::u32x4*)rowp = w; }
    }
    __device__ __forceinline__ int sig(const SchedMoeUp::Unit& u) const { return u.isctx ? u.be * 4 : -1; }
    __device__ __forceinline__ void signal(int i, int lane) const { if (lane == 0) __hip_atomic_fetch_add(dep + i, 1u, __ATOMIC_RELAXED, __HIP_MEMORY_SCOPE_AGENT); }
};
__device__ __forceinline__ void st_moe_up_fast(int part, char* smem) {
    STAGE_PARAMS();
    SchedMoeUp S{(const char*)WSP(bf16_t, O_HX), (const char*)WSP(bf16_t, O_WGUT), WSP(const int, O_IDX), WSP(const int, O_IDXC), G_, vcu_of(bid_, G_), part ? 1536 : 0, part ? 1632 : 1536};
    EpiMoeUp E{WSP(bf16_t, O_HID), WSP(bf16_t, O_HIDC), WSP(unsigned, O_DEPH)};
    pg::gemm_run<true>((LAS unsigned char*)(LAS char*)smem, 1024, S, E, tid_);
}
struct SchedMoeDown {
    struct Unit { int be, pm, pn, isctx; };
    const char* hid; const char* hidc; const char* B; const unsigned* dep; int G, c, nunits;
    __device__ __forceinline__ bool next(int i, Unit& u) const { const int cs = (G == 256) ? 96 : 0; int L = i * G + c;
        if (L >= 1024) { const int j = L - 1024 - cs; L = (j >= 0) ? 1024 + j : nunits; }
        if (L >= nunits) return false;
        const bool ic = L >= 1024; const int q = ic ? L - 1024 : L;
        if (ic) { const unsigned* dw = dep + (q >> 2) * 4;
            if ((opaque_tid() & 63) == 0) for (unsigned spins = 0; __hip_atomic_load(dw, __ATOMIC_RELAXED, __HIP_MEMORY_SCOPE_AGENT) < 48u && spins < (1u << 24); ++spins) __builtin_amdgcn_s_sleep(2);
            __builtin_amdgcn_fence(__ATOMIC_ACQUIRE, "agent"); asm volatile("s_waitcnt vmcnt(0)" ::: "memory"); }
        const int i8 = q >> 3;
        u.be = ic ? (q >> 2) : (i8 & 7) * 16 + (i8 >> 3); u.pm = ic ? 0 : ((q & 7) >> 2); u.pn = q & 3; u.isctx = ic ? 1 : 0; return true; }
    __device__ __forceinline__ const char* a_base(const Unit& u) const { return u.isctx ? hidc + (size_t)u.be * 256 * FF * 2 : hid + ((size_t)u.be * CAP + u.pm * 256) * FF * 2; }
    __device__ __forceinline__ unsigned a_off(const Unit&, int r) const { return (unsigned)r * (FF * 2); }
    __device__ __forceinline__ const char* b_base(const Unit& u) const { return B + ((size_t)(u.isctx ? u.be : (u.be & 15)) * 1024 + (size_t)u.pn * 256) * (FF * 2); }
};
struct EpiMoeDown {
    bf16_t* ys; bf16_t* ysc; const float* gate; const float* gatec;
    __device__ __forceinline__ void operator()(const pg::f32x4 (&acc)[2][2][4][2], const SchedMoeDown::Unit& u, int wr, int wc, int fr, int fq) const {
        fr = opq(fr); fq = opq(fq);
        bf16_t* base = u.isctx ? ysc + (size_t)u.be * 256 * DM : ys + ((size_t)u.be * CAP + u.pm * 256) * DM;
        float gvs[2][4];
        { const float* gp = (u.isctx ? gatec + u.be * 256 : gate + u.be * CAP + u.pm * 256) + wr * 64 + fr;
#pragma unroll
          for (int ai = 0; ai < 2; ++ai)
#pragma unroll
              for (int m = 0; m < 4; ++m) gvs[ai][m] = gp[ai * 128 + m * 16]; }
        __builtin_amdgcn_sched_barrier(0);
#pragma unroll
        for (int ai = 0; ai < 2; ++ai)
#pragma unroll
            for (int m = 0; m < 4; ++m) { const int r = ai * 128 + wr * 64 + m * 16 + fr;
                const float gv = gvs[ai][m];
                bf16_t* rowp = base + (size_t)r * DM + u.pn * 256 + wc * 32 + 8 * fq;
#pragma unroll
                for (int bj = 0; bj < 2; ++bj) { const pg::f32x4 v0 = acc[ai][bj][m][0] * gv, v1 = acc[ai][bj][m][1] * gv;
                    pg::u32x4 w; w.x = pg::cvt_pk_bf16(v0[0], v0[1]); w.y = pg::cvt_pk_bf16(v0[2], v0[3]); w.z = pg::cvt_pk_bf16(v1[0], v1[1]); w.w = pg::cvt_pk_bf16(v1[2], v1[3]);
                    *(pg::u32x4*)(rowp + bj * 128) = w; } }
    }
    __device__ __forceinline__ int sig(const SchedMoeDown::Unit&) const { return -1; }
    __device__ __forceinline__ void signal(int, int) const {}
};
__device__ __forceinline__ void st_moe_down_fast(int layer, char* smem) {
    STAGE_PARAMS();
    SchedMoeDown S{(const char*)WSP(bf16_t, O_HID), (const char*)WSP(bf16_t, O_HIDC), (const char*)WSP(bf16_t, O_WDT), WSP(const unsigned, O_DEPH), G_, vcu_of(bid_, G_), 1024 + (layer == 0 ? 64 : 0)};
    EpiMoeDown E{WSP(bf16_t, O_YS), WSP(bf16_t, O_YSC), WSP(const float, O_GATE), WSP(const float, O_GATEC)};
    pg::gemm_run<false>((LAS unsigned char*)(LAS char*)smem, FF, S, E, tid_);
}

namespace fa {
typedef short bf16x8 __attribute__((ext_vector_type(8)));
typedef short bf16x4 __attribute__((ext_vector_type(4)));
typedef float f32x16 __attribute__((ext_vector_type(16)));
typedef unsigned u32x4 __attribute__((ext_vector_type(4)));
typedef unsigned u32x2 __attribute__((ext_vector_type(2)));
constexpr int VSTRIDE = 136;
__device__ __forceinline__ unsigned cvt_pk(float lo, float hi) { unsigned r; asm volatile("v_cvt_pk_bf16_f32 %0, %1, %2" : "=v"(r) : "v"(lo), "v"(hi)); return r; }
__device__ __forceinline__ float xhalf_max(float v) { const auto rr = __builtin_amdgcn_permlane32_swap(__float_as_uint(v), __float_as_uint(v), false, false); return fmaxf(__uint_as_float(rr[0]), __uint_as_float(rr[1])); }
__device__ __forceinline__ float xhalf_sum(float v) { const auto rr = __builtin_amdgcn_permlane32_swap(__float_as_uint(v), __float_as_uint(v), false, false); return __uint_as_float(rr[0]) + __uint_as_float(rr[1]); }
typedef short s16x4 __attribute__((ext_vector_type(4)));
__device__ __forceinline__ int vtr_st(int k, int c) { return ((k >> 3) * 2 + (c >> 5)) * 512 + ((k & 7) * 32 + (c & 31)) * 2; }
__device__ __forceinline__ int vtr_base(int lane) { return ((lane & 3) << 3) | (((lane >> 2) & 3) << 6) | (((lane >> 4) & 1) << 5) | (((lane >> 5) & 1) << 8); }
constexpr int vtr_off(int d0, int ks, int half) { return d0 * 512 + ks * 2048 + half * 1024; }
template <int OFF> __device__ __forceinline__ u32x2 vtr_read(int vb) { s16x4 r; asm volatile("ds_read_b64_tr_b16 %0, %1 offset:%2" : "=&v"(r) : "v"(vb), "i"(OFF) : "memory"); return __builtin_bit_cast(u32x2, r); }
#define VTR_READ_ALL(va_, vb_) do { \
    va_[0][0] = vtr_read<vtr_off(0, 0, 0)>(vb_); va_[0][1] = vtr_read<vtr_off(0, 0, 1)>(vb_); va_[0][2] = vtr_read<vtr_off(1, 0, 0)>(vb_); va_[0][3] = vtr_read<vtr_off(1, 0, 1)>(vb_); \
    va_[1][0] = vtr_read<vtr_off(0, 1, 0)>(vb_); va_[1][1] = vtr_read<vtr_off(0, 1, 1)>(vb_); va_[1][2] = vtr_read<vtr_off(1, 1, 0)>(vb_); va_[1][3] = vtr_read<vtr_off(1, 1, 1)>(vb_); \
    va_[2][0] = vtr_read<vtr_off(0, 2, 0)>(vb_); va_[2][1] = vtr_read<vtr_off(0, 2, 1)>(vb_); va_[2][2] = vtr_read<vtr_off(1, 2, 0)>(vb_); va_[2][3] = vtr_read<vtr_off(1, 2, 1)>(vb_); \
    va_[3][0] = vtr_read<vtr_off(0, 3, 0)>(vb_); va_[3][1] = vtr_read<vtr_off(0, 3, 1)>(vb_); va_[3][2] = vtr_read<vtr_off(1, 3, 0)>(vb_); va_[3][3] = vtr_read<vtr_off(1, 3, 1)>(vb_); } while (0)

__device__ __forceinline__ float max3f(float a, float b, float c) { float r; asm("v_max3_f32 %0, %1, %2, %3" : "=v"(r) : "v"(a), "v"(b), "v"(c)); return r; }
template <int DQK, bool WIN, bool QS = false, bool VTR = false>
__device__ __forceinline__ void attn_unit(LAS unsigned char* lds, const int tid, const bf16_t* Qp, const int qstride, const bf16_t* Kp, const bf16_t* Vt, const int vt_stride,
                                          const int ntiles, const int nfirst, const int second0, const int qtok0, const float sink_l2, bf16_t* Yp, const int ystride, const float sink_l2b = 0.f, const bf16_t* Vc = nullptr) {
    constexpr int KSTRIDE = DQK * 2 + 16, KCH = DQK / 8, KBUF = 64 * KSTRIDE, VBUF = 64 * VSTRIDE, NKS = DQK / 16;
    constexpr float THR = 8.f;
    const int lane = tid & 63, wave = __builtin_amdgcn_readfirstlane(tid >> 6), q32 = lane & 31, hh = lane >> 5;
    const int wrow = QS ? (wave & 3) * 32 : wave * 32, hoff = QS ? (wave >> 2) * 64 : 0;
    const int kr0 = tid / KCH, kc0 = tid % KCH, kr1 = (tid + 512) / KCH, kc1 = (tid + 512) % KCH; const bool k2 = (tid + 512) < 64 * KCH;
    const int vd = tid >> 3, vc = tid & 7;
    const unsigned kl0 = kr0 * KSTRIDE + kc0 * 16, kl1 = kr1 * KSTRIDE + kc1 * 16, vl = VTR ? vtr_st(vd, vc * 8) : vd * VSTRIDE + vc * 16;
#define FA_KEY0(i) ((i) < nfirst ? 64 * (i) : second0 + 64 * ((i) - nfirst))
    bf16x8 qf[NKS];
    { const bf16_t* qr = Qp + (size_t)(wrow + q32) * qstride + hoff + 8 * hh;
#pragma unroll
      for (int s = 0; s < NKS; ++s) qf[s] = *(const bf16x8*)(qr + 16 * s); }
    f32x16 o0, o1, o2, negm;
#pragma unroll
    for (int r = 0; r < 16; ++r) { o0[r] = 0.f; o1[r] = 0.f; o2[r] = 0.f; negm[r] = 0.f; }
    float mref = 0.f;
    const bf16x8 ones = (bf16x8){16256, 16256, 16256, 16256, 16256, 16256, 16256, 16256};
    u32x4 ak0, ak1 = (u32x4){0u, 0u, 0u, 0u}, av;
#define FA_LOAD(k0_, k1_, v_, ti_) do { const int key0_ = FA_KEY0(ti_); \
        k0_ = *(const u32x4*)(Kp + (size_t)(key0_ + kr0) * DQK + kc0 * 8); if (k2) k1_ = *(const u32x4*)(Kp + (size_t)(key0_ + kr1) * DQK + kc1 * 8); \
        if (VTR) v_ = *(const u32x4*)((key0_ < 256 ? Vc : Vt) + (size_t)(key0_ + vd) * vt_stride + vc * 8); else v_ = *(const u32x4*)(Vt + (size_t)vd * vt_stride + key0_ + vc * 8); } while (0)
#define FA_STORE(k0_, k1_, v_, b_) do { *(LAS u32x4*)(lds + (b_) * KBUF + kl0) = k0_; if (k2) *(LAS u32x4*)(lds + (b_) * KBUF + kl1) = k1_; \
        if (VTR) *(LAS u32x4*)(lds + 2 * KBUF + (b_) * VBUF + vl) = v_; else { *(LAS u32x2*)(lds + 2 * KBUF + (b_) * VBUF + vl) = (u32x2){v_.x, v_.y}; *(LAS u32x2*)(lds + 2 * KBUF + (b_) * VBUF + vl + 8) = (u32x2){v_.z, v_.w}; } } while (0)
#define FA_BAR() do { asm volatile("s_waitcnt lgkmcnt(0)" ::: "memory"); __syncthreads(); } while (0)
    FA_LOAD(ak0, ak1, av, 0);
    FA_BAR();
    FA_STORE(ak0, ak1, av, 0);
    for (int t = 0; t < ntiles; ++t) {
        const int buf = t & 1;
        FA_BAR();
        const bool more = (t + 1) < ntiles;
        if (more) FA_LOAD(ak0, ak1, av, t + 1);
        {
        const int key0 = FA_KEY0(t);
        bool active = true;
        if (WIN) { if ((t) >= nfirst) { const int kt0 = key0 - 256, qw0 = qtok0 + wrow; active = (kt0 <= qw0 + 31 + 128) && (kt0 + 63 >= qw0 - 128); } }
        if (active) {
            const LAS unsigned char* kb = lds + buf * KBUF + q32 * KSTRIDE + 16 * hh;
            const LAS unsigned char* vb = lds + 2 * KBUF + buf * VBUF + q32 * VSTRIDE + 8 * hh;
            bf16x8 kf0[NKS / 2], kf1[NKS / 2];
#pragma unroll
            for (int s = 0; s < NKS / 2; ++s) { kf0[s] = *(const LAS bf16x8*)(kb + 32 * s); kf1[s] = *(const LAS bf16x8*)(kb + 32 * KSTRIDE + 32 * s); }
            __builtin_amdgcn_sched_barrier(0);
            f32x16 p0 = __builtin_amdgcn_mfma_f32_32x32x16_bf16(kf0[0], qf[0], negm, 0, 0, 0), p1 = __builtin_amdgcn_mfma_f32_32x32x16_bf16(kf1[0], qf[0], negm, 0, 0, 0);
#pragma unroll
            for (int s = 1; s < NKS / 2; ++s) {
                p0 = __builtin_amdgcn_mfma_f32_32x32x16_bf16(kf0[s], qf[s], p0, 0, 0, 0);
                p1 = __builtin_amdgcn_mfma_f32_32x32x16_bf16(kf1[s], qf[s], p1, 0, 0, 0);
            }
            __builtin_amdgcn_sched_barrier(0);
#pragma unroll
            for (int s = 0; s < NKS / 2; ++s) { kf0[s] = *(const LAS bf16x8*)(kb + 32 * (s + NKS / 2)); kf1[s] = *(const LAS bf16x8*)(kb + 32 * KSTRIDE + 32 * (s + NKS / 2)); }
            __builtin_amdgcn_sched_barrier(0);
#pragma unroll
            for (int s = 0; s < NKS / 2; ++s) {
                p0 = __builtin_amdgcn_mfma_f32_32x32x16_bf16(kf0[s], qf[s + NKS / 2], p0, 0, 0, 0);
                p1 = __builtin_amdgcn_mfma_f32_32x32x16_bf16(kf1[s], qf[s + NKS / 2], p1, 0, 0, 0);
            }
            u32x2 va[4][4];
            if (VTR) { const int vtb = (int)(unsigned)(size_t)(lds + 2 * KBUF + buf * VBUF) + vtr_base(lane); VTR_READ_ALL(va, vtb); }
            else {
#pragma unroll
            for (int s = 0; s < 4; ++s) { va[s][0] = *(const LAS u32x2*)(vb + 32 * s); va[s][1] = *(const LAS u32x2*)(vb + 32 * s + 16);
                va[s][2] = *(const LAS u32x2*)(vb + 32 * VSTRIDE + 32 * s); va[s][3] = *(const LAS u32x2*)(vb + 32 * VSTRIDE + 32 * s + 16); } }
            __builtin_amdgcn_sched_barrier(0);
            asm volatile("s_nop 15\n\ts_nop 7" : "+v"(p0), "+v"(p1));
            if (WIN) { if ((t) >= nfirst) { const int qi = qtok0 + wrow + q32, kb0 = key0 - 256 + 4 * hh;
#pragma unroll
                for (int r = 0; r < 16; ++r) { const int kj = kb0 + (r & 3) + 8 * (r >> 2); const int d0 = kj - qi, d1 = d0 + 32;
                    if (d0 > 128 || d0 < -128) p0[r] = -1e30f; if (d1 > 128 || d1 < -128) p1[r] = -1e30f; } } }
            float mxa = max3f(p0[0], p0[1], p1[0]), mxb = max3f(p0[2], p0[3], p1[1]); mxa = max3f(mxa, p1[2], p1[3]);
#pragma unroll
            for (int r = 4; r < 16; r += 4) { mxa = max3f(mxa, p0[r], p0[r + 1]); mxb = max3f(mxb, p0[r + 2], p0[r + 3]); mxa = max3f(mxa, p1[r], p1[r + 1]); mxb = max3f(mxb, p1[r + 2], p1[r + 3]); }
            const float mx = xhalf_max(max3f(mxa, mxb, mxb));
            if ((t == 0) || __any(mx > THR)) {
                const float dl = ((t == 0)) ? mx : fmaxf(mx, 0.f), f = __builtin_amdgcn_exp2f(-dl);
                mref += dl; o2[0] *= f;
#pragma unroll
                for (int r = 0; r < 16; ++r) { o0[r] *= f; o1[r] *= f; p0[r] -= dl; p1[r] -= dl; negm[r] = -mref; }
            }
#pragma unroll
            for (int r = 0; r < 16; ++r) { p0[r] = __builtin_amdgcn_exp2f(p0[r]); p1[r] = __builtin_amdgcn_exp2f(p1[r]); }
            {
                float q0 = p0[0] + p1[0], q1 = p0[1] + p1[1], q2 = p0[2] + p1[2], q3 = p0[3] + p1[3];
#pragma unroll
                for (int r = 4; r < 16; r += 4) { q0 += p0[r] + p1[r]; q1 += p0[r + 1] + p1[r + 1]; q2 += p0[r + 2] + p1[r + 2]; q3 += p0[r + 3] + p1[r + 3]; }
                o2[0] += (q0 + q1) + (q2 + q3);
            }
            bf16x8 pf[4];
#pragma unroll
            for (int s = 0; s < 4; ++s) { unsigned w[4];
#pragma unroll
                for (int j = 0; j < 4; ++j) { const int r = 8 * (s & 1) + 2 * j; w[j] = (s < 2) ? cvt_pk(p0[r], p0[r + 1]) : cvt_pk(p1[r], p1[r + 1]); }
                const u32x4 u = (u32x4){w[0], w[1], w[2], w[3]}; pf[s] = __builtin_bit_cast(bf16x8, u); }
            if (VTR) { asm volatile("s_waitcnt lgkmcnt(0)" ::: "memory"); __builtin_amdgcn_sched_barrier(0); }
#pragma unroll
            for (int s = 0; s < 4; ++s) {
                const u32x4 u0 = (u32x4){va[s][0].x, va[s][0].y, va[s][1].x, va[s][1].y}, u1 = (u32x4){va[s][2].x, va[s][2].y, va[s][3].x, va[s][3].y};
                o0 = __builtin_amdgcn_mfma_f32_32x32x16_bf16(__builtin_bit_cast(bf16x8, u0), pf[s], o0, 0, 0, 0);
                o1 = __builtin_amdgcn_mfma_f32_32x32x16_bf16(__builtin_bit_cast(bf16x8, u1), pf[s], o1, 0, 0, 0);
            }
        }
        }
        if (more) FA_STORE(ak0, ak1, av, buf ^ 1);
    }
#undef FA_LOAD
#undef FA_STORE
#undef FA_BAR
#undef FA_KEY0
    float lt = xhalf_sum(o2[0]);
    if (WIN) lt += __builtin_amdgcn_exp2f(((QS && wave >= 4) ? sink_l2b : sink_l2) - mref);
    const float inv = 1.f / lt;
    bf16_t* yr = Yp + (size_t)(wrow + q32) * ystride + hoff + 4 * hh;
#pragma unroll
    for (int g = 0; g < 4; ++g) {
        *(uint2*)(yr + 8 * g) = make_uint2(cvt_pk(o0[4 * g] * inv, o0[4 * g + 1] * inv), cvt_pk(o0[4 * g + 2] * inv, o0[4 * g + 3] * inv));
        *(uint2*)(yr + 32 + 8 * g) = make_uint2(cvt_pk(o1[4 * g] * inv, o1[4 * g + 1] * inv), cvt_pk(o1[4 * g + 2] * inv, o1[4 * g + 3] * inv));
    }
}
}

__device__ __forceinline__ void st_mla_fast(int layer, char* smem) {
    STAGE_PARAMS();
    LAS unsigned char* lds = (LAS unsigned char*)(LAS char*)smem;
    const int c = vcu_of(bid_, G_);
    const int nunits = 1024 + (layer == 0 ? 64 : 0);
    const bf16_t* QM = WSP(const bf16_t, O_QM); const bf16_t* KM = WSP(const bf16_t, O_KM); const bf16_t* VT = WSP(const bf16_t, O_VT); bf16_t* Y = WSP(bf16_t, O_HX);
    if (tid_ >= 256) __builtin_amdgcn_s_setprio(1);
    for (int L = c; L < nunits; L += G_) {
        int bh, row0, ntiles;
        if (L < 1024) { bh = L >> 4; row0 = (bh >> 3) * SEQ + (L & 15) * 256; ntiles = NKEYS / 64; }
        else { bh = L - 1024; row0 = NLAT + (bh >> 3) * CTXL; ntiles = CTXL / 64; }
        const int h = bh & 7;
        fa::attn_unit<96, false>(lds, tid_, QM + ((size_t)row0 * 8 + h) * 96, 768, KM + (size_t)bh * NKEYS * 96, VT + (size_t)bh * 64 * NKEYS, NKEYS,
                                 ntiles, ntiles, 0, 0, 0.f, Y + (size_t)row0 * DM + 256 + h * 64, DM);
    }
    __builtin_amdgcn_s_setprio(0);
}

template <int NC>
__device__ __forceinline__ void tile_transpose(const bf16_t* P, int row0, int c0, bf16_t* dst, int NH, int b, int key0, LAS unsigned short* scr, int tid) {
    constexpr int LDW = NC + 2;
    for (int id = tid; id < 64 * (NC / 8); id += 512) { const int r = id / (NC / 8), ch = id % (NC / 8);
        const uint4 u = *(const uint4*)(P + (size_t)(row0 + r) * PLD + c0 + ch * 8);
        LAS unsigned* d = (LAS unsigned*)(scr + r * LDW + ch * 8); d[0] = u.x; d[1] = u.y; d[2] = u.z; d[3] = u.w; }
    __syncthreads();
    for (int id = tid; id < NC * 8; id += 512) { const int col = id >> 3, c8 = id & 7;
        unsigned w[4];
#pragma unroll
        for (int j = 0; j < 4; ++j) w[j] = (unsigned)scr[(c8 * 8 + 2 * j) * LDW + col] | ((unsigned)scr[(c8 * 8 + 2 * j + 1) * LDW + col] << 16);
        *(uint4*)(dst + ((size_t)(b * NH + (col >> 6)) * 64 + (col & 63)) * NKEYS + key0 + c8 * 8) = make_uint4(w[0], w[1], w[2], w[3]); }
    __syncthreads();
}
__device__ __forceinline__ int chunk_row0(int b, int ck) { return ck < 2 ? NLAT + b * CTXL + ck * 128 : b * SEQ + (ck - 2) * 128; }
template <class PT>
__device__ __forceinline__ void ret_kv_item(const PT& p, int layer, int item, char* smem, int tid) {
    using namespace fa;
    LAS unsigned char* lds = (LAS unsigned char*)(LAS char*)smem;
    constexpr int IMG = 16384, OFF_KF = IMG, OFF_KB = 2 * IMG;
    const bf16_t* P = WSP(const bf16_t, O_P);
    const int ck = item % 34, bh = item / 34, h = bh & 3, b = bh >> 2;
    const int row0 = chunk_row0(b, ck);
    const float lgf = WSP(const float, O_RETLG)[layer * 8 + h], lgb = WSP(const float, O_RETLG)[layer * 8 + 4 + h];
    {
        u32x4 uk[2], uv[2];
#pragma unroll
        for (int i = 0; i < 2; ++i) { const int id = tid + 512 * i, r = id >> 3, ch = id & 7;
            uk[i] = *(const u32x4*)(P + (size_t)(row0 + r) * PLD + C_RK + h * 64 + ch * 8); uv[i] = *(const u32x4*)(P + (size_t)(row0 + r) * PLD + C_RV + h * 64 + ch * 8); }
#pragma unroll
        for (int i = 0; i < 2; ++i) { const int id = tid + 512 * i, r = id >> 3, ch = id & 7;
            const float wf = __builtin_amdgcn_exp2f(lgf * (float)(127 - r)), wb = __builtin_amdgcn_exp2f(lgb * (float)r);
            const unsigned kw[4] = {uk[i].x, uk[i].y, uk[i].z, uk[i].w};
            u32x4 kf, kbw;
#pragma unroll
            for (int j = 0; j < 4; ++j) { const float k0 = bflo(kw[j]), k1 = bfhi(kw[j]); kf[j] = cvt_pk(k0 * wf, k1 * wf); kbw[j] = cvt_pk(k0 * wb, k1 * wb); }
            const unsigned la = (r >> 6) * 8192 + vtr_st(r & 63, ch * 8);
            *(LAS u32x4*)(lds + la) = uv[i]; *(LAS u32x4*)(lds + OFF_KF + la) = kf; *(LAS u32x4*)(lds + OFF_KB + la) = kbw;
        }
    }
    asm volatile("s_waitcnt lgkmcnt(0)" ::: "memory"); __syncthreads();
    {
        const int lane = tid & 63, wave = __builtin_amdgcn_readfirstlane(tid >> 6), l31 = lane & 31, hh = lane >> 5;
        const int dir = wave >> 2, dvb = (wave >> 1) & 1, dkb = wave & 1;
        const int vab = (int)(unsigned)(size_t)lds + vtr_base(lane) + dvb * 512;
        const int kbb = (int)(unsigned)(size_t)lds + (dir ? OFF_KB : OFF_KF) + vtr_base(lane) + dkb * 512;
        u32x2 fa_[8][2], fb_[8][2];
#define RK_RD(s_) fa_[s_][0] = vtr_read<vtr_off(0, (s_) & 3, 0) + ((s_) >> 2) * 8192>(vab); fa_[s_][1] = vtr_read<vtr_off(0, (s_) & 3, 1) + ((s_) >> 2) * 8192>(vab); \
                  fb_[s_][0] = vtr_read<vtr_off(0, (s_) & 3, 0) + ((s_) >> 2) * 8192>(kbb); fb_[s_][1] = vtr_read<vtr_off(0, (s_) & 3, 1) + ((s_) >> 2) * 8192>(kbb);
        RK_RD(0) RK_RD(1) RK_RD(2) RK_RD(3) RK_RD(4) RK_RD(5) RK_RD(6) RK_RD(7)
#undef RK_RD
        asm volatile("s_waitcnt lgkmcnt(0)" ::: "memory"); __builtin_amdgcn_sched_barrier(0);
        f32x16 acc;
#pragma unroll
        for (int r = 0; r < 16; ++r) acc[r] = 0.f;
#pragma unroll
        for (int s = 0; s < 8; ++s) { const u32x4 ua = (u32x4){fa_[s][0].x, fa_[s][0].y, fa_[s][1].x, fa_[s][1].y}, ub = (u32x4){fb_[s][0].x, fb_[s][0].y, fb_[s][1].x, fb_[s][1].y};
            acc = __builtin_amdgcn_mfma_f32_32x32x16_bf16(__builtin_bit_cast(bf16x8, ua), __builtin_bit_cast(bf16x8, ub), acc, 0, 0, 0); }
        float* o = WSP(float, dir ? O_KVB : O_KVF) + ((size_t)bh * 34 + ck) * 4096 + (size_t)(32 * dvb + 4 * hh) * 64 + 32 * dkb + l31;
#pragma unroll
        for (int r = 0; r < 16; ++r) o[((r & 3) + 8 * (r >> 2)) * 64] = acc[r];
    }
    asm volatile("s_waitcnt lgkmcnt(0)" ::: "memory"); __syncthreads();
}
__device__ __forceinline__ void st_ret_scan(int layer) {
    STAGE_PARAMS();
    for (int g = bid_ * 512 + tid_; g < 32 * 2 * 4096; g += G_ * 512) {
        const int e = g & 4095, dir = (g >> 12) & 1, bh = g >> 13, h = bh & 3;
        const float lg = WSP(const float, O_RETLG)[layer * 8 + dir * 4 + h];
        const float gch = exp2f(lg * 128.f);
        const float* kv = WSP(const float, dir ? O_KVB : O_KVF) + (size_t)bh * 34 * 4096 + e;
        bf16_t* sp = WSP(bf16_t, dir ? O_SPB : O_SPF) + (size_t)bh * 34 * 4096 + e;
        float s = 0.f;
#pragma unroll 1
        for (int c0 = 0; c0 < 34; c0 += 17) {
            float kvv[17];
#pragma unroll
            for (int i = 0; i < 17; ++i) { const int ii = c0 + i, ck = dir ? (ii < 2 ? 1 - ii : 35 - ii) : ii; kvv[i] = kv[(size_t)ck * 4096]; }
#pragma unroll
            for (int i = 0; i < 17; ++i) { const int ii = c0 + i, ck = dir ? (ii < 2 ? 1 - ii : 35 - ii) : ii; sp[(size_t)ck * 4096] = (bf16_t)f2bf(s); s = gch * s + kvv[i]; }
        }
    }
}

__device__ __forceinline__ void st_phase_c(int layer, char* smem, bool canon) {
    STAGE_PARAMS();
    using namespace fa;
    LAS unsigned char* lds = (LAS unsigned char*)(LAS char*)smem;
    constexpr int A1S = 528, A2S = 272, OFF_A2 = 64 * A1S, OFF_TM = OFF_A2 + 64 * A2S, OFF_TW = OFF_TM + 64 * 8 * 8, OFF_TR = OFF_TW + 64 * 16 * 8;
    typedef float f32x2v __attribute__((ext_vector_type(2)));
    LAS f32x2v* tabm = (LAS f32x2v*)(lds + OFF_TM);
    LAS f32x2v* tabw = (LAS f32x2v*)(lds + OFF_TW);
    const int tid = tid_, lane = tid & 63, wave = __builtin_amdgcn_readfirstlane(tid >> 6), l31 = lane & 31, hh = lane >> 5;
    for (int i = tid; i < 64 * 24; i += 512) { const int pos = i / 24, f = i % 24; float sn, cs;
        if (f < 8) { sincos_acc((float)pos * ROPE_INV8[f], sn, cs); tabm[pos * 8 + f] = (f32x2v){cs, sn}; }
        else { sincos_acc((float)pos * ROPE_INV16[f - 8], sn, cs); tabw[pos * 16 + f - 8] = (f32x2v){cs, sn}; } }
    const bf16_t* P = WSP(const bf16_t, O_P);
    const bf16_t* WUQ = WSP(const bf16_t, O_WUQT) + (size_t)layer * 768 * 256;
    const bf16_t* WUK = WSP(const bf16_t, O_WUKT) + (size_t)layer * 512 * 128;
    const bf16_t* WUV = WSP(const bf16_t, O_WUVT) + (size_t)layer * 512 * 128;
    bf16_t* QM = WSP(bf16_t, O_QM); bf16_t* KM = WSP(bf16_t, O_KM); bf16_t* VT = WSP(bf16_t, O_VT);
    const float qscale = 0.10206207261596575f * LOG2E, wscale = 0.125f * LOG2E;
    __syncthreads();
    LAS int* qslot = (LAS int*)(lds + 150016);
    LAS unsigned char* stg = lds + 96512 + (tid >> 6) * 6656;
    for (;;) {
        __syncthreads();
        if (tid == 0) {
            int it;
            if (canon) {
                const int x = vcu_of(bid_, G_) >> 5;
                const int q = (int)__hip_atomic_fetch_add(WSP(unsigned, O_QXCD) + (layer * 8 + x) * 64, 1u, __ATOMIC_RELAXED, __HIP_MEMORY_SCOPE_AGENT);
                if (q >= 204) it = NROWS / 64 + 8 * 4 * 34;
                else { const int mt = q < 68 ? q >> 2 : (q - 68) >> 3, pm = mt < 16 ? 32 * (mt >> 2) + 4 * x + (mt & 3) : 128 + x;
                    if (q < 68) it = pm * 4 + (q & 3);
                    else { const int sub = (q - 68) & 7, chunk = sub >> 2, hd = sub & 3, b = pm < 128 ? pm >> 4 : pm - 128, ck = pm < 128 ? 2 + (pm & 15) * 2 + chunk : chunk;
                        it = NROWS / 64 + (b * 4 + hd) * 34 + ck; } }
            } else it = (int)__hip_atomic_fetch_add(WSP(unsigned, O_QCNT) + layer * 64, 1u, __ATOMIC_RELAXED, __HIP_MEMORY_SCOPE_AGENT);
            if (it < NROWS / 64 + 8 * 4 * 34) {
                int r0 = it * 64;
                if (it >= NROWS / 64) { const int q = it - NROWS / 64; r0 = chunk_row0((q / 34) >> 2, q % 34); }
                const unsigned* dw = WSP(const unsigned, O_DEPW) + (layer * 136 + (r0 >> 8)) * 8;
                for (unsigned spins = 0; __hip_atomic_load(dw, __ATOMIC_RELAXED, __HIP_MEMORY_SCOPE_AGENT) < 64u && spins < (1u << 24); ++spins) __builtin_amdgcn_s_sleep(2);
                __builtin_amdgcn_fence(__ATOMIC_ACQUIRE, "agent");
                asm volatile("s_waitcnt vmcnt(0)" ::: "memory");
            }
            *qslot = it;
        }
        __syncthreads();
        const int item = *qslot;
        if (item >= NROWS / 64 + 8 * 4 * 34) break;
        if (item >= NROWS / 64) { ret_kv_item(p, layer, item - NROWS / 64, smem, tid); continue; }
        const int row0 = item * 64; const RowInfo ri = row_info(row0);
        const int key0 = ri.key, rowpos = ri.t >> 6; const bool isctx = ri.isctx != 0; const bool need_q = !(isctx && layer != 0);
        uint2 uqs[8]; unsigned uks[8];
#pragma unroll
        for (int rr = 0; rr < 8; ++rr) { const bf16_t* pr = P + (size_t)(row0 + wave * 8 + rr) * PLD; uqs[rr] = *(const uint2*)(pr + C_CQ + lane * 4); uks[rr] = *(const unsigned*)(pr + C_CKV + lane * 2); }
        const float4 gq = ((const float4*)(p.mla_qnorm_g + layer * 256))[lane]; const float2 gk = ((const float2*)(p.mla_kvnorm_g + layer * 128))[lane];
        __builtin_amdgcn_sched_barrier(0);
#pragma unroll
        for (int rr = 0; rr < 8; ++rr) { const int r = wave * 8 + rr;
            const uint2 uq = uqs[rr]; const unsigned uk = uks[rr];
            const float q0 = bflo(uq.x), q1 = bfhi(uq.x), q2 = bflo(uq.y), q3 = bfhi(uq.y), k0 = bflo(uk), k1 = bfhi(uk);
            const float rq = rsqrtf(wave_sum(q0 * q0 + q1 * q1 + q2 * q2 + q3 * q3) * (1.f / 256.f) + 1e-6f), rk = rsqrtf(wave_sum(k0 * k0 + k1 * k1) * (1.f / 128.f) + 1e-6f);
            *(LAS u32x2*)(lds + r * A1S + lane * 8) = (u32x2){cvt_pk(q0 * rq * gq.x, q1 * rq * gq.y), cvt_pk(q2 * rq * gq.z, q3 * rq * gq.w)};
            *(LAS unsigned*)(lds + OFF_A2 + r * A2S + lane * 4) = cvt_pk(k0 * rk * gk.x, k1 * rk * gk.y); }
        __syncthreads();
        if (need_q) {
            f32x16 acc[3][2];
#pragma unroll
            for (int nb = 0; nb < 3; ++nb)
#pragma unroll
                for (int tb = 0; tb < 2; ++tb)
#pragma unroll
                    for (int r = 0; r < 16; ++r) acc[nb][tb][r] = 0.f;
            const __attribute__((address_space(1))) bf16_t* wq = (const __attribute__((address_space(1))) bf16_t*)(WUQ + (size_t)(wave * 48) * 512 + lane * 8);
            asm volatile("" : "+v"(wq));
            const LAS unsigned char* ab = lds + l31 * A1S + 16 * hh;
            bf16x8 wA[2][3], wB[2][3];
#define PC_LDW(w_, s0_) do { _Pragma("unroll") for (int j = 0; j < 2; ++j) _Pragma("unroll") for (int nb = 0; nb < 3; ++nb) w_[j][nb] = *(const __attribute__((address_space(1))) bf16x8*)(wq + (size_t)(nb * 16 + (s0_) + j) * 512); } while (0)
#define PC_MMA(w_, s0_) do { _Pragma("unroll") for (int j = 0; j < 2; ++j) { const bf16x8 b0 = *(const LAS bf16x8*)(ab + 32 * ((s0_) + j)), b1 = *(const LAS bf16x8*)(ab + 32 * A1S + 32 * ((s0_) + j)); \
                _Pragma("unroll") for (int nb = 0; nb < 3; ++nb) { acc[nb][0] = __builtin_amdgcn_mfma_f32_32x32x16_bf16(w_[j][nb], b0, acc[nb][0], 0, 0, 0); acc[nb][1] = __builtin_amdgcn_mfma_f32_32x32x16_bf16(w_[j][nb], b1, acc[nb][1], 0, 0, 0); } } } while (0)
            PC_LDW(wA, 0); __builtin_amdgcn_sched_barrier(0);
#pragma unroll
            for (int c = 0; c < 16; c += 4) {
                PC_LDW(wB, c + 2); __builtin_amdgcn_sched_barrier(0);
                PC_MMA(wA, c); __builtin_amdgcn_sched_barrier(0);
                if (c + 4 < 16) { PC_LDW(wA, c + 4); __builtin_amdgcn_sched_barrier(0); }
                PC_MMA(wB, c + 2); __builtin_amdgcn_sched_barrier(0);
            }
#undef PC_LDW
#undef PC_MMA
#pragma unroll
            for (int tb = 0; tb < 2; ++tb) {
                if (!isctx) {
#pragma unroll
                    for (int r = 0; r < 4; ++r) {
                        const f32x2v cr = tabm[rowpos * 8 + 4 * hh + r], cc = tabm[(32 * tb + l31) * 8 + 4 * hh + r];
                        const float x1 = acc[2][tb][r], x2 = acc[2][tb][r + 4], y1 = acc[2][tb][r + 8], y2 = acc[2][tb][r + 12];
                        acc[2][tb][r] = x1 * cr.x - x2 * cr.y; acc[2][tb][r + 4] = x1 * cr.y + x2 * cr.x;
                        acc[2][tb][r + 8] = y1 * cc.x - y2 * cc.y; acc[2][tb][r + 12] = y1 * cc.y + y2 * cc.x; }
                }
#pragma unroll
                for (int nb = 0; nb < 3; ++nb)
#pragma unroll
                    for (int g = 0; g < 4; ++g) *(LAS u32x2*)(stg + opq(l31 * 208 + 8 * hh) + (32 * nb + 8 * g) * 2) = (u32x2){cvt_pk(acc[nb][tb][4 * g] * qscale, acc[nb][tb][4 * g + 1] * qscale), cvt_pk(acc[nb][tb][4 * g + 2] * qscale, acc[nb][tb][4 * g + 3] * qscale)};
                asm volatile("s_waitcnt lgkmcnt(0)" ::: "memory");
#pragma unroll
                for (int ps = 0; ps < 6; ++ps) { const int idx = opq(lane) + 64 * ps, rw = idx / 12, ch = idx % 12;
                    const u32x4 v = *(const LAS u32x4*)(stg + rw * 208 + ch * 16);
                    *(u32x4*)(QM + ((size_t)(row0 + 32 * tb + rw) * 8 + wave) * 96 + ch * 8) = v; }
                asm volatile("s_waitcnt lgkmcnt(0)" ::: "memory");
            }
        }
        {
            f32x16 ak[2][2], av[2][2];
#pragma unroll
            for (int nb = 0; nb < 2; ++nb)
#pragma unroll
                for (int tb = 0; tb < 2; ++tb)
#pragma unroll
                    for (int r = 0; r < 16; ++r) { ak[nb][tb][r] = 0.f; av[nb][tb][r] = 0.f; }
            const __attribute__((address_space(1))) bf16_t* wk = (const __attribute__((address_space(1))) bf16_t*)(WUK + (size_t)(wave * 16) * 512 + lane * 8);
            const __attribute__((address_space(1))) bf16_t* wv = (const __attribute__((address_space(1))) bf16_t*)(WUV + (size_t)(wave * 16) * 512 + lane * 8);
            asm volatile("" : "+v"(wk), "+v"(wv));
            const LAS unsigned char* ab = lds + OFF_A2 + l31 * A2S + 16 * hh;
            bf16x8 uA[2][2], uB[2][2];
#define PC_LDW(w_, s_) do { _Pragma("unroll") for (int nb = 0; nb < 2; ++nb) { w_[nb][0] = *(const __attribute__((address_space(1))) bf16x8*)(wk + (size_t)(nb * 8 + (s_)) * 512); w_[nb][1] = *(const __attribute__((address_space(1))) bf16x8*)(wv + (size_t)(nb * 8 + (s_)) * 512); } } while (0)
#define PC_MMA(w_, s_) do { const bf16x8 b0 = *(const LAS bf16x8*)(ab + 32 * (s_)), b1 = *(const LAS bf16x8*)(ab + 32 * A2S + 32 * (s_)); \
                _Pragma("unroll") for (int nb = 0; nb < 2; ++nb) { \
                    ak[nb][0] = __builtin_amdgcn_mfma_f32_32x32x16_bf16(w_[nb][0], b0, ak[nb][0], 0, 0, 0); ak[nb][1] = __builtin_amdgcn_mfma_f32_32x32x16_bf16(w_[nb][0], b1, ak[nb][1], 0, 0, 0); \
                    av[nb][0] = __builtin_amdgcn_mfma_f32_32x32x16_bf16(b0, w_[nb][1], av[nb][0], 0, 0, 0); av[nb][1] = __builtin_amdgcn_mfma_f32_32x32x16_bf16(b1, w_[nb][1], av[nb][1], 0, 0, 0); } } while (0)
            PC_LDW(uA, 0); __builtin_amdgcn_sched_barrier(0);
#pragma unroll
            for (int c = 0; c < 8; c += 2) {
                PC_LDW(uB, c + 1); __builtin_amdgcn_sched_barrier(0);
                PC_MMA(uA, c); __builtin_amdgcn_sched_barrier(0);
                if (c + 2 < 8) { PC_LDW(uA, c + 2); __builtin_amdgcn_sched_barrier(0); }
                PC_MMA(uB, c + 1); __builtin_amdgcn_sched_barrier(0);
            }
#undef PC_LDW
#undef PC_MMA
            const size_t bhw = (size_t)(ri.b * 8 + wave);
#pragma unroll
            for (int tb = 0; tb < 2; ++tb) {
#pragma unroll
                for (int nb = 0; nb < 2; ++nb)
#pragma unroll
                    for (int g = 0; g < 4; ++g) *(LAS u32x2*)(stg + opq(l31 * 144 + 8 * hh) + (32 * nb + 8 * g) * 2) = (u32x2){cvt_pk(ak[nb][tb][4 * g], ak[nb][tb][4 * g + 1]), cvt_pk(ak[nb][tb][4 * g + 2], ak[nb][tb][4 * g + 3])};
                asm volatile("s_waitcnt lgkmcnt(0)" ::: "memory");
#pragma unroll
                for (int ps = 0; ps < 4; ++ps) { const int idx = opq(lane) + 64 * ps, rw = idx >> 3, ch = idx & 7;
                    const u32x4 v = *(const LAS u32x4*)(stg + rw * 144 + ch * 16);
                    *(u32x4*)(KM + (bhw * NKEYS + key0 + 32 * tb + rw) * 96 + ch * 8) = v; }
                asm volatile("s_waitcnt lgkmcnt(0)" ::: "memory");
            }
#pragma unroll
            for (int nb = 0; nb < 2; ++nb) {
#pragma unroll
                for (int tb = 0; tb < 2; ++tb)
#pragma unroll
                    for (int g = 0; g < 4; ++g) *(LAS u32x2*)(stg + opq(l31 * 144 + 8 * hh) + (32 * tb + 8 * g) * 2) = (u32x2){cvt_pk(av[nb][tb][4 * g], av[nb][tb][4 * g + 1]), cvt_pk(av[nb][tb][4 * g + 2], av[nb][tb][4 * g + 3])};
                asm volatile("s_waitcnt lgkmcnt(0)" ::: "memory");
#pragma unroll
                for (int ps = 0; ps < 4; ++ps) { const int idx = opq(lane) + 64 * ps, rw = idx >> 3, ch = idx & 7;
                    const u32x4 v = *(const LAS u32x4*)(stg + rw * 144 + ch * 16);
                    *(u32x4*)(VT + (bhw * 64 + 32 * nb + rw) * NKEYS + key0 + ch * 8) = v; }
                asm volatile("s_waitcnt lgkmcnt(0)" ::: "memory");
            }
        }
        {
#pragma unroll
            for (int ps = 0; ps < 4; ++ps) { const int id = opq(tid) + 512 * ps, cc = id & 3, tk = (id >> 2) & 63, hd = id >> 8;
                const bf16_t* pr = P + (size_t)(row0 + tk) * PLD + C_KR;
                const uint4 uo = ((const uint4*)pr)[cc], up = ((const uint4*)pr)[cc ^ 1];
                const unsigned wo[4] = {uo.x, uo.y, uo.z, uo.w}, wp[4] = {up.x, up.y, up.z, up.w};
                float y[8];
#pragma unroll
                for (int j = 0; j < 8; ++j) { const float xo = (j & 1) ? bfhi(wo[j >> 1]) : bflo(wo[j >> 1]), xp = (j & 1) ? bfhi(wp[j >> 1]) : bflo(wp[j >> 1]);
                    if (isctx) y[j] = xo;
                    else { const f32x2v cs = tabm[((cc & 2) ? tk : rowpos) * 8 + j]; y[j] = (cc & 1) ? xp * cs.y + xo * cs.x : xo * cs.x - xp * cs.y; } }
                *(uint4*)(KM + ((size_t)(ri.b * 8 + hd) * NKEYS + key0 + tk) * 96 + 64 + cc * 8) = make_uint4(cvt_pk(y[0], y[1]), cvt_pk(y[2], y[3]), cvt_pk(y[4], y[5]), cvt_pk(y[6], y[7]));
            }
        }
        {
#pragma unroll 1
            for (int pg3 = 0; pg3 < 2; ++pg3) {
                uint4 uo3[3], up3[3];
#pragma unroll
                for (int q3 = 0; q3 < 3; ++q3) { const int ps = 3 * pg3 + q3; const bool isq = ps < 4; const int id = opq(tid) + 512 * (isq ? ps : ps - 4);
                    const int ch = isq ? (id & 31) : (id & 7), tk = isq ? (id >> 5) : ((id >> 3) & 63), hdk = id >> 9, cc = ch & 3;
                    const bf16_t* pr = P + (size_t)(row0 + tk) * PLD + (isq ? C_WQ : C_WK + hdk * 64) + (ch >> 2) * 32;
                    uo3[q3] = ((const uint4*)pr)[cc]; up3[q3] = ((const uint4*)pr)[cc ^ 2]; }
                __builtin_amdgcn_sched_barrier(0);
#pragma unroll
                for (int q3 = 0; q3 < 3; ++q3) { const int ps = 3 * pg3 + q3; const bool isq = ps < 4; const int id = opq(tid) + 512 * (isq ? ps : ps - 4);
                    const int ch = isq ? (id & 31) : (id & 7), tk = isq ? (id >> 5) : ((id >> 3) & 63), hdk = id >> 9;
                    const int cc = ch & 3, half = (ch >> 2) & 1;
                    const uint4 uo = uo3[q3], up = up3[q3];
                    const unsigned wo[4] = {uo.x, uo.y, uo.z, uo.w}, wp[4] = {up.x, up.y, up.z, up.w};
                    const float sc = isq ? wscale : 1.f;
                    float y[8];
#pragma unroll
                    for (int j = 0; j < 8; ++j) { const float xo = (j & 1) ? bfhi(wo[j >> 1]) : bflo(wo[j >> 1]), xp = (j & 1) ? bfhi(wp[j >> 1]) : bflo(wp[j >> 1]);
                        if (isctx) y[j] = xo * sc;
                        else { const f32x2v cs = tabw[(half == 0 ? rowpos : tk) * 16 + (cc & 1) * 8 + j]; y[j] = ((cc & 2) ? xp * cs.y + xo * cs.x : xo * cs.x - xp * cs.y) * sc; } }
                    bf16_t* o = isq ? WSP(bf16_t, O_WQ) + (size_t)(row0 + tk) * 256 + ch * 8 : WSP(bf16_t, O_WK) + ((size_t)(ri.b * 2 + hdk) * NKEYS + key0 + tk) * 64 + ch * 8;
                    *(uint4*)o = make_uint4(cvt_pk(y[0], y[1]), cvt_pk(y[2], y[3]), cvt_pk(y[4], y[5]), cvt_pk(y[6], y[7]));
                }
            }
        }
    }
}

__device__ __forceinline__ void st_win_fast(int layer, char* smem) {
    STAGE_PARAMS();
    LAS unsigned char* lds = (LAS unsigned char*)(LAS char*)smem;
    const int c = (vcu_of(bid_, G_) + G_ - 64 % G_) % G_;
    const int nunits = 512 + (layer == 0 ? 32 : 0);
    const bf16_t* WQ = WSP(const bf16_t, O_WQ); const bf16_t* WK = WSP(const bf16_t, O_WK); const bf16_t* WVT = WSP(const bf16_t, O_WVT); bf16_t* Y = WSP(bf16_t, O_HX);
    if (tid_ >= 256) __builtin_amdgcn_s_setprio(1);
    for (int L = c; L < nunits; L += G_) {
        int b, hk, row0, ntiles, second0 = 0, qtok0 = 0;
        if (L < 512) { const int bk = L >> 5, qb = L & 31; b = bk >> 1; hk = bk & 1; qtok0 = qb * 128; row0 = b * SEQ + qtok0;
            const int lo = qtok0 - 128 < 0 ? 0 : qtok0 - 128, hi = qtok0 + 255 > SEQ - 1 ? SEQ - 1 : qtok0 + 255;
            ntiles = 4 + (hi + 1 - lo) / 64; second0 = 256 + lo; }
        else { const int q = L - 512; b = q >> 2; hk = (q >> 1) & 1; row0 = NLAT + b * CTXL + (q & 1) * 128; ntiles = 4; }
        const bf16_t* Pv = WSP(const bf16_t, O_P) + C_WV + hk * 64;
        fa::attn_unit<64, true, true, true>(lds, tid_, WQ + (size_t)row0 * 256 + hk * 128, 256, WK + (size_t)(b * 2 + hk) * NKEYS * 64, Pv + ((long)b * SEQ - 256) * (long)PLD, PLD,
                                      ntiles, 4, second0, qtok0, p.win_sink[layer * 4 + 2 * hk] * LOG2E, Y + (size_t)row0 * DM + 768 + hk * 128, DM, p.win_sink[layer * 4 + 2 * hk + 1] * LOG2E,
                                      Pv + ((size_t)NLAT + (size_t)b * CTXL) * PLD);
    }
    __builtin_amdgcn_s_setprio(0);
}
__device__ __forceinline__ void st_ret_fast(int layer, char* smem) {
    STAGE_PARAMS();
    using namespace fa;
    LAS unsigned char* lds = (LAS unsigned char*)(LAS char*)smem;
    constexpr int KSTR = 144, VSTR = 520, KB = 256 * KSTR;
    const int tid = tid_, lane = tid & 63, wave = __builtin_amdgcn_readfirstlane(tid >> 6), q32 = lane & 31, hh = lane >> 5;
    const int c = (vcu_of(bid_, G_) + G_ - 96 % G_) % G_;
    const int npair = layer == 0 ? 17 : 16, nunits = 32 * npair;
    const bf16_t* P = WSP(const bf16_t, O_P); const bf16_t* RVT = WSP(const bf16_t, O_RVT); bf16_t* Y = WSP(bf16_t, O_HX);
    for (int L = c; L < nunits; L += G_) {
        const int bh = L / npair, pr = L % npair + (layer == 0 ? 0 : 1), b = bh >> 2, h = bh & 3;
        const int row0 = chunk_row0(b, 2 * pr), key0 = pr == 0 ? 0 : 256 + (2 * pr - 2) * 128;
        const float lgf = WSP(const float, O_RETLG)[layer * 8 + h], lgb = WSP(const float, O_RETLG)[layer * 8 + 4 + h];
        __syncthreads();
        const int ckl = wave >> 2, ck = 2 * pr + ckl, cpos = opq(32 * (wave & 3) + q32);
        const int row = row0 + wave * 32 + q32;
        u32x4 uk4[4], uv4[4];
#pragma unroll
        for (int i = 0; i < 4; ++i) { const int id = tid + 512 * i; uk4[i] = *(const u32x4*)(P + (size_t)(row0 + (id >> 3)) * PLD + C_RK + h * 64 + (id & 7) * 8);
            uv4[i] = *(const u32x4*)(P + (size_t)(row0 + (id >> 3)) * PLD + C_RV + h * 64 + (id & 7) * 8); }
        bf16x8 qf[4];
#pragma unroll
        for (int s = 0; s < 4; ++s) qf[s] = *(const bf16x8*)(P + (size_t)row * PLD + C_RQ + h * 64 + 16 * s + 8 * hh);
        uint2 gga[4], ggb[4];
        { const bf16_t* gr0 = P + (size_t)row * PLD + C_RG + h * 64 + 4 * hh;
#pragma unroll
          for (int g = 0; g < 4; ++g) { gga[g] = *(const uint2*)(gr0 + 8 * g); ggb[g] = *(const uint2*)(gr0 + 32 + 8 * g); } }
        bf16x8 spf[2][4][2];
#pragma unroll
        for (int dir = 0; dir < 2; ++dir) { const bf16_t* sp = WSP(const bf16_t, dir ? O_SPB : O_SPF) + ((size_t)bh * 34 + ck) * 4096 + (size_t)q32 * 64 + 8 * hh;
#pragma unroll
            for (int s = 0; s < 4; ++s) { spf[dir][s][0] = *(const bf16x8*)(sp + 16 * s); spf[dir][s][1] = *(const bf16x8*)(sp + 32 * 64 + 16 * s); } }
        __builtin_amdgcn_sched_barrier(0);
#pragma unroll
        for (int i = 0; i < 4; ++i) { const int id = tid + 512 * i; const int r = id >> 3, ch = id & 7;
            *(LAS u32x4*)(lds + r * KSTR + ch * 16) = uk4[i]; }
#pragma unroll
        for (int i = 0; i < 4; ++i) { const int id = tid + 512 * i; const int r = id >> 3, ch = id & 7;
            *(LAS u32x4*)(lds + KB + (r >> 6) * 8192 + vtr_st(r & 63, ch * 8)) = uv4[i]; }
        f32x16 o0, o1;
#pragma unroll
        for (int r = 0; r < 16; ++r) { o0[r] = 0.f; o1[r] = 0.f; }
#pragma unroll
        for (int dir = 0; dir < 2; ++dir) {
            f32x16 r0, r1;
#pragma unroll
            for (int r = 0; r < 16; ++r) { r0[r] = 0.f; r1[r] = 0.f; }
#pragma unroll
            for (int s = 0; s < 4; ++s) {
                const bf16x8 a0 = spf[dir][s][0], a1 = spf[dir][s][1];
                r0 = __builtin_amdgcn_mfma_f32_32x32x16_bf16(a0, qf[s], r0, 0, 0, 0);
                r1 = __builtin_amdgcn_mfma_f32_32x32x16_bf16(a1, qf[s], r1, 0, 0, 0);
            }
            const float wq = __builtin_amdgcn_exp2f(dir ? lgb * (float)(128 - cpos) : lgf * (float)(cpos + 1));
#pragma unroll
            for (int r = 0; r < 16; ++r) { o0[r] += wq * r0[r]; o1[r] += wq * r1[r]; }
        }
        __syncthreads();
#pragma unroll
        for (int tt = 0; tt < 2; ++tt) {
            const int kbase = ckl * 128 + tt * 64;
            const LAS unsigned char* kb = lds + (kbase + q32) * KSTR + 16 * hh;
            f32x16 p0, p1;
#pragma unroll
            for (int r = 0; r < 16; ++r) { p0[r] = 0.f; p1[r] = 0.f; }
#pragma unroll
            for (int s = 0; s < 4; ++s) {
                const bf16x8 a0 = *(const LAS bf16x8*)(kb + 32 * s), a1 = *(const LAS bf16x8*)(kb + 32 * KSTR + 32 * s);
                p0 = __builtin_amdgcn_mfma_f32_32x32x16_bf16(a0, qf[s], p0, 0, 0, 0);
                p1 = __builtin_amdgcn_mfma_f32_32x32x16_bf16(a1, qf[s], p1, 0, 0, 0);
            }
#pragma unroll
            for (int r = 0; r < 16; ++r) { const int mp = tt * 64 + 4 * hh + (r & 3) + 8 * (r >> 2); const int d0 = cpos - mp, d1 = d0 - 32;
                p0[r] *= __builtin_amdgcn_exp2f(((d0 >= 0) ? lgf : -lgb) * (float)d0);
                p1[r] *= __builtin_amdgcn_exp2f(((d1 >= 0) ? lgf : -lgb) * (float)d1); }
            bf16x8 pf[4];
#pragma unroll
            for (int s = 0; s < 4; ++s) { unsigned w[4];
#pragma unroll
                for (int j = 0; j < 4; ++j) { const int r = 8 * (s & 1) + 2 * j; w[j] = (s < 2) ? cvt_pk(p0[r], p0[r + 1]) : cvt_pk(p1[r], p1[r + 1]); }
                const u32x4 u = (u32x4){w[0], w[1], w[2], w[3]}; pf[s] = __builtin_bit_cast(bf16x8, u); }
            u32x2 va[4][4];
            { const int vtb = (int)(unsigned)(size_t)(lds + KB + (kbase >> 6) * 8192) + vtr_base(lane); VTR_READ_ALL(va, vtb); }
            asm volatile("s_waitcnt lgkmcnt(0)" ::: "memory"); __builtin_amdgcn_sched_barrier(0);
#pragma unroll
            for (int s = 0; s < 4; ++s) {
                const u32x2 a00 = va[s][0], a01 = va[s][1], a10 = va[s][2], a11 = va[s][3];
                const u32x4 u0 = (u32x4){a00.x, a00.y, a01.x, a01.y}, u1 = (u32x4){a10.x, a10.y, a11.x, a11.y};
                o0 = __builtin_amdgcn_mfma_f32_32x32x16_bf16(__builtin_bit_cast(bf16x8, u0), pf[s], o0, 0, 0, 0);
                o1 = __builtin_amdgcn_mfma_f32_32x32x16_bf16(__builtin_bit_cast(bf16x8, u1), pf[s], o1, 0, 0, 0);
            }
        }
        float sm = 0.f;
#pragma unroll
        for (int r = 0; r < 16; ++r) { o0[r] *= 0.125f; o1[r] *= 0.125f; sm += o0[r] + o1[r]; }
        const float mu = xhalf_sum(sm) * (1.f / 64.f);
        float sq = 0.f;
#pragma unroll
        for (int r = 0; r < 16; ++r) { o0[r] -= mu; o1[r] -= mu; sq += o0[r] * o0[r] + o1[r] * o1[r]; }
        const float rstd = rsqrtf(xhalf_sum(sq) * (1.f / 64.f) + 1e-5f);
        bf16_t* yr = Y + (size_t)row * DM + h * 64 + 4 * hh;
#pragma unroll
        for (int g = 0; g < 4; ++g) {
            const uint2 ga = gga[g], gb = ggb[g];
            const float g0[4] = {bflo(ga.x), bfhi(ga.x), bflo(ga.y), bfhi(ga.y)}, g1[4] = {bflo(gb.x), bfhi(gb.x), bflo(gb.y), bfhi(gb.y)};
            float y0[4], y1[4];
#pragma unroll
            for (int j = 0; j < 4; ++j) { y0[j] = o0[4 * g + j] * rstd * g0[j] * __builtin_amdgcn_rcpf(1.f + __builtin_amdgcn_exp2f(-g0[j] * LOG2E)); y1[j] = o1[4 * g + j] * rstd * g1[j] * __builtin_amdgcn_rcpf(1.f + __builtin_amdgcn_exp2f(-g1[j] * LOG2E)); }
            *(uint2*)(yr + 8 * g) = make_uint2(cvt_pk(y0[0], y0[1]), cvt_pk(y0[2], y0[3]));
            *(uint2*)(yr + 32 + 8 * g) = make_uint2(cvt_pk(y1[0], y1[1]), cvt_pk(y1[2], y1[3]));
        }
    }
}

#define XB_TMO      128
#define XB_XCNT(j)  (256  + 64 * (j))
#define XB_XSUB(j)  (1280 + 64 * (j))
#define XB_XGEN(j)  (2304 + 64 * (j))
#define XB_TOP      3328
#define XB_TOPGEN   3392
#define XCD_BAR_WORDS 3456
#define XB_SPIN_CAP (1u << 18)

__device__ __forceinline__ unsigned xb_ld(unsigned* p)              { return __hip_atomic_load(p, __ATOMIC_RELAXED, __HIP_MEMORY_SCOPE_AGENT); }
__device__ __forceinline__ unsigned xb_add(unsigned* p, unsigned v) { return __hip_atomic_fetch_add(p, v, __ATOMIC_RELAXED, __HIP_MEMORY_SCOPE_AGENT); }
__device__ __forceinline__ unsigned xb_xcc_id() { return (unsigned)__builtin_amdgcn_s_getreg((3 << 11) | 20) & 0xFu; }
#define XB_SPIN(cond, bar) do { unsigned _sp = 0; while (cond) { __builtin_amdgcn_s_sleep(1); \
    if ((++_sp & 255u) == 0u) { if (xb_ld(&(bar)[XB_TMO])) break; if (_sp > XB_SPIN_CAP) { atomicAdd(&(bar)[XB_TMO], 1u); break; } } } } while (0)

struct XcdBarrier {
    unsigned* bar; unsigned x;
    volatile LAS unsigned* st;
};

__device__ __forceinline__ XcdBarrier xcd_barrier_post(unsigned* bar, volatile LAS unsigned* st) {
    XcdBarrier b; b.bar = bar; b.x = xb_xcc_id(); b.st = st;
    if (threadIdx.x == 0) (void)xb_add(&bar[XB_XCNT(b.x)], 1u);
    return b;
}
__device__ __forceinline__ void xcd_barrier_complete(unsigned* bar, unsigned x, unsigned& nloc, unsigned& nx) {
    const unsigned G = gridDim.x * gridDim.y * gridDim.z;
    unsigned sum, cnt, mine, sp = 0u;
    for (;;) {
        sum = 0u; cnt = 0u; mine = 0u;
#pragma unroll
        for (unsigned j = 0; j < 16; ++j) { const unsigned c = xb_ld(&bar[XB_XCNT(j)]); sum += c; cnt += (c > 0u) ? 1u : 0u; mine = (j == x) ? c : mine; }
        if (sum == G) break;
        __builtin_amdgcn_s_sleep(1);
        if ((++sp & 255u) == 0u) { if (xb_ld(&bar[XB_TMO])) break; if (sp > XB_SPIN_CAP) { atomicAdd(&bar[XB_TMO], 1u); break; } }
    }
    nloc = mine > 0u ? mine : 1u; nx = cnt > 0u ? cnt : 1u;
}

__device__ __forceinline__ void xcd_barrier(const XcdBarrier& b) {
    asm volatile("s_waitcnt vmcnt(0)" ::: "memory");
    __syncthreads();
    if (threadIdx.x == 0) {
        unsigned* bar = b.bar; unsigned bx = b.x; asm volatile("" : "+s"(bar), "+s"(bx));
        __builtin_amdgcn_s_waitcnt(0);
        unsigned nloc = b.st[0], nx = b.st[1];
        if (nloc == 0u) { xcd_barrier_complete(bar, bx, nloc, nx); b.st[0] = nloc; b.st[1] = nx; }
        const unsigned old = xb_add(&bar[XB_XSUB(bx)], 1u);
        const unsigned gen = old / nloc;
        if (old + 1u == (gen + 1u) * nloc) {
            __builtin_amdgcn_fence(__ATOMIC_RELEASE, "agent");
            asm volatile("s_waitcnt vmcnt(0)" ::: "memory");
            const unsigned og = xb_add(&bar[XB_TOP], 1u);
            const unsigned tg = og / nx;
            if (og + 1u == (tg + 1u) * nx) xb_add(&bar[XB_TOPGEN], 1u);
            else XB_SPIN(xb_ld(&bar[XB_TOPGEN]) == tg, bar);
            __builtin_amdgcn_fence(__ATOMIC_ACQUIRE, "agent");
            asm volatile("s_waitcnt vmcnt(0)" ::: "memory");
        } else {
            XB_SPIN(xb_ld(&bar[XB_TOPGEN]) == gen, bar);
            __builtin_amdgcn_fence(__ATOMIC_ACQUIRE, "agent");
            asm volatile("s_waitcnt vmcnt(0)" ::: "memory");
        }
    }
    __syncthreads();
}

constexpr int MK_LDS = 151552;
constexpr size_t CW_BAR = 4096;
__global__ void __launch_bounds__(512, 2) k_mega(Params p, int pad0, int pad1) {
    extern __shared__ __attribute__((aligned(16))) char smem[];
    volatile LAS unsigned* misc = (volatile LAS unsigned*)(smem + MK_LDS - 64);
    if (threadIdx.x < 16) misc[threadIdx.x] = 0u;
    __syncthreads();
    XcdBarrier bar = xcd_barrier_post(WSP(unsigned, O_CTL) + CW_BAR, misc);
#define GRID_BAR() xcd_barrier(bar)
    { const int myx = __builtin_amdgcn_readfirstlane((int)xb_xcc_id()), wantx = __builtin_amdgcn_readfirstlane((int)(blockIdx.x & 7u)), g256 = __builtin_amdgcn_readfirstlane((int)gridDim.x);
      unsigned mismv = (unsigned)(myx != wantx) | (unsigned)(g256 != 256);
      if (threadIdx.x == 0) __hip_atomic_fetch_or(WSP(unsigned, O_CANON), mismv, __ATOMIC_RELAXED, __HIP_MEMORY_SCOPE_AGENT); }
    st_mods(smem);
    st_prep_weights(0, 0, smem, (int)blockIdx.x, (int)gridDim.x);
    GRID_BAR();
    int canon_i = (int)__hip_atomic_load(WSP(unsigned, O_CANON), __ATOMIC_RELAXED, __HIP_MEMORY_SCOPE_AGENT); canon_i = __builtin_amdgcn_readfirstlane(canon_i); asm volatile("" : "+s"(canon_i));
    const bool canon = canon_i == 0;
    for (int l = 0; l < 2; ++l) {
        st_rownorm(l);
        GRID_BAR();
        st_gemm_win_fast(l, smem, canon);
        st_phase_c(l, smem, canon);
        GRID_BAR();
        st_ret_scan(l);
        GRID_BAR();
        st_mla_fast(l, smem); st_win_fast(l, smem); st_ret_fast(l, smem);
        GRID_BAR();
        st_gemm_wout_fast(l, smem, canon);
        if (!canon) GRID_BAR();
        st_norm2_router(l, smem, canon);
        {   const int G = (int)gridDim.x; int vb = (int)blockIdx.x, nb = G;
            if (l == 0) { if (canon) { const int cc = vcu_of((int)blockIdx.x, G); vb = (cc & 31) >= 4 ? (cc >> 5) * 28 + (cc & 31) - 4 : -1; nb = G - 32; } else { const int extra = 272 % G; vb = (int)blockIdx.x - extra; nb = G - extra; } }
            st_prep_weights(1, l, smem, vb, nb); }
        GRID_BAR();
        st_topk(l, smem);
        GRID_BAR();
#pragma unroll 1
        for (int part = 0; part < (l == 0 ? 2 : 1); ++part) {
            st_moe_up_fast(part, smem);
            if (part == 0) GRID_BAR();
        }
        st_moe_down_fast(l, smem);
        GRID_BAR();
    }
    st_rownorm(2);
}
}

extern "C" void kernel_launch(void* const* d_in, const int* in_sizes, int n_in, void* d_out, int out_size, void* d_ws, size_t ws_size, hipStream_t stream) {
    if (n_in != 23 || ws_size < O_END4) { fprintf(stderr, "kernel_launch: unexpected n_in %d or ws_size %zu (< %zu)\n", n_in, ws_size, (size_t)O_END4); return; }
    Params p{};
    const float** dst = (const float**)&p;
    for (int i = 0; i < 23; ++i) dst[i] = (const float*)d_in[i];
    p.out = (float*)d_out; p.ws = (unsigned char*)d_ws;
    static int grid = 0;
    if (grid == 0) {
        int dev = 0, cus = 0, per_cu = 0;
        if (hipGetDevice(&dev) != hipSuccess || hipDeviceGetAttribute(&cus, hipDeviceAttributeMultiprocessorCount, dev) != hipSuccess) { fprintf(stderr, "kernel_launch: device query failed\n"); grid = -1; return; }
        (void)hipFuncSetAttribute((const void*)k_mega, hipFuncAttributeMaxDynamicSharedMemorySize, MK_LDS);
        if (hipOccupancyMaxActiveBlocksPerMultiprocessor(&per_cu, (const void*)k_mega, 512, MK_LDS) != hipSuccess || per_cu < 1) { fprintf(stderr, "kernel_launch: occupancy query says %d\n", per_cu); per_cu = 1; }
        (void)hipGetLastError();
        grid = cus;
    }
    if (grid < 0) return;
    (void)hipMemsetAsync((char*)d_ws + O_CTL, 0, 65536, stream);
    hipLaunchKernelGGL(k_mega, dim3(grid), dim3(512), MK_LDS, stream, p, 0, 0);
}
```

```cpp
#include <hip/hip_runtime.h>
#include <stdint.h>
#include <stdio.h>

namespace {
typedef unsigned short bf16_t;
#define LAS __attribute__((address_space(3)))
constexpr int NB = 8, SEQ = 4096, CTXL = 256, DM = 1024;
constexpr int NLAT = NB * SEQ;
constexpr int NCTX = NB * CTXL;
constexpr int NROWS = NLAT + NCTX;
constexpr int NKEYS = CTXL + SEQ;
constexpr int PCOLS = 1952, PLD = 2048;
constexpr int C_RQ = 0, C_RK = 256, C_RV = 512, C_RG = 768, C_CQ = 1024, C_CKV = 1280, C_KR = 1408, C_WQ = 1440, C_WK = 1696, C_WV = 1824;
constexpr int NEXP = 16, FF = 768, CAP = 512, CAPC = 32;
constexpr float LOG2E = 1.4426950408889634f;

constexpr size_t O_CTL = 0;
constexpr size_t O_QCNT = 49152 + 1024;
constexpr size_t O_DEPW = 0;
constexpr size_t O_CANON = 49152 + 512;
constexpr size_t O_QXCD = 49152 + 4096;
constexpr size_t O_DEPX = 32768;
constexpr size_t O_DEPH = 49152 + 1024 + 512;
constexpr size_t O_RETLG = 49152;
constexpr size_t O_MOD = 65536;
constexpr size_t O_XC = 524288;
constexpr size_t O_AFF = O_XC + 8388608;
constexpr size_t O_IDX = O_AFF + 2228224;
constexpr size_t O_GATE = O_IDX + 262144;
constexpr size_t O_IDXC = O_GATE + 262144;
constexpr size_t O_GATEC = O_IDXC + 16384;
constexpr size_t O_SLOT = O_GATEC + 16384;
constexpr size_t O_WQ = O_SLOT + 1114112;
constexpr size_t O_WK = O_WQ + 17825792;
constexpr size_t O_WV = O_WK + 8912896;
constexpr size_t O_HX = O_WV + 8912896;
constexpr size_t O_P = O_HX + 71303168;
constexpr size_t O_QM = O_P + 142606336;
constexpr size_t O_KM = O_QM + 53477376;
constexpr size_t O_VM = O_KM + 53477376;
constexpr size_t O_END = O_VM + 35651584;
constexpr size_t O_WINT = O_END;
constexpr size_t O_WOUTT = O_WINT + 2 * 2048 * 1024 * 2;
constexpr size_t O_WGUT = O_WOUTT + 2 * 1024 * 1024 * 2;
constexpr size_t O_WDT = O_WGUT + (size_t)16 * 1536 * 1024 * 2;
constexpr size_t O_END2 = O_WDT + (size_t)16 * 1024 * 768 * 2;

constexpr size_t O_VT = O_END2;
constexpr size_t O_END3 = O_VT + 35651584;
constexpr size_t O_WVT = O_WV;
constexpr size_t O_RVT = O_WGUT;
constexpr size_t O_KVF = O_RVT + 17825792;
constexpr size_t O_KVB = O_KVF + 17825792;
constexpr size_t O_SPF = O_KVB + 17825792;
constexpr size_t O_SPB = O_SPF + 8912896;
static_assert(O_SPB + 8912896 <= O_WDT + (size_t)16 * 1024 * 768 * 2, "retention buffers fit in the expert-weight region");
constexpr size_t O_WUQT = O_END3;
constexpr size_t O_WUKT = O_WUQT + 2 * 768 * 256 * 2;
constexpr size_t O_WUVT = O_WUKT + 2 * 512 * 128 * 2;
constexpr size_t O_END4 = O_WUVT + 2 * 512 * 128 * 2;
constexpr size_t O_SSQ = O_END4;
constexpr size_t O_HID = O_P;
constexpr size_t O_HIDC = O_P + 100663296;
constexpr size_t O_YS = O_QM;
constexpr size_t O_YSC = O_QM + 134217728;

struct Params {
    const float *x, *c, *ctx, *c_ctx, *norm1_g, *norm2_g, *ada_w, *ada_b, *w_in, *ret_decay_f, *ret_decay_b,
        *mla_qnorm_g, *mla_kvnorm_g, *mla_w_uq, *mla_w_uk, *mla_w_uv, *win_sink, *w_out, *router_w,
        *exp_w_gate, *exp_w_up, *exp_w_down, *final_g;
    float* out; unsigned char* ws;
};

typedef const __attribute__((address_space(4))) Params KParams;
__device__ __forceinline__ int opaque_tid() { int t = (int)threadIdx.x; asm volatile("" : "+v"(t)); return t; }
#define STAGE_PARAMS() KParams* pp_ = (KParams*)__builtin_amdgcn_kernarg_segment_ptr(); asm volatile("" : "+s"(pp_)); KParams& p = *pp_; const int tid_ = opaque_tid(); int bid_ = (int)blockIdx.x, G_ = (int)gridDim.x; asm volatile("" : "+s"(bid_), "+s"(G_))
__device__ __forceinline__ float bf2f(bf16_t v) { return __uint_as_float(((unsigned)v) << 16); }
__device__ __forceinline__ float bflo(unsigned v) { return __uint_as_float(v << 16); }
__device__ __forceinline__ float bfhi(unsigned v) { return __uint_as_float(v & 0xffff0000u); }
__device__ __forceinline__ unsigned f2bf(float f) { unsigned u = __float_as_uint(f); return (u + 0x7fffu + ((u >> 16) & 1u)) >> 16; }
__device__ __forceinline__ unsigned pk2(float lo, float hi) { return f2bf(lo) | (f2bf(hi) << 16); }
__device__ __forceinline__ float wave_sum(float v) {
    v += __int_as_float(__builtin_amdgcn_ds_swizzle(__float_as_int(v), (1 << 10) | 0x1f));
    v += __int_as_float(__builtin_amdgcn_ds_swizzle(__float_as_int(v), (2 << 10) | 0x1f));
    v += __int_as_float(__builtin_amdgcn_ds_swizzle(__float_as_int(v), (4 << 10) | 0x1f));
    v += __int_as_float(__builtin_amdgcn_ds_swizzle(__float_as_int(v), (8 << 10) | 0x1f));
    v += __int_as_float(__builtin_amdgcn_ds_swizzle(__float_as_int(v), (16 << 10) | 0x1f));
    const auto rr = __builtin_amdgcn_permlane32_swap(__float_as_uint(v), __float_as_uint(v), false, false);
    return __uint_as_float(rr[0]) + __uint_as_float(rr[1]);
}
__device__ __forceinline__ float wave_max(float v) {
    v = fmaxf(v, __int_as_float(__builtin_amdgcn_ds_swizzle(__float_as_int(v), (1 << 10) | 0x1f)));
    v = fmaxf(v, __int_as_float(__builtin_amdgcn_ds_swizzle(__float_as_int(v), (2 << 10) | 0x1f)));
    v = fmaxf(v, __int_as_float(__builtin_amdgcn_ds_swizzle(__float_as_int(v), (4 << 10) | 0x1f)));
    v = fmaxf(v, __int_as_float(__builtin_amdgcn_ds_swizzle(__float_as_int(v), (8 << 10) | 0x1f)));
    v = fmaxf(v, __int_as_float(__builtin_amdgcn_ds_swizzle(__float_as_int(v), (16 << 10) | 0x1f)));
    const auto rr = __builtin_amdgcn_permlane32_swap(__float_as_uint(v), __float_as_uint(v), false, false);
    return fmaxf(__uint_as_float(rr[0]), __uint_as_float(rr[1]));
}
__device__ __forceinline__ float lane_bcast(float v, int srclane  ) { return __uint_as_float(__builtin_amdgcn_readlane(__float_as_uint(v), srclane)); }
__device__ __forceinline__ float silu_f(float v) { return v / (1.f + expf(-v)); }

#define WSP(T, off) ((T*)(p.ws + (off)))
template <class PT> __device__ __forceinline__ bf16_t* xs_ptr(const PT& p, int row, int seg) {
    if (seg == 0) return row < NLAT ? (bf16_t*)p.out + (size_t)row * DM : WSP(bf16_t, O_XC) + (size_t)(row - NLAT) * DM;
    return row < 16384 ? WSP(bf16_t, O_WQ) + (size_t)row * DM : WSP(bf16_t, O_VT) + (size_t)(row - 16384) * DM; }
template <class PT> __device__ __forceinline__ const float* mod_ptr(const PT& p, int layer, int bv, int chunk) { return WSP(const float, O_MOD) + ((size_t)(layer * 9 + bv) * 6 + chunk) * 1024; }
struct RowInfo { int b, t, isctx, bv, key; };
__device__ __forceinline__ RowInfo row_info(int row) {
    RowInfo r;
    if (row < NLAT) { r.b = row >> 12; r.t = row & 4095; r.isctx = 0; r.bv = r.b; r.key = 256 + r.t; }
    else { const int q = row - NLAT; r.b = q >> 8; r.t = q & 255; r.isctx = 1; r.bv = 8; r.key = r.t; }
    return r;
}

__constant__ float ROPE_INV8[8] = {1.f, 0.31622776601683794f, 0.1f, 0.031622776601683794f, 0.01f, 0.0031622776601683794f, 0.001f, 0.00031622776601683794f};
__constant__ float ROPE_INV16[16] = {1.f, 0.5623413251903491f, 0.31622776601683794f, 0.1778279410038923f, 0.1f, 0.05623413251903491f, 0.031622776601683794f, 0.01778279410038923f,
                                     0.01f, 0.005623413251903491f, 0.0031622776601683794f, 0.001778279410038923f, 0.001f, 0.0005623413251903491f, 0.00031622776601683794f, 0.0001778279410038923f};
__device__ __forceinline__ void sincos_acc(float ang, float& s, float& c) {
    float rev = ang * 0.15915494309189535f;
    rev -= floorf(rev);
    s = __builtin_amdgcn_sinf(rev); c = __builtin_amdgcn_cosf(rev);
}

__device__ __forceinline__ int vcu_of(int bid, int G) { return (G % 8 == 0) ? (bid % 8) * (G / 8) + bid / 8 : bid; }
__device__ __forceinline__ void st_mods(char* smem) {
    STAGE_PARAMS();
    float* sv = (float*)smem;
    float* red = sv + 9 * 1024;
    const int tid = tid_;
    if (bid_ == 0 && tid < 16) { const int l = tid >> 3, dir = (tid >> 2) & 1, h = tid & 3;
        const double dec = (double)(dir ? p.ret_decay_b : p.ret_decay_f)[l * 4 + h];
        WSP(float, O_RETLG)[tid] = (float)(log1p(-exp2(dec)) * 1.4426950408889634); }
    for (int i = tid; i < 9 * 1024; i += 512) { const int v = i >> 10, k = i & 1023; const float c = v < 8 ? p.c[v * 1024 + k] : p.c_ctx[k]; sv[i] = silu_f(c); }
    __syncthreads();
    for (int item = bid_; item < 2 * 96; item += G_) {
        const int l = item / 96, j0 = (item % 96) * 64, col = tid & 63, kq = tid >> 6;
        float acc[9];
#pragma unroll
        for (int v = 0; v < 9; ++v) acc[v] = 0.f;
        const float* W = p.ada_w + (size_t)l * 1024 * 6144 + j0 + col;
        for (int k = kq * 128; k < kq * 128 + 128; ++k) {
            const float w = W[(size_t)k * 6144];
#pragma unroll
            for (int v = 0; v < 9; ++v) acc[v] += sv[v * 1024 + k] * w;
        }
#pragma unroll
        for (int v = 0; v < 9; ++v) red[(kq * 9 + v) * 64 + col] = acc[v];
        __syncthreads();
        for (int i = tid; i < 576; i += 512) {
            const int v = i >> 6, cc = i & 63; float s = 0.f;
#pragma unroll
            for (int q = 0; q < 8; ++q) s += red[(q * 9 + v) * 64 + cc];
            WSP(float, O_MOD)[(size_t)(l * 9 + v) * 6144 + j0 + cc] = s + p.ada_b[l * 6144 + j0 + cc];
        }
        __syncthreads();
    }
}

__device__ __forceinline__ void st_rownorm(int mode) {
    STAGE_PARAMS();
    typedef float f32x4v __attribute__((ext_vector_type(4)));
    const int lane = tid_ & 63, wave = tid_ >> 6;
    const int gw = bid_ * 8 + wave, NGW = G_ * 8;
    const int nrows = mode == 2 ? NLAT : NROWS;
    f32x4v vn[4]; int msn = -1;
#define RN_LD(dst_, r_) do { if (mode == 0) { const float* src_ = (r_) >= NLAT ? p.ctx + (size_t)((r_) - NLAT) * DM : p.x + (size_t)(r_) * DM; \
        _Pragma("unroll") for (int j = 0; j < 4; ++j) dst_[j] = ((const f32x4v*)src_)[lane + 64 * j]; } \
    else { const uint2* src_ = (const uint2*)xs_ptr(p, (r_), mode - 1); \
        _Pragma("unroll") for (int j = 0; j < 4; ++j) { const uint2 u_ = src_[lane + 64 * j]; dst_[j] = (f32x4v){bflo(u_.x), bfhi(u_.x), bflo(u_.y), bfhi(u_.y)}; } } } while (0)
    if (gw < nrows) { RN_LD(vn, gw);
        if (mode != 0) msn = (int)WSP(const short, O_SLOT)[(size_t)gw * 16 + (lane & 15)]; }
    for (int row = gw; row < nrows; row += NGW) {
        const RowInfo ri = row_info(row);
        f32x4v v[4];
#pragma unroll
        for (int j = 0; j < 4; ++j) v[j] = vn[j];
        const int ms = msn;
        const int nrow = row + NGW;
        if (nrow < nrows) { RN_LD(vn, nrow);
            if (mode != 0) msn = (int)WSP(const short, O_SLOT)[(size_t)nrow * 16 + (lane & 15)]; }
        f32x4v pg5[4], pg1[4], psc[4], psh[4];
        {   const float* g5p = mode != 0 ? mod_ptr(p, mode - 1, ri.bv, 5) : p.final_g;
            const float* g1p = mode == 2 ? p.final_g : p.norm1_g + mode * 1024;
            const float* shp = mode == 2 ? p.final_g : mod_ptr(p, mode, ri.bv, 0); const float* scp = mode == 2 ? p.final_g : mod_ptr(p, mode, ri.bv, 1);
#pragma unroll
            for (int j = 0; j < 4; ++j) { if (mode != 0) pg5[j] = ((const f32x4v*)g5p)[lane + 64 * j]; pg1[j] = ((const f32x4v*)g1p)[lane + 64 * j];
                if (mode != 2) { psc[j] = ((const f32x4v*)scp)[lane + 64 * j]; psh[j] = ((const f32x4v*)shp)[lane + 64 * j]; } } }
        __builtin_amdgcn_sched_barrier(0);
        if (mode != 0) {
            const int lprev = mode - 1;
            f32x4v a[4];
#pragma unroll
            for (int j = 0; j < 4; ++j) a[j] = (f32x4v){0.f, 0.f, 0.f, 0.f};
            unsigned em = (unsigned)__ballot(ms >= 0) & 0xffffu;
            while (em != 0u) {
                int ee[4], es[4]; bool ok[4];
#pragma unroll
                for (int k = 0; k < 4; ++k) { ok[k] = em != 0u; ee[k] = ok[k] ? __builtin_ctz(em) : 0; em = ok[k] ? (em & (em - 1u)) : 0u; es[k] = __builtin_amdgcn_readlane(ms, ee[k]); }
                uint2 yb[4][4];
#pragma unroll
                for (int k = 0; k < 4; ++k) {
                    if (ok[k]) {
                        const int e = ee[k], s = es[k];
                        const bf16_t* yr = ri.isctx ? WSP(const bf16_t, O_YSC) + ((size_t)e * 256 + ri.b * 32 + s) * 1024
                                                    : WSP(const bf16_t, O_YS) + ((size_t)(ri.b * 16 + e) * 512 + s) * 1024;
#pragma unroll
                        for (int j = 0; j < 4; ++j) yb[k][j] = ((const uint2*)yr)[lane + 64 * j];
                    } }
                __builtin_amdgcn_sched_barrier(0);
#pragma unroll
                for (int k = 0; k < 4; ++k) {
                    if (ok[k]) {
#pragma unroll
                        for (int j = 0; j < 4; ++j) { const uint2 u = yb[k][j]; a[j].x += bflo(u.x); a[j].y += bfhi(u.x); a[j].z += bflo(u.y); a[j].w += bfhi(u.y); }
                    } }
            }
            uint2* dst = (uint2*)xs_ptr(p, row, 0);
#pragma unroll
            for (int j = 0; j < 4; ++j) {
                v[j] += pg5[j] * a[j];
                if (mode == 1) dst[lane + 64 * j] = make_uint2(pk2(v[j].x, v[j].y), pk2(v[j].z, v[j].w));
            }
        }
        float ss = 0.f;
#pragma unroll
        for (int j = 0; j < 4; ++j) ss += v[j].x * v[j].x + v[j].y * v[j].y + v[j].z * v[j].z + v[j].w * v[j].w;
        ss = wave_sum(ss);
        const float rstd = rsqrtf(ss * (1.f / 1024.f) + 1e-6f);
        if (mode == 2) {
#pragma unroll
            for (int j = 0; j < 4; ++j) ((f32x4v*)(p.out + (size_t)row * DM))[lane + 64 * j] = v[j] * rstd * pg1[j];
        } else {
            const int layer = mode;
            bf16_t* hx = WSP(bf16_t, O_HX) + (size_t)row * DM;
#pragma unroll
            for (int j = 0; j < 4; ++j) {
                const f32x4v h = v[j] * rstd * pg1[j] * (psc[j] + 1.f) + psh[j];
                ((uint2*)hx)[lane + 64 * j] = make_uint2(pk2(h.x, h.y), pk2(h.z, h.w));
            }
        }
    }
#undef RN_LD
}

__device__ __forceinline__ int opq(int v) { asm volatile("" : "+v"(v)); return v; }


__device__ __forceinline__ void st_norm2_router(int layer, char* smem, bool canon) {
    STAGE_PARAMS();
    typedef float f32x4v __attribute__((ext_vector_type(4)));
    typedef short bf16x8v __attribute__((ext_vector_type(8)));
    typedef unsigned u32x4v __attribute__((ext_vector_type(4)));
    LAS unsigned char* lds = (LAS unsigned char*)(LAS char*)smem;
    constexpr int WS = 2064;
    LAS unsigned short* whi = (LAS unsigned short*)lds; LAS unsigned short* wlo = (LAS unsigned short*)(lds + 16 * WS);
    LAS float* gg = (LAS float*)(lds + 32 * WS); LAS float* s4 = gg + 1024;
    const int tid = tid_, lane = tid & 63, wave = tid >> 6, r16 = lane & 15, kg = lane >> 4;
    const int nrows = layer == 0 ? NROWS : NLAT;
    { const float* RW = p.router_w + (size_t)layer * 1024 * 16;
      float wv[32];
#pragma unroll
      for (int k = 0; k < 32; ++k) wv[k] = RW[tid + 512 * k];
      __builtin_amdgcn_sched_barrier(0);
#pragma unroll
      for (int k = 0; k < 32; ++k) { const int i = tid + 512 * k; const float w = wv[k]; const unsigned hi = f2bf(w); const unsigned lo = f2bf(w - __uint_as_float(hi << 16));
          whi[(i & 15) * (WS / 2) + (i >> 4)] = (unsigned short)hi; wlo[(i & 15) * (WS / 2) + (i >> 4)] = (unsigned short)lo; } }
    const float* g2 = p.norm2_g + layer * 1024;
    const int cx = vcu_of(bid_, G_), xj = cx & 31, xx = cx >> 5;
    const int nmine = canon ? 1 + ((layer == 0 && (xj == 4 || xj == 5)) ? 1 : 0) : (nrows / 128 - bid_ + G_ - 1) / G_;
    for (int kk = 0; kk < nmine; ++kk) {
        int chunk;
        if (canon) { const int mt = kk == 0 ? xj >> 1 : 16, pm = mt < 8 ? 8 * xx + mt : (mt < 16 ? 64 + 8 * xx + (mt - 8) : 128 + xx); chunk = pm * 2 + (xj & 1);
            if (tid == 0) { const unsigned* dw = WSP(const unsigned, O_DEPX) + (layer * 136 + pm) * 8;
                for (unsigned spins = 0; __hip_atomic_load(dw, __ATOMIC_RELAXED, __HIP_MEMORY_SCOPE_AGENT) < 32u && spins < (1u << 24); ++spins) __builtin_amdgcn_s_sleep(2);
                __builtin_amdgcn_fence(__ATOMIC_ACQUIRE, "agent"); asm volatile("s_waitcnt vmcnt(0)" ::: "memory"); } }
        else chunk = bid_ + kk * G_;
        const int row0 = chunk * 128; const RowInfo ri = row_info(row0);
        __syncthreads();
        { const float* sh = mod_ptr(p, layer, ri.bv, 3); const float* sc = mod_ptr(p, layer, ri.bv, 4);
          for (int i = tid; i < 1024; i += 512) { gg[i] = g2[i] * (1.f + sc[i]); s4[i] = sh[i]; } }
        __syncthreads();
        const int row = row0 + wave * 16 + r16;
        const u32x4v* xr = (const u32x4v*)(xs_ptr(p, row, layer) + 8 * kg);
        float ss;
        { const float* sq = WSP(const float, O_SSQ) + (size_t)(4 * kg) * NROWS + row; ss = (sq[0] + sq[NROWS]) + (sq[2 * (size_t)NROWS] + sq[3 * (size_t)NROWS]); }
        ss += __int_as_float(__builtin_amdgcn_ds_swizzle(__float_as_int(ss), (16 << 10) | 0x1f));
        { const auto rr = __builtin_amdgcn_permlane32_swap(__float_as_uint(ss), __float_as_uint(ss), false, false); ss = __uint_as_float(rr[0]) + __uint_as_float(rr[1]); }
        const float rstd = rsqrtf(ss * (1.f / 1024.f) + 1e-6f);
        bf16_t* h2 = WSP(bf16_t, O_HX) + (size_t)row * DM + 8 * kg;
        const LAS unsigned char* wb = lds + r16 * WS + 16 * kg;
        f32x4v acc = (f32x4v){0.f, 0.f, 0.f, 0.f};
        u32x4v xq[4];
#pragma unroll
        for (int j = 0; j < 4; ++j) xq[j] = xr[4 * j];
#pragma unroll 1
        for (int sg = 0; sg < 32; sg += 4) {
          u32x4v cq[4];
#pragma unroll
          for (int j = 0; j < 4; ++j) cq[j] = xq[j];
          if (sg + 4 < 32) {
#pragma unroll
              for (int j = 0; j < 4; ++j) xq[j] = xr[4 * (sg + 4 + j)]; }
          __builtin_amdgcn_sched_barrier(0);
#pragma unroll
          for (int j = 0; j < 4; ++j) {
            const int s = sg + j;
            const f32x4v a = (f32x4v){bflo(cq[j].x), bfhi(cq[j].x), bflo(cq[j].y), bfhi(cq[j].y)}, b = (f32x4v){bflo(cq[j].z), bfhi(cq[j].z), bflo(cq[j].w), bfhi(cq[j].w)};
            const f32x4v ga = *(const LAS f32x4v*)(gg + 32 * s + 8 * kg), gb = *(const LAS f32x4v*)(gg + 32 * s + 8 * kg + 4), sa = *(const LAS f32x4v*)(s4 + 32 * s + 8 * kg), sb = *(const LAS f32x4v*)(s4 + 32 * s + 8 * kg + 4);
            const f32x4v ha = a * rstd * ga + sa, hb = b * rstd * gb + sb;
            u32x4v hi, lo;
            hi.x = pk2(ha.x, ha.y); hi.y = pk2(ha.z, ha.w); hi.z = pk2(hb.x, hb.y); hi.w = pk2(hb.z, hb.w);
            lo.x = pk2(ha.x - bflo(hi.x), ha.y - bfhi(hi.x)); lo.y = pk2(ha.z - bflo(hi.y), ha.w - bfhi(hi.y));
            lo.z = pk2(hb.x - bflo(hi.z), hb.y - bfhi(hi.z)); lo.w = pk2(hb.z - bflo(hi.w), hb.w - bfhi(hi.w));
            *(u32x4v*)(h2 + 32 * s) = hi;
            const bf16x8v wh = *(const LAS bf16x8v*)(wb + 64 * s), wl = *(const LAS bf16x8v*)(wb + 16 * WS + 64 * s);
            const bf16x8v hiv = __builtin_bit_cast(bf16x8v, hi), lov = __builtin_bit_cast(bf16x8v, lo);
            acc = __builtin_amdgcn_mfma_f32_16x16x32_bf16(hiv, wh, acc, 0, 0, 0);
            acc = __builtin_amdgcn_mfma_f32_16x16x32_bf16(hiv, wl, acc, 0, 0, 0);
            acc = __builtin_amdgcn_mfma_f32_16x16x32_bf16(lov, wh, acc, 0, 0, 0);
          }
        }
#pragma unroll
        for (int q = 0; q < 4; ++q) {
            float mx = acc[q];
            mx = fmaxf(mx, __int_as_float(__builtin_amdgcn_ds_swizzle(__float_as_int(mx), (1 << 10) | 0x1f)));
            mx = fmaxf(mx, __int_as_float(__builtin_amdgcn_ds_swizzle(__float_as_int(mx), (2 << 10) | 0x1f)));
            mx = fmaxf(mx, __int_as_float(__builtin_amdgcn_ds_swizzle(__float_as_int(mx), (4 << 10) | 0x1f)));
            mx = fmaxf(mx, __int_as_float(__builtin_amdgcn_ds_swizzle(__float_as_int(mx), (8 << 10) | 0x1f)));
            const float ex = expf(acc[q] - mx);
            float sm = ex;
            sm += __int_as_float(__builtin_amdgcn_ds_swizzle(__float_as_int(sm), (1 << 10) | 0x1f));
            sm += __int_as_float(__builtin_amdgcn_ds_swizzle(__float_as_int(sm), (2 << 10) | 0x1f));
            sm += __int_as_float(__builtin_amdgcn_ds_swizzle(__float_as_int(sm), (4 << 10) | 0x1f));
            sm += __int_as_float(__builtin_amdgcn_ds_swizzle(__float_as_int(sm), (8 << 10) | 0x1f));
            WSP(float, O_AFF)[(size_t)(row0 + wave * 16 + 4 * kg + q) * 16 + r16] = ex / sm;
        }
    }
    __syncthreads();
}

__device__ __forceinline__ void st_topk(int layer, char* smem) {
    STAGE_PARAMS();
    uint4* wc4 = (uint4*)smem;
    unsigned* wsum = (unsigned*)(smem + 256);
    const int tid = tid_, lane = tid & 63, wave = tid >> 6;
    const int nprob = layer == 0 ? 256 : 128;
    const float* AFF = WSP(const float, O_AFF);
    for (int pr = bid_; pr < nprob; pr += G_) {
        const bool isctx = pr >= 128; const int be = pr & 127, b = be >> 4, e = be & 15;
        const int n = isctx ? CTXL : SEQ, kk = isctx ? CAPC : CAP;
        const size_t row0 = isctx ? (size_t)NLAT + b * CTXL : (size_t)b * SEQ;
        unsigned kx[8];
#pragma unroll
        for (int u = 0; u < 8; ++u) { const int t = tid * 8 + u; kx[u] = (t < n) ? __float_as_uint(AFF[(row0 + t) * 16 + e]) : 0u; }
        __syncthreads();
        unsigned T = 0u, above = 0u; int par = 0;
#pragma unroll 1
        for (int shift = 27; shift >= 0; shift -= 3) {
            unsigned cw[8];
#pragma unroll
            for (int j = 0; j < 8; ++j) { const unsigned cand = T + ((unsigned)(j + 1) << shift); unsigned c = 0u;
#pragma unroll
                for (int u = 0; u < 8; ++u) c += (kx[u] >= cand) ? 1u : 0u;
                cw[j] = c; }
            unsigned pk[4] = {cw[0] | (cw[1] << 16), cw[2] | (cw[3] << 16), cw[4] | (cw[5] << 16), cw[6] | (cw[7] << 16)};
#define TK_SWZ(M_) _Pragma("unroll") for (int i = 0; i < 4; ++i) pk[i] += (unsigned)__builtin_amdgcn_ds_swizzle((int)pk[i], ((M_) << 10) | 0x1f)
            TK_SWZ(1); TK_SWZ(2); TK_SWZ(4); TK_SWZ(8); TK_SWZ(16);
#undef TK_SWZ
#pragma unroll
            for (int i = 0; i < 4; ++i) { const auto rr = __builtin_amdgcn_permlane32_swap(pk[i], pk[i], false, false); pk[i] = rr[0] + rr[1]; }
            if (lane == 0) wc4[par * 8 + wave] = make_uint4(pk[0], pk[1], pk[2], pk[3]);
            __syncthreads();
            uint4 sa = wc4[par * 8];
#pragma unroll
            for (int w = 1; w < 8; ++w) { const uint4 x = wc4[par * 8 + w]; sa.x += x.x; sa.y += x.y; sa.z += x.z; sa.w += x.w; }
            par ^= 1;
            const unsigned tot[8] = {sa.x & 0xFFFFu, sa.x >> 16, sa.y & 0xFFFFu, sa.y >> 16, sa.z & 0xFFFFu, sa.z >> 16, sa.w & 0xFFFFu, sa.w >> 16};
            int js = 0;
#pragma unroll
            for (int j = 0; j < 7; ++j) js += (tot[j] >= (unsigned)kk) ? 1 : 0;
            T += (unsigned)js << shift;
#pragma unroll
            for (int j = 0; j < 8; ++j) if (j == js) above = tot[j];
        }
        __syncthreads();
        const int krem = kk - (int)above;
        unsigned cg = 0u, ce = 0u;
#pragma unroll
        for (int u = 0; u < 8; ++u) { cg += (kx[u] > T) ? 1u : 0u; ce += (kx[u] == T) ? 1u : 0u; }
        const unsigned packed = cg | (ce << 16);
        unsigned incl = packed;
#pragma unroll
        for (int o = 1; o < 64; o <<= 1) { const unsigned t2 = (unsigned)__builtin_amdgcn_ds_bpermute(((lane - o) & 63) << 2, (int)incl); if (lane >= o) incl += t2; }
        if (lane == 63) wsum[wave] = incl;
        __syncthreads();
        unsigned off = 0u;
        for (int w = 0; w < wave; ++w) off += wsum[w];
        const unsigned excl = incl - packed + off;
        unsigned gpre = excl & 0xFFFFu, epre = excl >> 16;
        int* IDX = isctx ? WSP(int, O_IDXC) + e * 256 + b * CAPC : WSP(int, O_IDX) + be * CAP;
        float* GT = isctx ? WSP(float, O_GATEC) + e * 256 + b * CAPC : WSP(float, O_GATE) + be * CAP;
        short* SL = WSP(short, O_SLOT);
#pragma unroll
        for (int u = 0; u < 8; ++u) {
            const int t = tid * 8 + u;
            if (t < n) {
                const unsigned k = kx[u]; const bool g = k > T, eq = k == T;
                const bool sel = g || (eq && (int)epre < krem);
                const int slot = (int)gpre + ((int)epre < krem ? (int)epre : krem);
                if (sel) { IDX[slot] = (int)row0 + t; GT[slot] = __uint_as_float(k); }
                SL[(row0 + t) * 16 + e] = sel ? (short)slot : (short)-1;
                gpre += g ? 1u : 0u; epre += eq ? 1u : 0u;
            }
        }
        __syncthreads();
    }
}


namespace pg {
typedef short bf16x8 __attribute__((ext_vector_type(8)));
typedef float f32x4 __attribute__((ext_vector_type(4)));
typedef unsigned u32x4 __attribute__((ext_vector_type(4)));
constexpr int BM = 256, BK = 64, HALF = 128, HTB = HALF * BK * 2, STAGE_BYTES = 8 * HTB;
__device__ __forceinline__ int lds_byte(int r, int c) { const int st = (r >> 4) * 2 + (c >> 5), rr = r & 15, cc = c & 31, ob = rr * 64 + cc * 2; return st * 1024 + (ob ^ (((ob >> 9) & 1) << 5)); }
__device__ __forceinline__ void stage_rc(int b, int& R, int& C) { const int st = b / 1024, sb = b % 1024, swz = sb ^ (((sb >> 9) & 1) << 5); R = (st >> 1) * 16 + swz / 64; C = (st & 1) * 32 + (swz % 64) / 2; }
__device__ __forceinline__ int perm32(int rho) { const int n = rho >> 4, i = rho & 15; return 8 * (i >> 2) + 4 * n + (i & 3); }
__device__ __forceinline__ unsigned cvt_pk_bf16(float lo, float hi) { unsigned r; asm volatile("v_cvt_pk_bf16_f32 %0, %1, %2" : "=v"(r) : "v"(lo), "v"(hi)); return r; }

template <bool GATHER, class Epi, class Sched>
__device__ __forceinline__ void gemm_run(LAS unsigned char* lds, const int K, const Sched& S, const Epi& E, const int tid) {
    typedef typename Sched::Unit Unit;
    const int wid = __builtin_amdgcn_readfirstlane(tid >> 6), lane = tid & 63, wr = wid >> 2, wc = wid & 3, fr = lane & 15, fq = lane >> 4;
    const int nt = K / BK;
    int Rs[2], Cs[2]; unsigned voffB[2], voffA[2];
#pragma unroll
    for (int i = 0; i < 2; ++i) { stage_rc(tid * 16 + i * 8192, Rs[i], Cs[i]); const int Rb = (Rs[i] & ~31) + perm32(Rs[i] & 31); voffB[i] = (unsigned)(Rb * K + Cs[i]) * 2u; voffA[i] = (unsigned)(Rs[i] * K + Cs[i]) * 2u; }
    const size_t kstep = (size_t)(BK * 2);
    const size_t hstepB = (size_t)HALF * K * 2;
    const unsigned ldsw = (unsigned)wid * 1024u;
    const int aoff = lds_byte(wr * 64 + fr, fq * 8), boff = lds_byte(wc * 32 + fr, fq * 8);
#define PG_SA(b, h) (((b) * 2 + (h)) * HTB)
#define PG_SB(b, h) ((4 + (b) * 2 + (h)) * HTB)
#define PG_STAGE_B(bufoff, gbase) do { _Pragma("unroll") for (int _i = 0; _i < 2; ++_i) \
        __builtin_amdgcn_global_load_lds((const unsigned*)((const char*)(gbase) + voffB[_i]), (LAS unsigned*)(lds + (bufoff) + ldsw + _i * 8192), 16, 0, 0); } while (0)
#define PG_GLDS(src_, dst_) __builtin_amdgcn_global_load_lds((const unsigned*)(src_), (LAS unsigned*)(dst_), 16, 0, 0)
#define PG_STAGE_A(bufoff, gbase, h, NXT) do { \
        if constexpr (GATHER) { if (NXT) { PG_GLDS((const char*)(gbase) + ((h) ? on10 : on00), lds + (bufoff) + ldsw); PG_GLDS((const char*)(gbase) + ((h) ? on11 : on01), lds + (bufoff) + ldsw + 8192); } \
                                else     { PG_GLDS((const char*)(gbase) + ((h) ? oc10 : oc00), lds + (bufoff) + ldsw); PG_GLDS((const char*)(gbase) + ((h) ? oc11 : oc01), lds + (bufoff) + ldsw + 8192); } } \
        else { PG_GLDS((const char*)(gbase) + (size_t)(h) * hstepB + voffA[0], lds + (bufoff) + ldsw); PG_GLDS((const char*)(gbase) + (size_t)(h) * hstepB + voffA[1], lds + (bufoff) + ldsw + 8192); } } while (0)
#define PG_LDA(dst, b, h) do { _Pragma("unroll") for (int m = 0; m < 4; ++m) _Pragma("unroll") for (int k = 0; k < 2; ++k) dst[m][k] = *(const LAS bf16x8*)(lds + PG_SA(b, h) + aoff + m * 2048 + k * 1024); } while (0)
#define PG_LDB(dst, b, h) do { _Pragma("unroll") for (int n = 0; n < 2; ++n) _Pragma("unroll") for (int k = 0; k < 2; ++k) dst[n][k] = *(const LAS bf16x8*)(lds + PG_SB(b, h) + boff + n * 2048 + k * 1024); } while (0)
#define PG_MMA(ai, bj, At, Bt) do { __builtin_amdgcn_s_setprio(1); _Pragma("unroll") for (int m = 0; m < 4; ++m) _Pragma("unroll") for (int n = 0; n < 2; ++n) _Pragma("unroll") for (int k = 0; k < 2; ++k) \
        acc[ai][bj][m][n] = __builtin_amdgcn_mfma_f32_16x16x32_bf16(Bt[n][k], At[m][k], acc[ai][bj][m][n], 0, 0, 0); __builtin_amdgcn_s_setprio(0); } while (0)
#define PG_WAIT_V(n) asm volatile("s_waitcnt vmcnt(" #n ")" ::: "memory")
#define PG_WAIT_L(n) asm volatile("s_waitcnt lgkmcnt(" #n ")" ::: "memory")
#define PG_BAR __builtin_amdgcn_s_barrier()
#define PG_SCHED __builtin_amdgcn_sched_barrier(0)
    Unit cur, nxt; int ui = 0;
    if (!S.next(0, cur)) return;
    f32x4 acc[2][2][4][2];
#pragma unroll
    for (int a = 0; a < 2; ++a)
#pragma unroll
        for (int b = 0; b < 2; ++b)
#pragma unroll
            for (int m = 0; m < 4; ++m)
#pragma unroll
                for (int n = 0; n < 2; ++n) acc[a][b][m][n] = (f32x4){0.f, 0.f, 0.f, 0.f};
    bf16x8 At[4][2], B0[2][2], B1[2][2];
    unsigned oc00 = 0, oc01 = 0, oc10 = 0, oc11 = 0, on00 = 0, on01 = 0, on10 = 0, on11 = 0;
    if constexpr (GATHER) { oc00 = S.a_off(cur, Rs[0]) + (unsigned)Cs[0] * 2u; oc01 = S.a_off(cur, Rs[1]) + (unsigned)Cs[1] * 2u;
        oc10 = S.a_off(cur, HALF + Rs[0]) + (unsigned)Cs[0] * 2u; oc11 = S.a_off(cur, HALF + Rs[1]) + (unsigned)Cs[1] * 2u; }
    const char* cA = S.a_base(cur); const char* cB = S.b_base(cur);
    PG_STAGE_B(PG_SB(0, 0), cB); PG_STAGE_B(PG_SB(0, 1), cB + hstepB); PG_STAGE_A(PG_SA(0, 0), cA, 0, false); PG_STAGE_A(PG_SA(0, 1), cA, 1, false);
    if (wr == 1) PG_BAR;
    PG_WAIT_V(2); PG_BAR;
    PG_STAGE_B(PG_SB(1, 0), cB + kstep); PG_STAGE_A(PG_SA(1, 0), cA + kstep, 0, false); PG_STAGE_B(PG_SB(1, 1), cB + hstepB + kstep);
    PG_WAIT_V(6); PG_BAR;
    int psig = -1;
    for (;;) {
        const bool has_next = S.next(ui + 1, nxt);
        const char* nA = cA; const char* nB = cB;
        if (has_next) { nA = S.a_base(nxt); nB = S.b_base(nxt); }
        for (int t = 0; t < nt; t += 2) {
            const bool last = (t == nt - 2);
            if constexpr (GATHER) { if (last) {
                const Unit& nu = has_next ? nxt : cur;
                on00 = S.a_off(nu, Rs[0]) + (unsigned)Cs[0] * 2u; on01 = S.a_off(nu, Rs[1]) + (unsigned)Cs[1] * 2u;
                on10 = S.a_off(nu, HALF + Rs[0]) + (unsigned)Cs[0] * 2u; on11 = S.a_off(nu, HALF + Rs[1]) + (unsigned)Cs[1] * 2u; } }
            const char* a1 = cA + (size_t)(t + 1) * kstep;
            const char* a2 = last ? nA : cA + (size_t)(t + 2) * kstep; const char* b2 = last ? nB : cB + (size_t)(t + 2) * kstep;
            const char* a3 = a2 + kstep; const char* b3 = b2 + kstep;
            PG_LDB(B0, 0, 0); PG_LDB(B1, 0, 1); PG_SCHED; PG_LDA(At, 0, 0); PG_STAGE_A(PG_SA(1, 1), a1, 1, false);
            PG_WAIT_V(8); PG_WAIT_L(0); PG_BAR; PG_MMA(0, 0, At, B0); PG_MMA(0, 1, At, B1); PG_BAR; PG_SCHED;
            PG_LDA(At, 0, 1); PG_STAGE_B(PG_SB(0, 0), b2); PG_STAGE_B(PG_SB(0, 1), b2 + hstepB); PG_STAGE_A(PG_SA(0, 0), a2, 0, last);
            PG_WAIT_V(8); PG_WAIT_L(0); PG_BAR; PG_MMA(1, 0, At, B0); PG_MMA(1, 1, At, B1); PG_BAR; PG_SCHED;
            PG_LDB(B0, 1, 0); PG_LDB(B1, 1, 1); PG_SCHED; PG_LDA(At, 1, 0); PG_STAGE_A(PG_SA(0, 1), a2, 1, last);
            PG_WAIT_V(8); PG_WAIT_L(0); PG_BAR; PG_MMA(0, 0, At, B0); PG_MMA(0, 1, At, B1); PG_BAR; PG_SCHED;
            PG_LDA(At, 1, 1); PG_STAGE_B(PG_SB(1, 0), b3); PG_STAGE_B(PG_SB(1, 1), b3 + hstepB); PG_STAGE_A(PG_SA(1, 0), a3, 0, last);
            PG_WAIT_V(8); PG_WAIT_L(0); PG_BAR; PG_MMA(1, 0, At, B0); PG_MMA(1, 1, At, B1); PG_BAR; PG_SCHED;
        }
        if (wr == 0) PG_BAR;
        if (psig >= 0) E.signal(psig, lane);
        E(acc, cur, wr, wc, fr, fq);
        psig = __builtin_amdgcn_readfirstlane(E.sig(cur));
        if (!has_next) break;
#pragma unroll
        for (int a = 0; a < 2; ++a)
#pragma unroll
            for (int b = 0; b < 2; ++b)
#pragma unroll
                for (int m = 0; m < 4; ++m)
#pragma unroll
                    for (int n = 0; n < 2; ++n) acc[a][b][m][n] = (f32x4){0.f, 0.f, 0.f, 0.f};
        cur = nxt; cA = nA; cB = nB; if constexpr (GATHER) { oc00 = on00; oc01 = on01; oc10 = on10; oc11 = on11; } ++ui;
        if (wr == 1) PG_BAR;
    }
    PG_WAIT_V(0);
    if (psig >= 0) E.signal(psig, lane);
    PG_BAR;
#undef PG_SA
#undef PG_SB
#undef PG_STAGE_A
#undef PG_GLDS
#undef PG_STAGE_B
#undef PG_LDA
#undef PG_LDB
#undef PG_MMA
#undef PG_WAIT_V
#undef PG_WAIT_L
#undef PG_BAR
#undef PG_SCHED
}
}

__device__ __forceinline__ void transpose_item(const float* W, int K, int N, bf16_t* WT, int row_off, LAS float* scr, int item, int lane) {
    typedef float f32x4v __attribute__((ext_vector_type(4)));
    const int nblk = N / 32, kb = item / nblk, nb = item % nblk, k0 = 64 * kb, n0 = 32 * nb;
    const int kk = lane >> 3, n4 = (lane & 7) * 4;
    f32x4v v[8];
#pragma unroll
    for (int i = 0; i < 8; ++i) v[i] = *(const f32x4v*)(W + (size_t)(k0 + 8 * i + kk) * N + n0 + n4);
#pragma unroll
    for (int i = 0; i < 8; ++i) *(LAS f32x4v*)(scr + (8 * i + kk) * 36 + n4) = v[i];
    asm volatile("s_waitcnt lgkmcnt(0)" ::: "memory");
    const int n = lane & 31;
#pragma unroll
    for (int j = 0; j < 4; ++j) { const int c = (lane >> 5) + 2 * j; const LAS float* s = scr + (8 * c) * 36 + n;
        uint4 o; o.x = pk2(s[0 * 36], s[1 * 36]); o.y = pk2(s[2 * 36], s[3 * 36]); o.z = pk2(s[4 * 36], s[5 * 36]); o.w = pk2(s[6 * 36], s[7 * 36]);
        *(uint4*)(WT + (size_t)(row_off + n0 + n) * K + k0 + 8 * c) = o; }
    asm volatile("s_waitcnt lgkmcnt(0)" ::: "memory");
}
__device__ __forceinline__ void st_prep_weights(int which, int layer, char* smem, int vb, int nb) {
    STAGE_PARAMS();
    if (vb < 0) return;
    const int lane = tid_ & 63, wave = tid_ >> 6;
    LAS float* scr = (LAS float*)(LAS char*)smem + wave * (64 * 36);
    const int gw = vb * 8 + wave, NGW = nb * 8;
    if (which == 0) {
        constexpr int I_IN = 16 * 61, I_OUT = 16 * 32;
        for (int it = gw; it < 2 * (I_IN + I_OUT); it += NGW) {
            const int l = it / (I_IN + I_OUT); int r = it % (I_IN + I_OUT);
            if (r < I_IN) transpose_item(p.w_in + (size_t)l * 1024 * PCOLS, 1024, PCOLS, WSP(bf16_t, O_WINT) + (size_t)l * 2048 * 1024, 0, scr, r, lane);
            else transpose_item(p.w_out + (size_t)l * 1024 * 1024, 1024, 1024, WSP(bf16_t, O_WOUTT) + (size_t)l * 1024 * 1024, 0, scr, r - I_IN, lane);
        }
        for (int it = gw; it < 2 * 640; it += NGW) {
            const int l = it / 640, r = it % 640;
            const float* W; int N, n, s_; bf16_t* dst;
            if (r < 384) { const int f = r, hd = f / 48, nb = (f / 16) % 3; s_ = f % 16; W = p.mla_w_uq + (size_t)l * 256 * 768; N = 768; n = 96 * hd + 32 * nb + (lane & 31); dst = WSP(bf16_t, O_WUQT) + (size_t)l * 768 * 256 + (size_t)f * 512; }
            else { const int f = (r - 384) & 127, hd = f / 16, nb = (f / 8) & 1; s_ = f % 8; const bool isv = r >= 512; W = (isv ? p.mla_w_uv : p.mla_w_uk) + (size_t)l * 128 * 512; N = 512; n = 64 * hd + 32 * nb + (lane & 31);
                dst = WSP(bf16_t, isv ? O_WUVT : O_WUKT) + (size_t)l * 512 * 128 + (size_t)f * 512; }
            const float* src = W + (size_t)(16 * s_ + 8 * (lane >> 5)) * N + n;
            float v[8];
#pragma unroll
            for (int j = 0; j < 8; ++j) v[j] = src[(size_t)j * N];
            *(uint4*)(dst + lane * 8) = make_uint4(pk2(v[0], v[1]), pk2(v[2], v[3]), pk2(v[4], v[5]), pk2(v[6], v[7]));
        }
        for (int i = gw * 64 + lane; i < 2 * 96 * 128; i += NGW * 64) { const int l = i / (96 * 128), r = i % (96 * 128);
            ((uint4*)(WSP(bf16_t, O_WINT) + ((size_t)l * 2048 + 1952) * 1024))[r] = make_uint4(0u, 0u, 0u, 0u); }
    } else {
        constexpr int I_G = 16 * 24, I_D = 12 * 32;
        for (int it = gw; it < 16 * (2 * I_G + I_D); it += NGW) {
            const int e = it / (2 * I_G + I_D); int r = it % (2 * I_G + I_D);
            const size_t le = (size_t)(layer * 16 + e);
            if (r < 2 * I_G) {
                const bool up = r >= I_G; if (up) r -= I_G;
                const int nb = r % 24;
                const int n0 = nb * 32, dst0 = (n0 >> 7) * 256 + (up ? 128 : 0) + (n0 & 127);
                transpose_item((up ? p.exp_w_up : p.exp_w_gate) + le * 1024 * FF, 1024, FF, WSP(bf16_t, O_WGUT) + (size_t)e * 1536 * 1024, dst0 - n0, scr, r, lane);
            } else transpose_item(p.exp_w_down + le * FF * 1024, FF, 1024, WSP(bf16_t, O_WDT) + (size_t)e * 1024 * FF, 0, scr, r - 2 * I_G, lane);
        }
    }
}

struct SchedWin {
    struct Unit { int pm, pn; };
    const char* A; const char* B; int G, c; bool canon;
    __device__ __forceinline__ bool next(int i, Unit& u) const { const int L = i * G + c;
        if (canon && L >= 1024) { if (L >= 1280 || (c & 31) >= 8) return false; u.pm = 128 + (c >> 5); u.pn = c & 7; return true; }
        if (L >= 136 * 8) return false; u.pm = L >> 3; u.pn = L & 7; return true; }
    __device__ __forceinline__ const char* a_base(const Unit& u) const { return A + (size_t)u.pm * 256 * 2048; }
    __device__ __forceinline__ unsigned a_off(const Unit&, int) const { return 0u; }
    __device__ __forceinline__ const char* b_base(const Unit& u) const { return B + (size_t)u.pn * 256 * 2048; }
};
struct EpiWin {
    bf16_t* P; unsigned* dep; bool plain;
    __device__ __forceinline__ void operator()(const pg::f32x4 (&acc)[2][2][4][2], const SchedWin::Unit& u, int wr, int wc, int fr, int fq) const {
        fr = opq(fr); fq = opq(fq);
#pragma unroll
        for (int ai = 0; ai < 2; ++ai)
#pragma unroll
            for (int m = 0; m < 4; ++m) { bf16_t* rowp = P + (size_t)(u.pm * 256 + ai * 128 + wr * 64 + m * 16 + fr) * PLD + u.pn * 256 + wc * 32 + 8 * fq;
#pragma unroll
                for (int bj = 0; bj < 2; ++bj) { const pg::f32x4 v0 = acc[ai][bj][m][0], v1 = acc[ai][bj][m][1];
                    pg::u32x4 w; w.x = pg::cvt_pk_bf16(v0[0], v0[1]); w.y = pg::cvt_pk_bf16(v0[2], v0[3]); w.z = pg::cvt_pk_bf16(v1[0], v1[1]); w.w = pg::cvt_pk_bf16(v1[2], v1[3]);
                    if (plain) *(pg::u32x4*)(rowp + bj * 128) = w;
                    else asm volatile("global_store_dwordx4 %0, %1, off sc1\n\ts_nop 1" :: "v"(rowp + bj * 128), "v"(w) : "memory"); } }
    }
    __device__ __forceinline__ int sig(const SchedWin::Unit& u) const { return u.pm * 8; }
    __device__ __forceinline__ void signal(int i, int lane) const { if (lane == 0) __hip_atomic_fetch_add(dep + i, 1u, __ATOMIC_RELAXED, __HIP_MEMORY_SCOPE_AGENT); }
};
__device__ __forceinline__ void st_gemm_win_fast(int layer, char* smem, bool canon) {
    STAGE_PARAMS();
    SchedWin S{(const char*)WSP(bf16_t, O_HX), (const char*)(WSP(bf16_t, O_WINT) + (size_t)layer * 2048 * 1024), G_, vcu_of(bid_, G_), canon};
    EpiWin E{WSP(bf16_t, O_P), WSP(unsigned, O_DEPW) + layer * 136 * 8, canon};
    pg::gemm_run<false>((LAS unsigned char*)(LAS char*)smem, 1024, S, E, tid_);
}
struct SchedWout {
    struct Unit { int pm, pn; };
    const char* A; const char* B; int G, c, nunits; bool canon;
    __device__ __forceinline__ bool next(int i, Unit& u) const { const int L = i * G + c;
        if (canon && L >= 512) { if (L >= 768 || nunits <= 512 || (c & 31) >= 4) return false; u.pm = 128 + (c >> 5); u.pn = c & 3; return true; }
        if (L >= nunits) return false; u.pm = L >> 2; u.pn = L & 3; return true; }
    __device__ __forceinline__ const char* a_base(const Unit& u) const { return A + (size_t)u.pm * 256 * 2048; }
    __device__ __forceinline__ unsigned a_off(const Unit&, int) const { return 0u; }
    __device__ __forceinline__ const char* b_base(const Unit& u) const { return B + (size_t)u.pn * 256 * 2048; }
};
struct EpiWout {
    const float* xin_lat; const float* xin_ctx; const bf16_t* xinb; bool in_bf16; bf16_t* xo_lat; bf16_t* xo_lat2; bf16_t* xo_ctx;
    const float* mod2; LAS float* stage; float* ssq; unsigned* dep; bool canon;
    __device__ __forceinline__ void operator()(const pg::f32x4 (&acc)[2][2][4][2], const SchedWout::Unit& u, int wr, int wc, int fr, int fq) const {
        fr = opq(fr); fq = opq(fq);
        const bool isctx = u.pm >= 128; const int bv = isctx ? 8 : (u.pm >> 4);
        const float* xin = isctx ? xin_ctx + (size_t)(u.pm - 128) * 256 * DM : xin_lat + (size_t)u.pm * 256 * DM;
        const bf16_t* xib = xinb + (size_t)u.pm * 256 * DM;
        bf16_t* xo = isctx ? xo_ctx + (size_t)(u.pm - 128) * 256 * DM : (u.pm < 64 ? xo_lat + (size_t)u.pm * 256 * DM : xo_lat2 + (size_t)(u.pm - 64) * 256 * DM);
        const float* g = mod2 + (size_t)bv * 6144 + u.pn * 256 + wc * 32 + 8 * fq;
        pg::f32x4 gv[2][2];
#pragma unroll
        for (int bj = 0; bj < 2; ++bj)
#pragma unroll
            for (int n = 0; n < 2; ++n) gv[bj][n] = *(const pg::f32x4*)(g + bj * 128 + 4 * n);
        LAS float* st = stage + (wr * 4 + wc) * 576;
        const int lane = fr + 16 * fq, sr = lane >> 3, sc = (lane & 7) * 4;
#pragma unroll
        for (int ai = 0; ai < 2; ++ai)
        {
            pg::f32x4 xs[4][2][2];
            if (in_bf16) {
#pragma unroll
                for (int m = 0; m < 4; ++m)
#pragma unroll
                    for (int bj = 0; bj < 2; ++bj) { const size_t off = (size_t)(ai * 128 + wr * 64 + m * 16) * DM + u.pn * 256 + wc * 32 + bj * 128;
                        const uint2 a0 = *(const uint2*)(xib + off + (size_t)sr * DM + sc), a1 = *(const uint2*)(xib + off + (size_t)(sr + 8) * DM + sc);
                        xs[m][bj][0] = (pg::f32x4){__uint_as_float(a0.x), __uint_as_float(a0.y), 0.f, 0.f}; xs[m][bj][1] = (pg::f32x4){__uint_as_float(a1.x), __uint_as_float(a1.y), 0.f, 0.f}; }
            } else {
#pragma unroll
                for (int m = 0; m < 4; ++m)
#pragma unroll
                    for (int bj = 0; bj < 2; ++bj) { const size_t off = (size_t)(ai * 128 + wr * 64 + m * 16) * DM + u.pn * 256 + wc * 32 + bj * 128;
                        xs[m][bj][0] = *(const pg::f32x4*)(xin + off + (size_t)sr * DM + sc); xs[m][bj][1] = *(const pg::f32x4*)(xin + off + (size_t)(sr + 8) * DM + sc); }
            }
            __builtin_amdgcn_sched_barrier(0);
#pragma unroll
            for (int m = 0; m < 4; ++m) {
                float q0 = 0.f, q1 = 0.f;
#pragma unroll
                for (int bj = 0; bj < 2; ++bj) {
                    const size_t off = (size_t)(ai * 128 + wr * 64 + m * 16) * DM + u.pn * 256 + wc * 32 + bj * 128;
                    *(LAS pg::f32x4*)(st + fr * 36 + 8 * fq) = gv[bj][0] * acc[ai][bj][m][0];
                    *(LAS pg::f32x4*)(st + fr * 36 + 8 * fq + 4) = gv[bj][1] * acc[ai][bj][m][1];
                    pg::f32x4 x0, x1;
                    if (in_bf16) { const unsigned a0x = __float_as_uint(xs[m][bj][0][0]), a0y = __float_as_uint(xs[m][bj][0][1]), a1x = __float_as_uint(xs[m][bj][1][0]), a1y = __float_as_uint(xs[m][bj][1][1]);
                        x0 = (pg::f32x4){bflo(a0x), bfhi(a0x), bflo(a0y), bfhi(a0y)}; x1 = (pg::f32x4){bflo(a1x), bfhi(a1x), bflo(a1y), bfhi(a1y)}; }
                    else { x0 = xs[m][bj][0]; x1 = xs[m][bj][1]; }
                    asm volatile("s_waitcnt lgkmcnt(0)" ::: "memory");
                    const pg::f32x4 r0 = x0 + *(const LAS pg::f32x4*)(st + sr * 36 + sc), r1 = x1 + *(const LAS pg::f32x4*)(st + (sr + 8) * 36 + sc);
                    *(uint2*)(xo + off + (size_t)sr * DM + sc) = make_uint2(pk2(r0[0], r0[1]), pk2(r0[2], r0[3]));
                    *(uint2*)(xo + off + (size_t)(sr + 8) * DM + sc) = make_uint2(pk2(r1[0], r1[1]), pk2(r1[2], r1[3]));
                    q0 += r0[0] * r0[0] + r0[1] * r0[1] + r0[2] * r0[2] + r0[3] * r0[3]; q1 += r1[0] * r1[0] + r1[1] * r1[1] + r1[2] * r1[2] + r1[3] * r1[3];
                    asm volatile("s_waitcnt lgkmcnt(0)" ::: "memory");
                }
#define EW_RED(x_) q0 += __int_as_float(__builtin_amdgcn_ds_swizzle(__float_as_int(q0), ((x_) << 10) | 0x1f)); q1 += __int_as_float(__builtin_amdgcn_ds_swizzle(__float_as_int(q1), ((x_) << 10) | 0x1f));
                EW_RED(1) EW_RED(2) EW_RED(4)
#undef EW_RED
                if ((lane & 7) == 0) { float* d = ssq + (size_t)(u.pn * 4 + wc) * NROWS + u.pm * 256 + ai * 128 + wr * 64 + m * 16 + sr; d[0] = q0; d[8] = q1; }
            }
        }
    }
    __device__ __forceinline__ int sig(const SchedWout::Unit& u) const { return canon ? u.pm * 8 : -1; }
    __device__ __forceinline__ void signal(int i, int lane) const { if (lane == 0) __hip_atomic_fetch_add(dep + i, 1u, __ATOMIC_RELAXED, __HIP_MEMORY_SCOPE_AGENT); }
};
__device__ __forceinline__ void st_gemm_wout_fast(int layer, char* smem, bool canon) {
    STAGE_PARAMS();
    SchedWout S{(const char*)WSP(bf16_t, O_HX), (const char*)(WSP(bf16_t, O_WOUTT) + (size_t)layer * 1024 * 1024), G_, vcu_of(bid_, G_), (layer == 0 ? 136 : 128) * 4, canon};
    EpiWout E{p.x, p.ctx, (const bf16_t*)p.out, layer != 0, layer == 0 ? (bf16_t*)p.out : WSP(bf16_t, O_WQ), layer == 0 ? (bf16_t*)p.out + (size_t)64 * 256 * DM : WSP(bf16_t, O_VT), WSP(bf16_t, O_XC), WSP(float, O_MOD) + (size_t)layer * 9 * 6144 + 2 * 1024, (LAS float*)((LAS char*)smem + 131072), WSP(float, O_SSQ), WSP(unsigned, O_DEPX) + layer * 136 * 8, canon};
    pg::gemm_run<false>((LAS unsigned char*)(LAS char*)smem, 1024, S, E, tid_);
}
struct SchedMoeUp {
    struct Unit { int be, pm, pn, isctx; };
    const char* H2; const char* B; const int* idx; const int* idxc; int G, c, first, nunits;
    __device__ __forceinline__ bool next(int i, Unit& u) const { const int L = first + i * G + c; if (L >= nunits) return false;
        const bool ic = L >= 1536; const int q = ic ? L - 1536 : L; const int r = ic ? q % 6 : q % 12;
        const int i12 = q / 12;
        u.be = ic ? q / 6 : (i12 & 7) * 16 + (i12 >> 3); u.pm = ic ? 0 : r / 6; u.pn = r % 6; u.isctx = ic ? 1 : 0; return true; }
    __device__ __forceinline__ const char* a_base(const Unit&) const { return H2; }
    __device__ __forceinline__ unsigned a_off(const Unit& u, int r) const { const int* ri = u.isctx ? idxc + u.be * 256 : idx + u.be * CAP + u.pm * 256; return (unsigned)ri[r] * 2048u; }
    __device__ __forceinline__ const char* b_base(const Unit& u) const { return B + ((size_t)(u.isctx ? u.be : (u.be & 15)) * 1536 + (size_t)u.pn * 256) * 2048; }
};
struct EpiMoeUp {
    bf16_t* hid; bf16_t* hidc; unsigned* dep;
    __device__ __forceinline__ void operator()(const pg::f32x4 (&acc)[2][2][4][2], const SchedMoeUp::Unit& u, int wr, int wc, int fr, int fq) const {
        fr = opq(fr); fq = opq(fq);
        bf16_t* base = u.isctx ? hidc + (size_t)u.be * 256 * FF : hid + ((size_t)u.be * CAP + u.pm * 256) * FF;
#pragma unroll
        for (int ai = 0; ai < 2; ++ai)
#pragma unroll
            for (int m = 0; m < 4; ++m) { bf16_t* rowp = base + (size_t)(ai * 128 + wr * 64 + m * 16 + fr) * FF + u.pn * 128 + wc * 32 + 8 * fq;
                float h[8];
#pragma unroll
                for (int n = 0; n < 2; ++n)
#pragma unroll
                    for (int j = 0; j < 4; ++j) { const float gt = acc[ai][0][m][n][j], up = acc[ai][1][m][n][j]; h[n * 4 + j] = gt * __builtin_amdgcn_rcpf(1.f + __builtin_amdgcn_exp2f(-gt * LOG2E)) * up; }
                pg::u32x4 w; w.x = pg::cvt_pk_bf16(h[0], h[1]); w.y = pg::cvt_pk_bf16(h[2], h[3]); w.z = pg::cvt_pk_bf16(h[4], h[5]); w.w = pg::cvt_pk_bf16(h[6], h[7]);
                if (u.isctx) asm volatile("global_store_dwordx4 %0, %1, off sc1\n\ts_nop 1" :: "v"(rowp), "v"(w) : "memory"); else *(pg::u32x4*)rowp = w; }
    }
    __device__ __forceinline__ int sig(const SchedMoeUp::Unit& u) const { return u.isctx ? u.be * 4 : -1; }
    __device__ __forceinline__ void signal(int i, int lane) const { if (lane == 0) __hip_atomic_fetch_add(dep + i, 1u, __ATOMIC_RELAXED, __HIP_MEMORY_SCOPE_AGENT); }
};
__device__ __forceinline__ void st_moe_up_fast(int part, char* smem) {
    STAGE_PARAMS();
    SchedMoeUp S{(const char*)WSP(bf16_t, O_HX), (const char*)WSP(bf16_t, O_WGUT), WSP(const int, O_IDX), WSP(const int, O_IDXC), G_, vcu_of(bid_, G_), part ? 1536 : 0, part ? 1632 : 1536};
    EpiMoeUp E{WSP(bf16_t, O_HID), WSP(bf16_t, O_HIDC), WSP(unsigned, O_DEPH)};
    pg::gemm_run<true>((LAS unsigned char*)(LAS char*)smem, 1024, S, E, tid_);
}
struct SchedMoeDown {
    struct Unit { int be, pm, pn, isctx; };
    const char* hid; const char* hidc; const char* B; const unsigned* dep; int G, c, nunits;
    __device__ __forceinline__ bool next(int i, Unit& u) const { const int cs = (G == 256) ? 96 : 0; int L = i * G + c;
        if (L >= 1024) { const int j = L - 1024 - cs; L = (j >= 0) ? 1024 + j : nunits; }
        if (L >= nunits) return false;
        const bool ic = L >= 1024; const int q = ic ? L - 1024 : L;
        if (ic) { const unsigned* dw = dep + (q >> 2) * 4;
            if ((opaque_tid() & 63) == 0) for (unsigned spins = 0; __hip_atomic_load(dw, __ATOMIC_RELAXED, __HIP_MEMORY_SCOPE_AGENT) < 48u && spins < (1u << 24); ++spins) __builtin_amdgcn_s_sleep(2);
            __builtin_amdgcn_fence(__ATOMIC_ACQUIRE, "agent"); asm volatile("s_waitcnt vmcnt(0)" ::: "memory"); }
        const int i8 = q >> 3;
        u.be = ic ? (q >> 2) : (i8 & 7) * 16 + (i8 >> 3); u.pm = ic ? 0 : ((q & 7) >> 2); u.pn = q & 3; u.isctx = ic ? 1 : 0; return true; }
    __device__ __forceinline__ const char* a_base(const Unit& u) const { return u.isctx ? hidc + (size_t)u.be * 256 * FF * 2 : hid + ((size_t)u.be * CAP + u.pm * 256) * FF * 2; }
    __device__ __forceinline__ unsigned a_off(const Unit&, int r) const { return (unsigned)r * (FF * 2); }
    __device__ __forceinline__ const char* b_base(const Unit& u) const { return B + ((size_t)(u.isctx ? u.be : (u.be & 15)) * 1024 + (size_t)u.pn * 256) * (FF * 2); }
};
struct EpiMoeDown {
    bf16_t* ys; bf16_t* ysc; const float* gate; const float* gatec;
    __device__ __forceinline__ void operator()(const pg::f32x4 (&acc)[2][2][4][2], const SchedMoeDown::Unit& u, int wr, int wc, int fr, int fq) const {
        fr = opq(fr); fq = opq(fq);
        bf16_t* base = u.isctx ? ysc + (size_t)u.be * 256 * DM : ys + ((size_t)u.be * CAP + u.pm * 256) * DM;
        float gvs[2][4];
        { const float* gp = (u.isctx ? gatec + u.be * 256 : gate + u.be * CAP + u.pm * 256) + wr * 64 + fr;
#pragma unroll
          for (int ai = 0; ai < 2; ++ai)
#pragma unroll
              for (int m = 0; m < 4; ++m) gvs[ai][m] = gp[ai * 128 + m * 16]; }
        __builtin_amdgcn_sched_barrier(0);
#pragma unroll
        for (int ai = 0; ai < 2; ++ai)
#pragma unroll
            for (int m = 0; m < 4; ++m) { const int r = ai * 128 + wr * 64 + m * 16 + fr;
                const float gv = gvs[ai][m];
                bf16_t* rowp = base + (size_t)r * DM + u.pn * 256 + wc * 32 + 8 * fq;
#pragma unroll
                for (int bj = 0; bj < 2; ++bj) { const pg::f32x4 v0 = acc[ai][bj][m][0] * gv, v1 = acc[ai][bj][m][1] * gv;
                    pg::u32x4 w; w.x = pg::cvt_pk_bf16(v0[0], v0[1]); w.y = pg::cvt_pk_bf16(v0[2], v0[3]); w.z = pg::cvt_pk_bf16(v1[0], v1[1]); w.w = pg::cvt_pk_bf16(v1[2], v1[3]);
                    *(pg::u32x4*)(rowp + bj * 128) = w; } }
    }
    __device__ __forceinline__ int sig(const SchedMoeDown::Unit&) const { return -1; }
    __device__ __forceinline__ void signal(int, int) const {}
};
__device__ __forceinline__ void st_moe_down_fast(int layer, char* smem) {
    STAGE_PARAMS();
    SchedMoeDown S{(const char*)WSP(bf16_t, O_HID), (const char*)WSP(bf16_t, O_HIDC), (const char*)WSP(bf16_t, O_WDT), WSP(const unsigned, O_DEPH), G_, vcu_of(bid_, G_), 1024 + (layer == 0 ? 64 : 0)};
    EpiMoeDown E{WSP(bf16_t, O_YS), WSP(bf16_t, O_YSC), WSP(const float, O_GATE), WSP(const float, O_GATEC)};
    pg::gemm_run<false>((LAS unsigned char*)(LAS char*)smem, FF, S, E, tid_);
}

namespace fa {
typedef short bf16x8 __attribute__((ext_vector_type(8)));
typedef short bf16x4 __attribute__((ext_vector_type(4)));
typedef float f32x16 __attribute__((ext_vector_type(16)));
typedef unsigned u32x4 __attribute__((ext_vector_type(4)));
typedef unsigned u32x2 __attribute__((ext_vector_type(2)));
constexpr int VSTRIDE = 144;
__device__ __forceinline__ unsigned cvt_pk(float lo, float hi) { unsigned r; asm volatile("v_cvt_pk_bf16_f32 %0, %1, %2" : "=v"(r) : "v"(lo), "v"(hi)); return r; }
__device__ __forceinline__ float xhalf_max(float v) { const auto rr = __builtin_amdgcn_permlane32_swap(__float_as_uint(v), __float_as_uint(v), false, false); return fmaxf(__uint_as_float(rr[0]), __uint_as_float(rr[1])); }
__device__ __forceinline__ float xhalf_sum(float v) { const auto rr = __builtin_amdgcn_permlane32_swap(__float_as_uint(v), __float_as_uint(v), false, false); return __uint_as_float(rr[0]) + __uint_as_float(rr[1]); }
typedef short s16x4 __attribute__((ext_vector_type(4)));
__device__ __forceinline__ int vtr_st(int k, int c) { return ((k >> 3) * 2 + (c >> 5)) * 512 + ((k & 7) * 32 + (c & 31)) * 2; }
__device__ __forceinline__ int vtr_base(int lane) { return ((lane & 3) << 3) | (((lane >> 2) & 3) << 6) | (((lane >> 4) & 1) << 5) | (((lane >> 5) & 1) << 8); }
constexpr int vtr_off(int d0, int ks, int half) { return d0 * 512 + ks * 2048 + half * 1024; }
template <int OFF> __device__ __forceinline__ u32x2 vtr_read(int vb) { s16x4 r; asm volatile("ds_read_b64_tr_b16 %0, %1 offset:%2" : "=&v"(r) : "v"(vb), "i"(OFF) : "memory"); return __builtin_bit_cast(u32x2, r); }
#define VTR_READ_ALL(va_, vb_) do { \
    va_[0][0] = vtr_read<vtr_off(0, 0, 0)>(vb_); va_[0][1] = vtr_read<vtr_off(0, 0, 1)>(vb_); va_[0][2] = vtr_read<vtr_off(1, 0, 0)>(vb_); va_[0][3] = vtr_read<vtr_off(1, 0, 1)>(vb_); \
    va_[1][0] = vtr_read<vtr_off(0, 1, 0)>(vb_); va_[1][1] = vtr_read<vtr_off(0, 1, 1)>(vb_); va_[1][2] = vtr_read<vtr_off(1, 1, 0)>(vb_); va_[1][3] = vtr_read<vtr_off(1, 1, 1)>(vb_); \
    va_[2][0] = vtr_read<vtr_off(0, 2, 0)>(vb_); va_[2][1] = vtr_read<vtr_off(0, 2, 1)>(vb_); va_[2][2] = vtr_read<vtr_off(1, 2, 0)>(vb_); va_[2][3] = vtr_read<vtr_off(1, 2, 1)>(vb_); \
    va_[3][0] = vtr_read<vtr_off(0, 3, 0)>(vb_); va_[3][1] = vtr_read<vtr_off(0, 3, 1)>(vb_); va_[3][2] = vtr_read<vtr_off(1, 3, 0)>(vb_); va_[3][3] = vtr_read<vtr_off(1, 3, 1)>(vb_); } while (0)

__device__ __forceinline__ float max3f(float a, float b, float c) { float r; asm("v_max3_f32 %0, %1, %2, %3" : "=v"(r) : "v"(a), "v"(b), "v"(c)); return r; }
template <int DQK, bool WIN, bool QS = false, bool VTR = false>
__device__ __forceinline__ void attn_unit(LAS unsigned char* lds, const int tid, const bf16_t* Qp, const int qstride, const bf16_t* Kp, const bf16_t* Vt, const int vt_stride,
                                          const int ntiles, const int nfirst, const int second0, const int qtok0, const float sink_l2, bf16_t* Yp, const int ystride, const float sink_l2b = 0.f, const bf16_t* Vc = nullptr) {
    constexpr int KSTRIDE = DQK * 2 + 16, KCH = DQK / 8, KBUF = 64 * KSTRIDE, VBUF = 64 * VSTRIDE, NKS = DQK / 16;
    constexpr float THR = 8.f;
    const int lane = tid & 63, wave = __builtin_amdgcn_readfirstlane(tid >> 6), q32 = lane & 31, hh = lane >> 5;
    const int wrow = QS ? (wave & 3) * 32 : wave * 32, hoff = QS ? (wave >> 2) * 64 : 0;
    const int kr0 = tid / KCH, kc0 = tid % KCH, kr1 = (tid + 512) / KCH, kc1 = (tid + 512) % KCH; const bool k2 = (tid + 512) < 64 * KCH;
    const int vd = tid >> 3, vc = tid & 7;
    const unsigned kl0 = kr0 * KSTRIDE + kc0 * 16, kl1 = kr1 * KSTRIDE + kc1 * 16, vl = VTR ? vtr_st(vd, vc * 8) : vd * VSTRIDE + (vc >> 1) * 32 + (vc & 1) * 8;
#define FA_KEY0(i) ((i) < nfirst ? 64 * (i) : second0 + 64 * ((i) - nfirst))
    bf16x8 qf[NKS];
    { const bf16_t* qr = Qp + (size_t)(wrow + q32) * qstride + hoff + 8 * hh;
#pragma unroll
      for (int s = 0; s < NKS; ++s) qf[s] = *(const bf16x8*)(qr + 16 * s); }
    f32x16 o0, o1, o2, negm;
#pragma unroll
    for (int r = 0; r < 16; ++r) { o0[r] = 0.f; o1[r] = 0.f; o2[r] = 0.f; negm[r] = 0.f; }
    float mref = 0.f;
    const bf16x8 ones = (bf16x8){16256, 16256, 16256, 16256, 16256, 16256, 16256, 16256};
    u32x4 ak0, ak1 = (u32x4){0u, 0u, 0u, 0u}, av;
#define FA_LOAD(k0_, k1_, v_, ti_) do { const int key0_ = FA_KEY0(ti_); \
        k0_ = *(const u32x4*)(Kp + (size_t)(key0_ + kr0) * DQK + kc0 * 8); if (k2) k1_ = *(const u32x4*)(Kp + (size_t)(key0_ + kr1) * DQK + kc1 * 8); \
        if (VTR) v_ = *(const u32x4*)((key0_ < 256 ? Vc : Vt) + (size_t)(key0_ + vd) * vt_stride + vc * 8); else v_ = *(const u32x4*)(Vt + (size_t)vd * vt_stride + key0_ + vc * 8); } while (0)
#define FA_STORE(k0_, k1_, v_, b_) do { *(LAS u32x4*)(lds + (b_) * KBUF + kl0) = k0_; if (k2) *(LAS u32x4*)(lds + (b_) * KBUF + kl1) = k1_; \
        if (VTR) *(LAS u32x4*)(lds + 2 * KBUF + (b_) * VBUF + vl) = v_; else { *(LAS u32x2*)(lds + 2 * KBUF + (b_) * VBUF + vl) = (u32x2){v_.x, v_.y}; *(LAS u32x2*)(lds + 2 * KBUF + (b_) * VBUF + vl + 16) = (u32x2){v_.z, v_.w}; } } while (0)
#define FA_BAR() do { asm volatile("s_waitcnt lgkmcnt(0)" ::: "memory"); __syncthreads(); } while (0)
    FA_LOAD(ak0, ak1, av, 0);
    FA_BAR();
    FA_STORE(ak0, ak1, av, 0);
    for (int t = 0; t < ntiles; ++t) {
        const int buf = t & 1;
        FA_BAR();
        const bool more = (t + 1) < ntiles;
        if (WIN) { if (more) FA_LOAD(ak0, ak1, av, t + 1); }
        {
        const int key0 = FA_KEY0(t);
        bool active = true;
        if (WIN) { if ((t) >= nfirst) { const int kt0 = key0 - 256, qw0 = qtok0 + wrow; active = (kt0 <= qw0 + 31 + 128) && (kt0 + 63 >= qw0 - 128); } }
        if (active) {
            const LAS unsigned char* kb = lds + buf * KBUF + q32 * KSTRIDE + 16 * hh;
            const LAS unsigned char* vb = lds + 2 * KBUF + buf * VBUF + q32 * VSTRIDE + 16 * hh;
            bf16x8 kf0[NKS / 2], kf1[NKS / 2];
#pragma unroll
            for (int s = 0; s < NKS / 2; ++s) { kf0[s] = *(const LAS bf16x8*)(kb + 32 * s); kf1[s] = *(const LAS bf16x8*)(kb + 32 * KSTRIDE + 32 * s); }
            if (!WIN) { __builtin_amdgcn_sched_barrier(0); if (more) FA_LOAD(ak0, ak1, av, t + 1); }
            __builtin_amdgcn_sched_barrier(0);
            f32x16 p0 = __builtin_amdgcn_mfma_f32_32x32x16_bf16(kf0[0], qf[0], negm, 0, 0, 0), p1 = __builtin_amdgcn_mfma_f32_32x32x16_bf16(kf1[0], qf[0], negm, 0, 0, 0);
#pragma unroll
            for (int s = 1; s < NKS / 2; ++s) {
                p0 = __builtin_amdgcn_mfma_f32_32x32x16_bf16(kf0[s], qf[s], p0, 0, 0, 0);
                p1 = __builtin_amdgcn_mfma_f32_32x32x16_bf16(kf1[s], qf[s], p1, 0, 0, 0);
            }
            __builtin_amdgcn_sched_barrier(0);
#pragma unroll
            for (int s = 0; s < NKS / 2; ++s) { kf0[s] = *(const LAS bf16x8*)(kb + 32 * (s + NKS / 2)); kf1[s] = *(const LAS bf16x8*)(kb + 32 * KSTRIDE + 32 * (s + NKS / 2)); }
            __builtin_amdgcn_sched_barrier(0);
#pragma unroll
            for (int s = 0; s < NKS / 2; ++s) {
                p0 = __builtin_amdgcn_mfma_f32_32x32x16_bf16(kf0[s], qf[s + NKS / 2], p0, 0, 0, 0);
                p1 = __builtin_amdgcn_mfma_f32_32x32x16_bf16(kf1[s], qf[s + NKS / 2], p1, 0, 0, 0);
            }
            u32x2 va[4][4];
            if (VTR) { const int vtb = (int)(unsigned)(size_t)(lds + 2 * KBUF + buf * VBUF) + vtr_base(lane); VTR_READ_ALL(va, vtb); }
            else {
#pragma unroll
            for (int s = 0; s < 4; ++s) { const u32x4 t0 = *(const LAS u32x4*)(vb + 32 * s), t1 = *(const LAS u32x4*)(vb + 32 * VSTRIDE + 32 * s);
                va[s][0] = (u32x2){t0.x, t0.y}; va[s][1] = (u32x2){t0.z, t0.w}; va[s][2] = (u32x2){t1.x, t1.y}; va[s][3] = (u32x2){t1.z, t1.w}; } }
            __builtin_amdgcn_sched_barrier(0);
            asm volatile("s_nop 15\n\ts_nop 7" : "+v"(p0), "+v"(p1));
            if (WIN) { if ((t) >= nfirst && ((key0 - 256) < qtok0 + wrow + 31 - 128 || (key0 - 256) + 63 > qtok0 + wrow + 128)) { const int qi = qtok0 + wrow + q32, kb0 = key0 - 256 + 4 * hh;
#pragma unroll
                for (int r = 0; r < 16; ++r) { const int kj = kb0 + (r & 3) + 8 * (r >> 2); const int d0 = kj - qi, d1 = d0 + 32;
                    if (d0 > 128 || d0 < -128) p0[r] = -1e30f; if (d1 > 128 || d1 < -128) p1[r] = -1e30f; } } }
            float mxa, mxb, mxc, mxd;
#define FA_MAX16(A_, B_, P_) asm("v_max3_f32 %0, %2, %3, %4\n\tv_max3_f32 %1, %5, %6, %7\n\tv_max3_f32 %0, %0, %8, %9\n\tv_max3_f32 %1, %1, %10, %11\n\tv_max3_f32 %0, %0, %12, %13\n\tv_max3_f32 %1, %1, %14, %15\n\tv_max3_f32 %0, %0, %16, %17" \
                : "=&v"(A_), "=&v"(B_) : "v"(P_[0]), "v"(P_[1]), "v"(P_[2]), "v"(P_[3]), "v"(P_[4]), "v"(P_[5]), "v"(P_[6]), "v"(P_[7]), "v"(P_[8]), "v"(P_[9]), "v"(P_[10]), "v"(P_[11]), "v"(P_[12]), "v"(P_[13]), "v"(P_[14]), "v"(P_[15]))
            FA_MAX16(mxa, mxb, p0); FA_MAX16(mxc, mxd, p1);
#undef FA_MAX16
            const float mxl = max3f(max3f(mxa, mxb, mxc), mxd, mxd);
            if ((t == 0) || __any(mxl > THR)) {
                const float mx = xhalf_max(mxl);
                const float dl = ((t == 0)) ? mx : fmaxf(mx, 0.f), f = __builtin_amdgcn_exp2f(-dl);
                mref += dl; o2[0] *= f;
#pragma unroll
                for (int r = 0; r < 16; ++r) { o0[r] *= f; o1[r] *= f; p0[r] -= dl; p1[r] -= dl; negm[r] -= dl; }
            }
#pragma unroll
            for (int r = 0; r < 16; ++r) { p0[r] = __builtin_amdgcn_exp2f(p0[r]); p1[r] = __builtin_amdgcn_exp2f(p1[r]); }
            {
                float q0 = p0[0] + p1[0], q1 = p0[1] + p1[1], q2 = p0[2] + p1[2], q3 = p0[3] + p1[3];
#pragma unroll
                for (int r = 4; r < 16; r += 4) { q0 += p0[r] + p1[r]; q1 += p0[r + 1] + p1[r + 1]; q2 += p0[r + 2] + p1[r + 2]; q3 += p0[r + 3] + p1[r + 3]; }
                o2[0] += (q0 + q1) + (q2 + q3);
            }
            bf16x8 pf[4];
#pragma unroll
            for (int s = 0; s < 4; ++s) { unsigned w[4];
#pragma unroll
                for (int j = 0; j < 4; ++j) { const int r = 8 * (s & 1) + 2 * j; w[j] = (s < 2) ? cvt_pk(p0[r], p0[r + 1]) : cvt_pk(p1[r], p1[r + 1]); }
                const u32x4 u = (u32x4){w[0], w[1], w[2], w[3]}; pf[s] = __builtin_bit_cast(bf16x8, u); }
            if (VTR) { asm volatile("s_waitcnt lgkmcnt(0)" ::: "memory"); __builtin_amdgcn_sched_barrier(0); }
#pragma unroll
            for (int s = 0; s < 4; ++s) {
                const u32x4 u0 = (u32x4){va[s][0].x, va[s][0].y, va[s][1].x, va[s][1].y}, u1 = (u32x4){va[s][2].x, va[s][2].y, va[s][3].x, va[s][3].y};
                o0 = __builtin_amdgcn_mfma_f32_32x32x16_bf16(__builtin_bit_cast(bf16x8, u0), pf[s], o0, 0, 0, 0);
                o1 = __builtin_amdgcn_mfma_f32_32x32x16_bf16(__builtin_bit_cast(bf16x8, u1), pf[s], o1, 0, 0, 0);
            }
        }
        }
        if (more) FA_STORE(ak0, ak1, av, buf ^ 1);
    }
#undef FA_LOAD
#undef FA_STORE
#undef FA_BAR
#undef FA_KEY0
    float lt = xhalf_sum(o2[0]);
    if (WIN) lt += __builtin_amdgcn_exp2f(((QS && wave >= 4) ? sink_l2b : sink_l2) - mref);
    const float inv = 1.f / lt;
    bf16_t* yr = Yp + (size_t)(wrow + q32) * ystride + hoff + 4 * hh;
#pragma unroll
    for (int g = 0; g < 4; ++g) {
        *(uint2*)(yr + 8 * g) = make_uint2(cvt_pk(o0[4 * g] * inv, o0[4 * g + 1] * inv), cvt_pk(o0[4 * g + 2] * inv, o0[4 * g + 3] * inv));
        *(uint2*)(yr + 32 + 8 * g) = make_uint2(cvt_pk(o1[4 * g] * inv, o1[4 * g + 1] * inv), cvt_pk(o1[4 * g + 2] * inv, o1[4 * g + 3] * inv));
    }
}
}

__device__ __forceinline__ void st_mla_fast(int layer, char* smem) {
    STAGE_PARAMS();
    LAS unsigned char* lds = (LAS unsigned char*)(LAS char*)smem;
    const int c = vcu_of(bid_, G_);
    const int nunits = 1024 + (layer == 0 ? 64 : 0);
    const bf16_t* QM = WSP(const bf16_t, O_QM); const bf16_t* KM = WSP(const bf16_t, O_KM); const bf16_t* VT = WSP(const bf16_t, O_VT); bf16_t* Y = WSP(bf16_t, O_HX);
    if (tid_ >= 256) __builtin_amdgcn_s_setprio(1);
    for (int L = c; L < nunits; L += G_) {
        int bh, row0, ntiles;
        if (L < 1024) { bh = L >> 4; row0 = (bh >> 3) * SEQ + (L & 15) * 256; ntiles = NKEYS / 64; }
        else { bh = L - 1024; row0 = NLAT + (bh >> 3) * CTXL; ntiles = CTXL / 64; }
        const int h = bh & 7;
        fa::attn_unit<96, false>(lds, tid_, QM + ((size_t)row0 * 8 + h) * 96, 768, KM + (size_t)bh * NKEYS * 96, VT + (size_t)bh * 64 * NKEYS, NKEYS,
                                 ntiles, ntiles, 0, 0, 0.f, Y + (size_t)row0 * DM + 256 + h * 64, DM);
    }
    __builtin_amdgcn_s_setprio(0);
}

template <int NC>
__device__ __forceinline__ void tile_transpose(const bf16_t* P, int row0, int c0, bf16_t* dst, int NH, int b, int key0, LAS unsigned short* scr, int tid) {
    constexpr int LDW = NC + 2;
    for (int id = tid; id < 64 * (NC / 8); id += 512) { const int r = id / (NC / 8), ch = id % (NC / 8);
        const uint4 u = *(const uint4*)(P + (size_t)(row0 + r) * PLD + c0 + ch * 8);
        LAS unsigned* d = (LAS unsigned*)(scr + r * LDW + ch * 8); d[0] = u.x; d[1] = u.y; d[2] = u.z; d[3] = u.w; }
    __syncthreads();
    for (int id = tid; id < NC * 8; id += 512) { const int col = id >> 3, c8 = id & 7;
        unsigned w[4];
#pragma unroll
        for (int j = 0; j < 4; ++j) w[j] = (unsigned)scr[(c8 * 8 + 2 * j) * LDW + col] | ((unsigned)scr[(c8 * 8 + 2 * j + 1) * LDW + col] << 16);
        *(uint4*)(dst + ((size_t)(b * NH + (col >> 6)) * 64 + (col & 63)) * NKEYS + key0 + c8 * 8) = make_uint4(w[0], w[1], w[2], w[3]); }
    __syncthreads();
}
__device__ __forceinline__ int chunk_row0(int b, int ck) { return ck < 2 ? NLAT + b * CTXL + ck * 128 : b * SEQ + (ck - 2) * 128; }
template <class PT>
__device__ __forceinline__ void ret_kv_item(const PT& p, int layer, int item, char* smem, int tid) {
    using namespace fa;
    LAS unsigned char* lds = (LAS unsigned char*)(LAS char*)smem;
    constexpr int IMG = 16384, OFF_KF = IMG, OFF_KB = 2 * IMG;
    const bf16_t* P = WSP(const bf16_t, O_P);
    const int ck = item % 34, bh = item / 34, h = bh & 3, b = bh >> 2;
    const int row0 = chunk_row0(b, ck);
    const float lgf = WSP(const float, O_RETLG)[layer * 8 + h], lgb = WSP(const float, O_RETLG)[layer * 8 + 4 + h];
    {
        u32x4 uk[2], uv[2];
#pragma unroll
        for (int i = 0; i < 2; ++i) { const int id = tid + 512 * i, r = id >> 3, ch = id & 7;
            uk[i] = *(const u32x4*)(P + (size_t)(row0 + r) * PLD + C_RK + h * 64 + ch * 8); uv[i] = *(const u32x4*)(P + (size_t)(row0 + r) * PLD + C_RV + h * 64 + ch * 8); }
#pragma unroll
        for (int i = 0; i < 2; ++i) { const int id = tid + 512 * i, r = id >> 3, ch = id & 7;
            const float wf = __builtin_amdgcn_exp2f(lgf * (float)(127 - r)), wb = __builtin_amdgcn_exp2f(lgb * (float)r);
            const unsigned kw[4] = {uk[i].x, uk[i].y, uk[i].z, uk[i].w};
            u32x4 kf, kbw;
#pragma unroll
            for (int j = 0; j < 4; ++j) { const float k0 = bflo(kw[j]), k1 = bfhi(kw[j]); kf[j] = cvt_pk(k0 * wf, k1 * wf); kbw[j] = cvt_pk(k0 * wb, k1 * wb); }
            const unsigned la = (r >> 6) * 8192 + vtr_st(r & 63, ch * 8);
            *(LAS u32x4*)(lds + la) = uv[i]; *(LAS u32x4*)(lds + OFF_KF + la) = kf; *(LAS u32x4*)(lds + OFF_KB + la) = kbw;
        }
    }
    asm volatile("s_waitcnt lgkmcnt(0)" ::: "memory"); __syncthreads();
    {
        const int lane = tid & 63, wave = __builtin_amdgcn_readfirstlane(tid >> 6), l31 = lane & 31, hh = lane >> 5;
        const int dir = wave >> 2, dvb = (wave >> 1) & 1, dkb = wave & 1;
        const int vab = (int)(unsigned)(size_t)lds + vtr_base(lane) + dvb * 512;
        const int kbb = (int)(unsigned)(size_t)lds + (dir ? OFF_KB : OFF_KF) + vtr_base(lane) + dkb * 512;
        u32x2 fa_[8][2], fb_[8][2];
#define RK_RD(s_) fa_[s_][0] = vtr_read<vtr_off(0, (s_) & 3, 0) + ((s_) >> 2) * 8192>(vab); fa_[s_][1] = vtr_read<vtr_off(0, (s_) & 3, 1) + ((s_) >> 2) * 8192>(vab); \
                  fb_[s_][0] = vtr_read<vtr_off(0, (s_) & 3, 0) + ((s_) >> 2) * 8192>(kbb); fb_[s_][1] = vtr_read<vtr_off(0, (s_) & 3, 1) + ((s_) >> 2) * 8192>(kbb);
        RK_RD(0) RK_RD(1) RK_RD(2) RK_RD(3) RK_RD(4) RK_RD(5) RK_RD(6) RK_RD(7)
#undef RK_RD
        asm volatile("s_waitcnt lgkmcnt(0)" ::: "memory"); __builtin_amdgcn_sched_barrier(0);
        f32x16 acc;
#pragma unroll
        for (int r = 0; r < 16; ++r) acc[r] = 0.f;
#pragma unroll
        for (int s = 0; s < 8; ++s) { const u32x4 ua = (u32x4){fa_[s][0].x, fa_[s][0].y, fa_[s][1].x, fa_[s][1].y}, ub = (u32x4){fb_[s][0].x, fb_[s][0].y, fb_[s][1].x, fb_[s][1].y};
            acc = __builtin_amdgcn_mfma_f32_32x32x16_bf16(__builtin_bit_cast(bf16x8, ua), __builtin_bit_cast(bf16x8, ub), acc, 0, 0, 0); }
        float* o = WSP(float, dir ? O_KVB : O_KVF) + ((size_t)bh * 34 + ck) * 4096 + (size_t)(32 * dvb + 4 * hh) * 64 + 32 * dkb + l31;
#pragma unroll
        for (int r = 0; r < 16; ++r) o[((r & 3) + 8 * (r >> 2)) * 64] = acc[r];
    }
    asm volatile("s_waitcnt lgkmcnt(0)" ::: "memory"); __syncthreads();
}
__device__ __forceinline__ void st_ret_scan(int layer) {
    STAGE_PARAMS();
    for (int g = bid_ * 512 + tid_; g < 32 * 2 * 4096; g += G_ * 512) {
        const int e = g & 4095, dir = (g >> 12) & 1, bh = g >> 13, h = bh & 3;
        const float lg = WSP(const float, O_RETLG)[layer * 8 + dir * 4 + h];
        const float gch = exp2f(lg * 128.f);
        const float* kv = WSP(const float, dir ? O_KVB : O_KVF) + (size_t)bh * 34 * 4096 + e;
        bf16_t* sp = WSP(bf16_t, dir ? O_SPB : O_SPF) + (size_t)bh * 34 * 4096 + e;
        float s = 0.f;
#pragma unroll 1
        for (int c0 = 0; c0 < 34; c0 += 17) {
            float kvv[17];
#pragma unroll
            for (int i = 0; i < 17; ++i) { const int ii = c0 + i, ck = dir ? (ii < 2 ? 1 - ii : 35 - ii) : ii; kvv[i] = kv[(size_t)ck * 4096]; }
#pragma unroll
            for (int i = 0; i < 17; ++i) { const int ii = c0 + i, ck = dir ? (ii < 2 ? 1 - ii : 35 - ii) : ii; sp[(size_t)ck * 4096] = (bf16_t)f2bf(s); s = gch * s + kvv[i]; }
        }
    }
}

__device__ __forceinline__ void st_phase_c(int layer, char* smem, bool canon) {
    STAGE_PARAMS();
    using namespace fa;
    LAS unsigned char* lds = (LAS unsigned char*)(LAS char*)smem;
    constexpr int A1S = 528, A2S = 272, OFF_A2 = 64 * A1S, OFF_TM = OFF_A2 + 64 * A2S, OFF_TW = OFF_TM + 64 * 8 * 8, OFF_TR = OFF_TW + 64 * 16 * 8;
    typedef float f32x2v __attribute__((ext_vector_type(2)));
    LAS f32x2v* tabm = (LAS f32x2v*)(lds + OFF_TM);
    LAS f32x2v* tabw = (LAS f32x2v*)(lds + OFF_TW);
    const int tid = tid_, lane = tid & 63, wave = __builtin_amdgcn_readfirstlane(tid >> 6), l31 = lane & 31, hh = lane >> 5;
    for (int i = tid; i < 64 * 24; i += 512) { const int pos = i / 24, f = i % 24; float sn, cs;
        if (f < 8) { sincos_acc((float)pos * ROPE_INV8[f], sn, cs); tabm[pos * 8 + f] = (f32x2v){cs, sn}; }
        else { sincos_acc((float)pos * ROPE_INV16[f - 8], sn, cs); tabw[pos * 16 + f - 8] = (f32x2v){cs, sn}; } }
    const bf16_t* P = WSP(const bf16_t, O_P);
    const bf16_t* WUQ = WSP(const bf16_t, O_WUQT) + (size_t)layer * 768 * 256;
    const bf16_t* WUK = WSP(const bf16_t, O_WUKT) + (size_t)layer * 512 * 128;
    const bf16_t* WUV = WSP(const bf16_t, O_WUVT) + (size_t)layer * 512 * 128;
    bf16_t* QM = WSP(bf16_t, O_QM); bf16_t* KM = WSP(bf16_t, O_KM); bf16_t* VT = WSP(bf16_t, O_VT);
    const float qscale = 0.10206207261596575f * LOG2E, wscale = 0.125f * LOG2E;
    __syncthreads();
    LAS int* qslot = (LAS int*)(lds + 150016);
    LAS unsigned char* stg = lds + 96512 + (tid >> 6) * 6656;
    for (;;) {
        __syncthreads();
        if (tid == 0) {
            int it;
            if (canon) {
                const int x = vcu_of(bid_, G_) >> 5;
                const int q = (int)__hip_atomic_fetch_add(WSP(unsigned, O_QXCD) + (layer * 8 + x) * 64, 1u, __ATOMIC_RELAXED, __HIP_MEMORY_SCOPE_AGENT);
                if (q >= 204) it = NROWS / 64 + 8 * 4 * 34;
                else { const int mt = q < 68 ? q >> 2 : (q - 68) >> 3, pm = mt < 16 ? 32 * (mt >> 2) + 4 * x + (mt & 3) : 128 + x;
                    if (q < 68) it = pm * 4 + (q & 3);
                    else { const int sub = (q - 68) & 7, chunk = sub >> 2, hd = sub & 3, b = pm < 128 ? pm >> 4 : pm - 128, ck = pm < 128 ? 2 + (pm & 15) * 2 + chunk : chunk;
                        it = NROWS / 64 + (b * 4 + hd) * 34 + ck; } }
            } else it = (int)__hip_atomic_fetch_add(WSP(unsigned, O_QCNT) + layer * 64, 1u, __ATOMIC_RELAXED, __HIP_MEMORY_SCOPE_AGENT);
            if (it < NROWS / 64 + 8 * 4 * 34) {
                int r0 = it * 64;
                if (it >= NROWS / 64) { const int q = it - NROWS / 64; r0 = chunk_row0((q / 34) >> 2, q % 34); }
                const unsigned* dw = WSP(const unsigned, O_DEPW) + (layer * 136 + (r0 >> 8)) * 8;
                for (unsigned spins = 0; __hip_atomic_load(dw, __ATOMIC_RELAXED, __HIP_MEMORY_SCOPE_AGENT) < 64u && spins < (1u << 24); ++spins) __builtin_amdgcn_s_sleep(2);
                __builtin_amdgcn_fence(__ATOMIC_ACQUIRE, "agent");
                asm volatile("s_waitcnt vmcnt(0)" ::: "memory");
            }
            *qslot = it;
        }
        __syncthreads();
        const int item = *qslot;
        if (item >= NROWS / 64 + 8 * 4 * 34) break;
        if (item >= NROWS / 64) { ret_kv_item(p, layer, item - NROWS / 64, smem, tid); continue; }
        const int row0 = item * 64; const RowInfo ri = row_info(row0);
        const int key0 = ri.key, rowpos = ri.t >> 6; const bool isctx = ri.isctx != 0; const bool need_q = !(isctx && layer != 0);
        uint2 uqs[8]; unsigned uks[8];
#pragma unroll
        for (int rr = 0; rr < 8; ++rr) { const bf16_t* pr = P + (size_t)(row0 + wave * 8 + rr) * PLD; uqs[rr] = *(const uint2*)(pr + C_CQ + lane * 4); uks[rr] = *(const unsigned*)(pr + C_CKV + lane * 2); }
        const float4 gq = ((const float4*)(p.mla_qnorm_g + layer * 256))[lane]; const float2 gk = ((const float2*)(p.mla_kvnorm_g + layer * 128))[lane];
        __builtin_amdgcn_sched_barrier(0);
#pragma unroll
        for (int rr = 0; rr < 8; ++rr) { const int r = wave * 8 + rr;
            const uint2 uq = uqs[rr]; const unsigned uk = uks[rr];
            const float q0 = bflo(uq.x), q1 = bfhi(uq.x), q2 = bflo(uq.y), q3 = bfhi(uq.y), k0 = bflo(uk), k1 = bfhi(uk);
            const float rq = rsqrtf(wave_sum(q0 * q0 + q1 * q1 + q2 * q2 + q3 * q3) * (1.f / 256.f) + 1e-6f), rk = rsqrtf(wave_sum(k0 * k0 + k1 * k1) * (1.f / 128.f) + 1e-6f);
            *(LAS u32x2*)(lds + r * A1S + lane * 8) = (u32x2){cvt_pk(q0 * rq * gq.x, q1 * rq * gq.y), cvt_pk(q2 * rq * gq.z, q3 * rq * gq.w)};
            *(LAS unsigned*)(lds + OFF_A2 + r * A2S + lane * 4) = cvt_pk(k0 * rk * gk.x, k1 * rk * gk.y); }
        __syncthreads();
        if (need_q) {
            f32x16 acc[3][2];
#pragma unroll
            for (int nb = 0; nb < 3; ++nb)
#pragma unroll
                for (int tb = 0; tb < 2; ++tb)
#pragma unroll
                    for (int r = 0; r < 16; ++r) acc[nb][tb][r] = 0.f;
            const __attribute__((address_space(1))) bf16_t* wq = (const __attribute__((address_space(1))) bf16_t*)(WUQ + (size_t)(wave * 48) * 512 + lane * 8);
            asm volatile("" : "+v"(wq));
            const LAS unsigned char* ab = lds + l31 * A1S + 16 * hh;
            bf16x8 wA[2][3], wB[2][3];
#define PC_LDW(w_, s0_) do { _Pragma("unroll") for (int j = 0; j < 2; ++j) _Pragma("unroll") for (int nb = 0; nb < 3; ++nb) w_[j][nb] = *(const __attribute__((address_space(1))) bf16x8*)(wq + (size_t)(nb * 16 + (s0_) + j) * 512); } while (0)
#define PC_MMA(w_, s0_) do { _Pragma("unroll") for (int j = 0; j < 2; ++j) { const bf16x8 b0 = *(const LAS bf16x8*)(ab + 32 * ((s0_) + j)), b1 = *(const LAS bf16x8*)(ab + 32 * A1S + 32 * ((s0_) + j)); \
                _Pragma("unroll") for (int nb = 0; nb < 3; ++nb) { acc[nb][0] = __builtin_amdgcn_mfma_f32_32x32x16_bf16(w_[j][nb], b0, acc[nb][0], 0, 0, 0); acc[nb][1] = __builtin_amdgcn_mfma_f32_32x32x16_bf16(w_[j][nb], b1, acc[nb][1], 0, 0, 0); } } } while (0)
            PC_LDW(wA, 0); __builtin_amdgcn_sched_barrier(0);
#pragma unroll
            for (int c = 0; c < 16; c += 4) {
                PC_LDW(wB, c + 2); __builtin_amdgcn_sched_barrier(0);
                PC_MMA(wA, c); __builtin_amdgcn_sched_barrier(0);
                if (c + 4 < 16) { PC_LDW(wA, c + 4); __builtin_amdgcn_sched_barrier(0); }
                PC_MMA(wB, c + 2); __builtin_amdgcn_sched_barrier(0);
            }
#undef PC_LDW
#undef PC_MMA
#pragma unroll
            for (int tb = 0; tb < 2; ++tb) {
                if (!isctx) {
#pragma unroll
                    for (int r = 0; r < 4; ++r) {
                        const f32x2v cr = tabm[rowpos * 8 + 4 * hh + r], cc = tabm[(32 * tb + l31) * 8 + 4 * hh + r];
                        const float x1 = acc[2][tb][r], x2 = acc[2][tb][r + 4], y1 = acc[2][tb][r + 8], y2 = acc[2][tb][r + 12];
                        acc[2][tb][r] = x1 * cr.x - x2 * cr.y; acc[2][tb][r + 4] = x1 * cr.y + x2 * cr.x;
                        acc[2][tb][r + 8] = y1 * cc.x - y2 * cc.y; acc[2][tb][r + 12] = y1 * cc.y + y2 * cc.x; }
                }
#pragma unroll
                for (int nb = 0; nb < 3; ++nb)
#pragma unroll
                    for (int g = 0; g < 4; ++g) *(LAS u32x2*)(stg + opq(l31 * 208 + 8 * hh) + (32 * nb + 8 * g) * 2) = (u32x2){cvt_pk(acc[nb][tb][4 * g] * qscale, acc[nb][tb][4 * g + 1] * qscale), cvt_pk(acc[nb][tb][4 * g + 2] * qscale, acc[nb][tb][4 * g + 3] * qscale)};
                asm volatile("s_waitcnt lgkmcnt(0)" ::: "memory");
#pragma unroll
                for (int ps = 0; ps < 6; ++ps) { const int idx = opq(lane) + 64 * ps, rw = idx / 12, ch = idx % 12;
                    const u32x4 v = *(const LAS u32x4*)(stg + rw * 208 + ch * 16);
                    *(u32x4*)(QM + ((size_t)(row0 + 32 * tb + rw) * 8 + wave) * 96 + ch * 8) = v; }
                asm volatile("s_waitcnt lgkmcnt(0)" ::: "memory");
            }
        }
        {
            f32x16 ak[2][2], av[2][2];
#pragma unroll
            for (int nb = 0; nb < 2; ++nb)
#pragma unroll
                for (int tb = 0; tb < 2; ++tb)
#pragma unroll
                    for (int r = 0; r < 16; ++r) { ak[nb][tb][r] = 0.f; av[nb][tb][r] = 0.f; }
            const __attribute__((address_space(1))) bf16_t* wk = (const __attribute__((address_space(1))) bf16_t*)(WUK + (size_t)(wave * 16) * 512 + lane * 8);
            const __attribute__((address_space(1))) bf16_t* wv = (const __attribute__((address_space(1))) bf16_t*)(WUV + (size_t)(wave * 16) * 512 + lane * 8);
            asm volatile("" : "+v"(wk), "+v"(wv));
            const LAS unsigned char* ab = lds + OFF_A2 + l31 * A2S + 16 * hh;
            bf16x8 uA[2][2], uB[2][2];
#define PC_LDW(w_, s_) do { _Pragma("unroll") for (int nb = 0; nb < 2; ++nb) { w_[nb][0] = *(const __attribute__((address_space(1))) bf16x8*)(wk + (size_t)(nb * 8 + (s_)) * 512); w_[nb][1] = *(const __attribute__((address_space(1))) bf16x8*)(wv + (size_t)(nb * 8 + (s_)) * 512); } } while (0)
#define PC_MMA(w_, s_) do { const bf16x8 b0 = *(const LAS bf16x8*)(ab + 32 * (s_)), b1 = *(const LAS bf16x8*)(ab + 32 * A2S + 32 * (s_)); \
                _Pragma("unroll") for (int nb = 0; nb < 2; ++nb) { \
                    ak[nb][0] = __builtin_amdgcn_mfma_f32_32x32x16_bf16(w_[nb][0], b0, ak[nb][0], 0, 0, 0); ak[nb][1] = __builtin_amdgcn_mfma_f32_32x32x16_bf16(w_[nb][0], b1, ak[nb][1], 0, 0, 0); \
                    av[nb][0] = __builtin_amdgcn_mfma_f32_32x32x16_bf16(b0, w_[nb][1], av[nb][0], 0, 0, 0); av[nb][1] = __builtin_amdgcn_mfma_f32_32x32x16_bf16(b1, w_[nb][1], av[nb][1], 0, 0, 0); } } while (0)
            PC_LDW(uA, 0); __builtin_amdgcn_sched_barrier(0);
#pragma unroll
            for (int c = 0; c < 8; c += 2) {
                PC_LDW(uB, c + 1); __builtin_amdgcn_sched_barrier(0);
                PC_MMA(uA, c); __builtin_amdgcn_sched_barrier(0);
                if (c + 2 < 8) { PC_LDW(uA, c + 2); __builtin_amdgcn_sched_barrier(0); }
                PC_MMA(uB, c + 1); __builtin_amdgcn_sched_barrier(0);
            }
#undef PC_LDW
#undef PC_MMA
            const size_t bhw = (size_t)(ri.b * 8 + wave);
#pragma unroll
            for (int tb = 0; tb < 2; ++tb) {
#pragma unroll
                for (int nb = 0; nb < 2; ++nb)
#pragma unroll
                    for (int g = 0; g < 4; ++g) *(LAS u32x2*)(stg + opq(l31 * 144 + 8 * hh) + (32 * nb + 8 * g) * 2) = (u32x2){cvt_pk(ak[nb][tb][4 * g], ak[nb][tb][4 * g + 1]), cvt_pk(ak[nb][tb][4 * g + 2], ak[nb][tb][4 * g + 3])};
                asm volatile("s_waitcnt lgkmcnt(0)" ::: "memory");
#pragma unroll
                for (int ps = 0; ps < 4; ++ps) { const int idx = opq(lane) + 64 * ps, rw = idx >> 3, ch = idx & 7;
                    const u32x4 v = *(const LAS u32x4*)(stg + rw * 144 + ch * 16);
                    *(u32x4*)(KM + (bhw * NKEYS + key0 + 32 * tb + rw) * 96 + ch * 8) = v; }
                asm volatile("s_waitcnt lgkmcnt(0)" ::: "memory");
            }
#pragma unroll
            for (int nb = 0; nb < 2; ++nb) {
#pragma unroll
                for (int tb = 0; tb < 2; ++tb)
#pragma unroll
                    for (int g = 0; g < 4; ++g) *(LAS u32x2*)(stg + opq(l31 * 144 + 8 * hh) + (32 * tb + 8 * g) * 2) = (u32x2){cvt_pk(av[nb][tb][4 * g], av[nb][tb][4 * g + 1]), cvt_pk(av[nb][tb][4 * g + 2], av[nb][tb][4 * g + 3])};
                asm volatile("s_waitcnt lgkmcnt(0)" ::: "memory");
#pragma unroll
                for (int ps = 0; ps < 4; ++ps) { const int idx = opq(lane) + 64 * ps, rw = idx >> 3, ch = idx & 7;
                    const u32x4 v = *(const LAS u32x4*)(stg + rw * 144 + ch * 16);
                    *(u32x4*)(VT + (bhw * 64 + 32 * nb + rw) * NKEYS + key0 + ch * 8) = v; }
                asm volatile("s_waitcnt lgkmcnt(0)" ::: "memory");
            }
        }
        {
#pragma unroll
            for (int ps = 0; ps < 4; ++ps) { const int id = opq(tid) + 512 * ps, cc = id & 3, tk = (id >> 2) & 63, hd = id >> 8;
                const bf16_t* pr = P + (size_t)(row0 + tk) * PLD + C_KR;
                const uint4 uo = ((const uint4*)pr)[cc], up = ((const uint4*)pr)[cc ^ 1];
                const unsigned wo[4] = {uo.x, uo.y, uo.z, uo.w}, wp[4] = {up.x, up.y, up.z, up.w};
                float y[8];
#pragma unroll
                for (int j = 0; j < 8; ++j) { const float xo = (j & 1) ? bfhi(wo[j >> 1]) : bflo(wo[j >> 1]), xp = (j & 1) ? bfhi(wp[j >> 1]) : bflo(wp[j >> 1]);
                    if (isctx) y[j] = xo;
                    else { const f32x2v cs = tabm[((cc & 2) ? tk : rowpos) * 8 + j]; y[j] = (cc & 1) ? xp * cs.y + xo * cs.x : xo * cs.x - xp * cs.y; } }
                *(uint4*)(KM + ((size_t)(ri.b * 8 + hd) * NKEYS + key0 + tk) * 96 + 64 + cc * 8) = make_uint4(cvt_pk(y[0], y[1]), cvt_pk(y[2], y[3]), cvt_pk(y[4], y[5]), cvt_pk(y[6], y[7]));
            }
        }
        {
#pragma unroll 1
            for (int pg3 = 0; pg3 < 2; ++pg3) {
                uint4 uo3[3], up3[3];
#pragma unroll
                for (int q3 = 0; q3 < 3; ++q3) { const int ps = 3 * pg3 + q3; const bool isq = ps < 4; const int id = opq(tid) + 512 * (isq ? ps : ps - 4);
                    const int ch = isq ? (id & 31) : (id & 7), tk = isq ? (id >> 5) : ((id >> 3) & 63), hdk = id >> 9, cc = ch & 3;
                    const bf16_t* pr = P + (size_t)(row0 + tk) * PLD + (isq ? C_WQ : C_WK + hdk * 64) + (ch >> 2) * 32;
                    uo3[q3] = ((const uint4*)pr)[cc]; up3[q3] = ((const uint4*)pr)[cc ^ 2]; }
                __builtin_amdgcn_sched_barrier(0);
#pragma unroll
                for (int q3 = 0; q3 < 3; ++q3) { const int ps = 3 * pg3 + q3; const bool isq = ps < 4; const int id = opq(tid) + 512 * (isq ? ps : ps - 4);
                    const int ch = isq ? (id & 31) : (id & 7), tk = isq ? (id >> 5) : ((id >> 3) & 63), hdk = id >> 9;
                    const int cc = ch & 3, half = (ch >> 2) & 1;
                    const uint4 uo = uo3[q3], up = up3[q3];
                    const unsigned wo[4] = {uo.x, uo.y, uo.z, uo.w}, wp[4] = {up.x, up.y, up.z, up.w};
                    const float sc = isq ? wscale : 1.f;
                    float y[8];
#pragma unroll
                    for (int j = 0; j < 8; ++j) { const float xo = (j & 1) ? bfhi(wo[j >> 1]) : bflo(wo[j >> 1]), xp = (j & 1) ? bfhi(wp[j >> 1]) : bflo(wp[j >> 1]);
                        if (isctx) y[j] = xo * sc;
                        else { const f32x2v cs = tabw[(half == 0 ? rowpos : tk) * 16 + (cc & 1) * 8 + j]; y[j] = ((cc & 2) ? xp * cs.y + xo * cs.x : xo * cs.x - xp * cs.y) * sc; } }
                    bf16_t* o = isq ? WSP(bf16_t, O_WQ) + (size_t)(row0 + tk) * 256 + ch * 8 : WSP(bf16_t, O_WK) + ((size_t)(ri.b * 2 + hdk) * NKEYS + key0 + tk) * 64 + ch * 8;
                    *(uint4*)o = make_uint4(cvt_pk(y[0], y[1]), cvt_pk(y[2], y[3]), cvt_pk(y[4], y[5]), cvt_pk(y[6], y[7]));
                }
            }
        }
    }
}

__device__ __forceinline__ void st_win_fast(int layer, char* smem) {
    STAGE_PARAMS();
    LAS unsigned char* lds = (LAS unsigned char*)(LAS char*)smem;
    const int c = (vcu_of(bid_, G_) + G_ - 64 % G_) % G_;
    const int nunits = 512 + (layer == 0 ? 32 : 0);
    const bf16_t* WQ = WSP(const bf16_t, O_WQ); const bf16_t* WK = WSP(const bf16_t, O_WK); const bf16_t* WVT = WSP(const bf16_t, O_WVT); bf16_t* Y = WSP(bf16_t, O_HX);
    if (tid_ >= 256) __builtin_amdgcn_s_setprio(1);
    for (int L = c; L < nunits; L += G_) {
        int b, hk, row0, ntiles, second0 = 0, qtok0 = 0;
        if (L < 512) { const int bk = L >> 5, qb = L & 31; b = bk >> 1; hk = bk & 1; qtok0 = qb * 128; row0 = b * SEQ + qtok0;
            const int lo = qtok0 - 128 < 0 ? 0 : qtok0 - 128, hi = qtok0 + 255 > SEQ - 1 ? SEQ - 1 : qtok0 + 255;
            ntiles = 4 + (hi + 1 - lo) / 64; second0 = 256 + lo; }
        else { const int q = L - 512; b = q >> 2; hk = (q >> 1) & 1; row0 = NLAT + b * CTXL + (q & 1) * 128; ntiles = 4; }
        const bf16_t* Pv = WSP(const bf16_t, O_P) + C_WV + hk * 64;
        fa::attn_unit<64, true, true, true>(lds, tid_, WQ + (size_t)row0 * 256 + hk * 128, 256, WK + (size_t)(b * 2 + hk) * NKEYS * 64, Pv + ((long)b * SEQ - 256) * (long)PLD, PLD,
                                      ntiles, 4, second0, qtok0, p.win_sink[layer * 4 + 2 * hk] * LOG2E, Y + (size_t)row0 * DM + 768 + hk * 128, DM, p.win_sink[layer * 4 + 2 * hk + 1] * LOG2E,
                                      Pv + ((size_t)NLAT + (size_t)b * CTXL) * PLD);
    }
    __builtin_amdgcn_s_setprio(0);
}
__device__ __forceinline__ void st_ret_fast(int layer, char* smem) {
    STAGE_PARAMS();
    using namespace fa;
    LAS unsigned char* lds = (LAS unsigned char*)(LAS char*)smem;
    constexpr int KSTR = 144, VSTR = 520, KB = 256 * KSTR;
    const int tid = tid_, lane = tid & 63, wave = __builtin_amdgcn_readfirstlane(tid >> 6), q32 = lane & 31, hh = lane >> 5;
    const int c = (vcu_of(bid_, G_) + G_ - 96 % G_) % G_;
    const int npair = layer == 0 ? 17 : 16, nunits = 32 * npair;
    const bf16_t* P = WSP(const bf16_t, O_P); const bf16_t* RVT = WSP(const bf16_t, O_RVT); bf16_t* Y = WSP(bf16_t, O_HX);
    for (int L = c; L < nunits; L += G_) {
        const int bh = L / npair, pr = L % npair + (layer == 0 ? 0 : 1), b = bh >> 2, h = bh & 3;
        const int row0 = chunk_row0(b, 2 * pr), key0 = pr == 0 ? 0 : 256 + (2 * pr - 2) * 128;
        const float lgf = WSP(const float, O_RETLG)[layer * 8 + h], lgb = WSP(const float, O_RETLG)[layer * 8 + 4 + h];
        __syncthreads();
        const int ckl = wave >> 2, ck = 2 * pr + ckl, cpos = opq(32 * (wave & 3) + q32);
        const int row = row0 + wave * 32 + q32;
        u32x4 uk4[4], uv4[4];
#pragma unroll
        for (int i = 0; i < 4; ++i) { const int id = tid + 512 * i; uk4[i] = *(const u32x4*)(P + (size_t)(row0 + (id >> 3)) * PLD + C_RK + h * 64 + (id & 7) * 8);
            uv4[i] = *(const u32x4*)(P + (size_t)(row0 + (id >> 3)) * PLD + C_RV + h * 64 + (id & 7) * 8); }
        bf16x8 qf[4];
#pragma unroll
        for (int s = 0; s < 4; ++s) qf[s] = *(const bf16x8*)(P + (size_t)row * PLD + C_RQ + h * 64 + 16 * s + 8 * hh);
        uint2 gga[4], ggb[4];
        { const bf16_t* gr0 = P + (size_t)row * PLD + C_RG + h * 64 + 4 * hh;
#pragma unroll
          for (int g = 0; g < 4; ++g) { gga[g] = *(const uint2*)(gr0 + 8 * g); ggb[g] = *(const uint2*)(gr0 + 32 + 8 * g); } }
        bf16x8 spf[2][4][2];
#pragma unroll
        for (int dir = 0; dir < 2; ++dir) { const bf16_t* sp = WSP(const bf16_t, dir ? O_SPB : O_SPF) + ((size_t)bh * 34 + ck) * 4096 + (size_t)q32 * 64 + 8 * hh;
#pragma unroll
            for (int s = 0; s < 4; ++s) { spf[dir][s][0] = *(const bf16x8*)(sp + 16 * s); spf[dir][s][1] = *(const bf16x8*)(sp + 32 * 64 + 16 * s); } }
        __builtin_amdgcn_sched_barrier(0);
#pragma unroll
        for (int i = 0; i < 4; ++i) { const int id = tid + 512 * i; const int r = id >> 3, ch = id & 7;
            *(LAS u32x4*)(lds + r * KSTR + ch * 16) = uk4[i]; }
#pragma unroll
        for (int i = 0; i < 4; ++i) { const int id = tid + 512 * i; const int r = id >> 3, ch = id & 7;
            *(LAS u32x4*)(lds + KB + (r >> 6) * 8192 + vtr_st(r & 63, ch * 8)) = uv4[i]; }
        f32x16 o0, o1;
#pragma unroll
        for (int r = 0; r < 16; ++r) { o0[r] = 0.f; o1[r] = 0.f; }
#pragma unroll
        for (int dir = 0; dir < 2; ++dir) {
            f32x16 r0, r1;
#pragma unroll
            for (int r = 0; r < 16; ++r) { r0[r] = 0.f; r1[r] = 0.f; }
#pragma unroll
            for (int s = 0; s < 4; ++s) {
                const bf16x8 a0 = spf[dir][s][0], a1 = spf[dir][s][1];
                r0 = __builtin_amdgcn_mfma_f32_32x32x16_bf16(a0, qf[s], r0, 0, 0, 0);
                r1 = __builtin_amdgcn_mfma_f32_32x32x16_bf16(a1, qf[s], r1, 0, 0, 0);
            }
            const float wq = __builtin_amdgcn_exp2f(dir ? lgb * (float)(128 - cpos) : lgf * (float)(cpos + 1));
#pragma unroll
            for (int r = 0; r < 16; ++r) { o0[r] += wq * r0[r]; o1[r] += wq * r1[r]; }
        }
        __syncthreads();
#pragma unroll
        for (int tt = 0; tt < 2; ++tt) {
            const int kbase = ckl * 128 + tt * 64;
            const LAS unsigned char* kb = lds + (kbase + q32) * KSTR + 16 * hh;
            f32x16 p0, p1;
#pragma unroll
            for (int r = 0; r < 16; ++r) { p0[r] = 0.f; p1[r] = 0.f; }
#pragma unroll
            for (int s = 0; s < 4; ++s) {
                const bf16x8 a0 = *(const LAS bf16x8*)(kb + 32 * s), a1 = *(const LAS bf16x8*)(kb + 32 * KSTR + 32 * s);
                p0 = __builtin_amdgcn_mfma_f32_32x32x16_bf16(a0, qf[s], p0, 0, 0, 0);
                p1 = __builtin_amdgcn_mfma_f32_32x32x16_bf16(a1, qf[s], p1, 0, 0, 0);
            }
            const float dbase = (float)(cpos - tt * 64 - 4 * hh), nlgb = -lgb;
#pragma unroll
            for (int r = 0; r < 16; ++r) { const float df0 = dbase - (float)((r & 3) + 8 * (r >> 2)), df1 = df0 - 32.f;
                p0[r] *= __builtin_amdgcn_exp2f(fminf(lgf * df0, nlgb * df0));
                p1[r] *= __builtin_amdgcn_exp2f(fminf(lgf * df1, nlgb * df1)); }
            bf16x8 pf[4];
#pragma unroll
            for (int s = 0; s < 4; ++s) { unsigned w[4];
#pragma unroll
                for (int j = 0; j < 4; ++j) { const int r = 8 * (s & 1) + 2 * j; w[j] = (s < 2) ? cvt_pk(p0[r], p0[r + 1]) : cvt_pk(p1[r], p1[r + 1]); }
                const u32x4 u = (u32x4){w[0], w[1], w[2], w[3]}; pf[s] = __builtin_bit_cast(bf16x8, u); }
            u32x2 va[4][4];
            { const int vtb = (int)(unsigned)(size_t)(lds + KB + (kbase >> 6) * 8192) + vtr_base(lane); VTR_READ_ALL(va, vtb); }
            asm volatile("s_waitcnt lgkmcnt(0)" ::: "memory"); __builtin_amdgcn_sched_barrier(0);
#pragma unroll
            for (int s = 0; s < 4; ++s) {
                const u32x2 a00 = va[s][0], a01 = va[s][1], a10 = va[s][2], a11 = va[s][3];
                const u32x4 u0 = (u32x4){a00.x, a00.y, a01.x, a01.y}, u1 = (u32x4){a10.x, a10.y, a11.x, a11.y};
                o0 = __builtin_amdgcn_mfma_f32_32x32x16_bf16(__builtin_bit_cast(bf16x8, u0), pf[s], o0, 0, 0, 0);
                o1 = __builtin_amdgcn_mfma_f32_32x32x16_bf16(__builtin_bit_cast(bf16x8, u1), pf[s], o1, 0, 0, 0);
            }
        }
        float sm = 0.f;
#pragma unroll
        for (int r = 0; r < 16; ++r) { o0[r] *= 0.125f; o1[r] *= 0.125f; sm += o0[r] + o1[r]; }
        const float mu = xhalf_sum(sm) * (1.f / 64.f);
        float sq = 0.f;
#pragma unroll
        for (int r = 0; r < 16; ++r) { o0[r] -= mu; o1[r] -= mu; sq += o0[r] * o0[r] + o1[r] * o1[r]; }
        const float rstd = rsqrtf(xhalf_sum(sq) * (1.f / 64.f) + 1e-5f);
        bf16_t* yr = Y + (size_t)row * DM + h * 64 + 4 * hh;
#pragma unroll
        for (int g = 0; g < 4; ++g) {
            const uint2 ga = gga[g], gb = ggb[g];
            const float g0[4] = {bflo(ga.x), bfhi(ga.x), bflo(ga.y), bfhi(ga.y)}, g1[4] = {bflo(gb.x), bfhi(gb.x), bflo(gb.y), bfhi(gb.y)};
            float y0[4], y1[4];
#pragma unroll
            for (int j = 0; j < 4; ++j) { y0[j] = o0[4 * g + j] * rstd * g0[j] * __builtin_amdgcn_rcpf(1.f + __builtin_amdgcn_exp2f(-g0[j] * LOG2E)); y1[j] = o1[4 * g + j] * rstd * g1[j] * __builtin_amdgcn_rcpf(1.f + __builtin_amdgcn_exp2f(-g1[j] * LOG2E)); }
            *(uint2*)(yr + 8 * g) = make_uint2(cvt_pk(y0[0], y0[1]), cvt_pk(y0[2], y0[3]));
            *(uint2*)(yr + 32 + 8 * g) = make_uint2(cvt_pk(y1[0], y1[1]), cvt_pk(y1[2], y1[3]));
        }
    }
}

#define XB_TMO      128
#define XB_XCNT(j)  (256  + 64 * (j))
#define XB_XSUB(j)  (1280 + 64 * (j))
#define XB_XGEN(j)  (2304 + 64 * (j))
#define XB_TOP      3328
#define XB_TOPGEN   3392
#define XCD_BAR_WORDS 3456
#define XB_SPIN_CAP (1u << 18)

__device__ __forceinline__ unsigned xb_ld(unsigned* p)              { return __hip_atomic_load(p, __ATOMIC_RELAXED, __HIP_MEMORY_SCOPE_AGENT); }
__device__ __forceinline__ unsigned xb_add(unsigned* p, unsigned v) { return __hip_atomic_fetch_add(p, v, __ATOMIC_RELAXED, __HIP_MEMORY_SCOPE_AGENT); }
__device__ __forceinline__ unsigned xb_xcc_id() { return (unsigned)__builtin_amdgcn_s_getreg((3 << 11) | 20) & 0xFu; }
#define XB_SPIN(cond, bar) do { unsigned _sp = 0; while (cond) { __builtin_amdgcn_s_sleep(1); \
    if ((++_sp & 255u) == 0u) { if (xb_ld(&(bar)[XB_TMO])) break; if (_sp > XB_SPIN_CAP) { atomicAdd(&(bar)[XB_TMO], 1u); break; } } } } while (0)

struct XcdBarrier {
    unsigned* bar; unsigned x;
    volatile LAS unsigned* st;
};

__device__ __forceinline__ XcdBarrier xcd_barrier_post(unsigned* bar, volatile LAS unsigned* st) {
    XcdBarrier b; b.bar = bar; b.x = xb_xcc_id(); b.st = st;
    if (threadIdx.x == 0) (void)xb_add(&bar[XB_XCNT(b.x)], 1u);
    return b;
}
__device__ __forceinline__ void xcd_barrier_complete(unsigned* bar, unsigned x, unsigned& nloc, unsigned& nx) {
    const unsigned G = gridDim.x * gridDim.y * gridDim.z;
    unsigned sum, cnt, mine, sp = 0u;
    for (;;) {
        sum = 0u; cnt = 0u; mine = 0u;
#pragma unroll
        for (unsigned j = 0; j < 16; ++j) { const unsigned c = xb_ld(&bar[XB_XCNT(j)]); sum += c; cnt += (c > 0u) ? 1u : 0u; mine = (j == x) ? c : mine; }
        if (sum == G) break;
        __builtin_amdgcn_s_sleep(1);
        if ((++sp & 255u) == 0u) { if (xb_ld(&bar[XB_TMO])) break; if (sp > XB_SPIN_CAP) { atomicAdd(&bar[XB_TMO], 1u); break; } }
    }
    nloc = mine > 0u ? mine : 1u; nx = cnt > 0u ? cnt : 1u;
}

__device__ __forceinline__ void xcd_barrier(const XcdBarrier& b) {
    asm volatile("s_waitcnt vmcnt(0)" ::: "memory");
    __syncthreads();
    if (threadIdx.x == 0) {
        unsigned* bar = b.bar; unsigned bx = b.x; asm volatile("" : "+s"(bar), "+s"(bx));
        __builtin_amdgcn_s_waitcnt(0);
        unsigned nloc = b.st[0], nx = b.st[1];
        if (nloc == 0u) { xcd_barrier_complete(bar, bx, nloc, nx); b.st[0] = nloc; b.st[1] = nx; }
        const unsigned old = xb_add(&bar[XB_XSUB(bx)], 1u);
        const unsigned gen = old / nloc;
        if (old + 1u == (gen + 1u) * nloc) {
            __builtin_amdgcn_fence(__ATOMIC_RELEASE, "agent");
            asm volatile("s_waitcnt vmcnt(0)" ::: "memory");
            const unsigned og = xb_add(&bar[XB_TOP], 1u);
            const unsigned tg = og / nx;
            if (og + 1u == (tg + 1u) * nx) xb_add(&bar[XB_TOPGEN], 1u);
            else XB_SPIN(xb_ld(&bar[XB_TOPGEN]) == tg, bar);
            __builtin_amdgcn_fence(__ATOMIC_ACQUIRE, "agent");
            asm volatile("s_waitcnt vmcnt(0)" ::: "memory");
        } else {
            XB_SPIN(xb_ld(&bar[XB_TOPGEN]) == gen, bar);
            __builtin_amdgcn_fence(__ATOMIC_ACQUIRE, "agent");
            asm volatile("s_waitcnt vmcnt(0)" ::: "memory");
        }
    }
    __syncthreads();
}

constexpr int MK_LDS = 151552;
constexpr size_t CW_BAR = 4096;
__global__ void __launch_bounds__(512, 2) k_mega(Params p, int pad0, int pad1) {
    extern __shared__ __attribute__((aligned(16))) char smem[];
    volatile LAS unsigned* misc = (volatile LAS unsigned*)(smem + MK_LDS - 64);
    if (threadIdx.x < 16) misc[threadIdx.x] = 0u;
    __syncthreads();
    XcdBarrier bar = xcd_barrier_post(WSP(unsigned, O_CTL) + CW_BAR, misc);
#define GRID_BAR() xcd_barrier(bar)
    { const int myx = __builtin_amdgcn_readfirstlane((int)xb_xcc_id()), wantx = __builtin_amdgcn_readfirstlane((int)(blockIdx.x & 7u)), g256 = __builtin_amdgcn_readfirstlane((int)gridDim.x);
      unsigned mismv = (unsigned)(myx != wantx) | (unsigned)(g256 != 256);
      if (threadIdx.x == 0) __hip_atomic_fetch_or(WSP(unsigned, O_CANON), mismv, __ATOMIC_RELAXED, __HIP_MEMORY_SCOPE_AGENT); }
    st_mods(smem);
    st_prep_weights(0, 0, smem, (int)blockIdx.x, (int)gridDim.x);
    GRID_BAR();
    int canon_i = (int)__hip_atomic_load(WSP(unsigned, O_CANON), __ATOMIC_RELAXED, __HIP_MEMORY_SCOPE_AGENT); canon_i = __builtin_amdgcn_readfirstlane(canon_i); asm volatile("" : "+s"(canon_i));
    const bool canon = canon_i == 0;
    for (int l = 0; l < 2; ++l) {
        st_rownorm(l);
        GRID_BAR();
        st_gemm_win_fast(l, smem, canon);
        st_phase_c(l, smem, canon);
        GRID_BAR();
        st_ret_scan(l);
        GRID_BAR();
        st_mla_fast(l, smem); st_win_fast(l, smem); st_ret_fast(l, smem);
        GRID_BAR();
        st_gemm_wout_fast(l, smem, canon);
        if (!canon) GRID_BAR();
        st_norm2_router(l, smem, canon);
        {   const int G = (int)gridDim.x; int vb = (int)blockIdx.x, nb = G;
            if (l == 0) { if (canon) { const int cc = vcu_of((int)blockIdx.x, G); vb = (cc & 31) >= 6 ? (cc >> 5) * 26 + (cc & 31) - 6 : -1; nb = G - 48; } else { const int extra = 272 % G; vb = (int)blockIdx.x - extra; nb = G - extra; } }
            st_prep_weights(1, l, smem, vb, nb); }
        GRID_BAR();
        st_topk(l, smem);
        GRID_BAR();
#pragma unroll 1
        for (int part = 0; part < (l == 0 ? 2 : 1); ++part) {
            st_moe_up_fast(part, smem);
            if (part == 0) GRID_BAR();
        }
        st_moe_down_fast(l, smem);
        GRID_BAR();
    }
    st_rownorm(2);
}
}

extern "C" void kernel_launch(void* const* d_in, const int* in_sizes, int n_in, void* d_out, int out_size, void* d_ws, size_t ws_size, hipStream_t stream) {
    if (n_in != 23 || ws_size < O_END4 + (size_t)16 * NROWS * 4) { fprintf(stderr, "kernel_launch: unexpected n_in %d or ws_size %zu (< %zu)\n", n_in, ws_size, (size_t)(O_END4 + (size_t)16 * NROWS * 4)); return; }
    Params p{};
    const float** dst = (const float**)&p;
    for (int i = 0; i < 23; ++i) dst[i] = (const float*)d_in[i];
    p.out = (float*)d_out; p.ws = (unsigned char*)d_ws;
    static int grid = 0;
    if (grid == 0) {
        int dev = 0, cus = 0, per_cu = 0;
        if (hipGetDevice(&dev) != hipSuccess || hipDeviceGetAttribute(&cus, hipDeviceAttributeMultiprocessorCount, dev) != hipSuccess) { fprintf(stderr, "kernel_launch: device query failed\n"); grid = -1; return; }
        (void)hipFuncSetAttribute((const void*)k_mega, hipFuncAttributeMaxDynamicSharedMemorySize, MK_LDS);
        if (hipOccupancyMaxActiveBlocksPerMultiprocessor(&per_cu, (const void*)k_mega, 512, MK_LDS) != hipSuccess || per_cu < 1) { fprintf(stderr, "kernel_launch: occupancy query says %d\n", per_cu); per_cu = 1; }
        (void)hipGetLastError();
        grid = cus;
    }
    if (grid < 0) return;
    (void)hipMemsetAsync((char*)d_ws + O_CTL, 0, 65536, stream);
    hipLaunchKernelGGL(k_mega, dim3(grid), dim3(512), MK_LDS, stream, p, 0, 0);
}
```
